# Optimizing an MI355X kernel written in HIP

```python
import math
import jax
import jax.numpy as jnp
from jax import lax
import numpy as np

D_MODEL = 1024
BATCH = 4
SEQ = 8192
DEPTH = 4

DIFF_HEADS = 4
DIFF_WIDTH = D_MODEL // 2
DIFF_V_DIM = DIFF_WIDTH // DIFF_HEADS
DIFF_HEAD_DIM = DIFF_V_DIM // 2
DIFF_QK = DIFF_HEADS * 2 * DIFF_HEAD_DIM
Q_BLOCK = 128
ROPE_THETA = 10000.0
S5_WIDTH = D_MODEL // 4
S5_GROUP = 16
S5_GROUPS = S5_WIDTH // S5_GROUP
S5_STATE = 64
S5_DT_MIN = 0.001
S5_DT_MAX = 0.1
RET_HEADS = 4
RET_WIDTH = D_MODEL // 4
RET_HEAD_DIM = RET_WIDTH // RET_HEADS
RET_CHUNK = 128
MIX_WIDTH = DIFF_WIDTH + S5_WIDTH + RET_WIDTH
IN_WIDTH = 2 * DIFF_QK + DIFF_WIDTH + S5_WIDTH + 4 * RET_WIDTH
N_EXPERTS = 32
TOP_K = 4
EXPERT_FF = D_MODEL
SWIGLU_ALPHA = 1.702
SWIGLU_LIMIT = 7.0
EXPERT_BLOCK = 256
DEEPNORM_ALPHA = (2 * DEPTH) ** 0.25
DEEPNORM_BETA = (8 * DEPTH) ** -0.25
LN_EPS = 1e-5

kernel_name = 'hybrid_diffattn_s5_retention_moe_encoder'


def _layer_norm(x, g=None, b=None):
    xf = x.astype(jnp.float32)
    mu = jnp.mean(xf, axis=-1, keepdims=True)
    var = jnp.mean(jnp.square(xf - mu), axis=-1, keepdims=True)
    y = (xf - mu) * lax.rsqrt(var + LN_EPS)
    if g is not None:
        y = y * g.astype(jnp.float32) + b.astype(jnp.float32)
    return y.astype(x.dtype)


def _rms_norm(x, g):
    xf = x.astype(jnp.float32)
    y = xf * lax.rsqrt(jnp.mean(jnp.square(xf), axis=-1, keepdims=True) + LN_EPS)
    return (y * g.astype(jnp.float32)).astype(x.dtype)


def _rotary_tables(positions, inv_freq):
    ang = positions.astype(jnp.float32)[..., None] * inv_freq
    return jnp.cos(ang)[:, :, None, :], jnp.sin(ang)[:, :, None, :]


def _rotate(x, cos, sin):
    half = x.shape[-1] // 2
    x1, x2 = x[..., :half], x[..., half:]
    cos = cos.astype(x.dtype)
    sin = sin.astype(x.dtype)
    return jnp.concatenate([x1 * cos - x2 * sin, x2 * cos + x1 * sin], axis=-1)


def _split_projection(proj):
    sizes = (DIFF_QK, DIFF_QK, DIFF_WIDTH, S5_WIDTH, RET_WIDTH, RET_WIDTH, RET_WIDTH, RET_WIDTH)
    cuts = []
    acc = 0
    for s in sizes[:-1]:
        acc += s
        cuts.append(acc)
    return jnp.split(proj, cuts, axis=-1)


def _diff_attention(q, k, v, lam, subln_g, lambda_init):
    Bsz, L, H, _, d = q.shape
    scale = d ** -0.5
    qh = q.transpose(0, 2, 3, 1, 4)
    kh = k.transpose(0, 2, 3, 1, 4)
    vh = v.transpose(0, 2, 1, 3)
    nqb = L // Q_BLOCK
    qb = qh.reshape(Bsz, H, 2, nqb, Q_BLOCK, d).transpose(3, 0, 1, 2, 4, 5)

    def block(q_blk):
        s = jnp.einsum('bhcqd,bhckd->bhcqk', q_blk, kh).astype(jnp.float32) * scale
        p = jax.nn.softmax(s, axis=-1)
        a = (p[:, :, 0] - lam * p[:, :, 1]).astype(vh.dtype)
        return jnp.einsum('bhqk,bhkv->bhqv', a, vh)

    o = lax.map(block, qb)
    o = o.transpose(1, 0, 3, 2, 4).reshape(Bsz, L, H, 2 * d)
    o = _rms_norm(o, subln_g) * (1.0 - lambda_init)
    return o.reshape(Bsz, L, H * 2 * d)


def _s5_mixer(u, lam_re, lam_im, log_step, b_re, b_im, c_re, c_im, d_skip, glu_w, glu_b):
    f32 = jnp.float32
    Bsz, L, W = u.shape
    uf = u.astype(f32).reshape(Bsz, L, S5_GROUPS, S5_GROUP)
    lr = jnp.minimum(lam_re.astype(f32), -1e-4)
    li = lam_im.astype(f32)
    dt = jnp.exp(log_step.astype(f32))[..., None]
    mag = jnp.exp(lr * dt)
    ab_re = mag * jnp.cos(li * dt)
    ab_im = mag * jnp.sin(li * dt)
    den = lr * lr + li * li
    f_re = ((ab_re - 1.0) * lr + ab_im * li) / den
    f_im = (ab_im * lr - (ab_re - 1.0) * li) / den
    bre = b_re.astype(f32)
    bim = b_im.astype(f32)
    bb_re = f_re[..., None] * bre - f_im[..., None] * bim
    bb_im = f_re[..., None] * bim + f_im[..., None] * bre

    def combine(e_i, e_j):
        ai_r, ai_i, bi_r, bi_i = e_i
        aj_r, aj_i, bj_r, bj_i = e_j
        return (aj_r * ai_r - aj_i * ai_i,
                aj_r * ai_i + aj_i * ai_r,
                aj_r * bi_r - aj_i * bi_i + bj_r,
                aj_r * bi_i + aj_i * bi_r + bj_i)

    def scan_dir(dirn, reverse):
        bu_r = jnp.einsum('blgn,gpn->blgp', uf, bb_re[dirn])
        bu_i = jnp.einsum('blgn,gpn->blgp', uf, bb_im[dirn])
        shape = (1, L, S5_GROUPS, S5_STATE)
        a_r = jnp.broadcast_to(ab_re[dirn][None, None], shape)
        a_i = jnp.broadcast_to(ab_im[dirn][None, None], shape)
        _, _, h_r, h_i = lax.associative_scan(combine, (a_r, a_i, bu_r, bu_i), reverse=reverse, axis=1)
        return (jnp.einsum('gnp,blgp->blgn', c_re[dirn].astype(f32), h_r)
                - jnp.einsum('gnp,blgp->blgn', c_im[dirn].astype(f32), h_i))

    y = scan_dir(0, False) + scan_dir(1, True)
    y = y.reshape(Bsz, L, W) + d_skip.astype(f32) * u.astype(f32)
    y = jax.nn.gelu(y).astype(u.dtype)
    z = y @ glu_w + glu_b
    return z[..., :W] * jax.nn.sigmoid(z[..., W:])


def _retention(q, k, v, g, cos, sin):
    f32 = jnp.float32
    Bsz, L, H, dh = q.shape
    C = RET_CHUNK
    n = L // C
    dtp = q.dtype
    q = _rotate(q, cos, sin)
    k = _rotate(k, cos, sin) * (dh ** -0.5)

    def chunks(t):
        return t.reshape(Bsz, n, C, H, dh).transpose(0, 3, 1, 2, 4)

    qc, kc, vc = chunks(q), chunks(k), chunks(v)
    hidx = jnp.arange(H, dtype=f32)
    log_gf = jnp.log1p(-jnp.exp2(-5.0 - hidx))
    log_gb = jnp.log1p(-jnp.exp2(-5.5 - hidx))
    j = jnp.arange(C, dtype=f32)
    rel = j[:, None] - j[None, :]
    dmask = jnp.exp(jnp.where(rel >= 0, log_gf[:, None, None], log_gb[:, None, None]) * jnp.abs(rel))
    s = jnp.einsum('bhncd,bhnjd->bhncj', qc, kc) * dmask[None, :, None].astype(dtp)
    y = jnp.einsum('bhncj,bhnje->bhnce', s, vc)
    wf = jnp.exp(log_gf[:, None] * (C - 1.0 - j)).astype(dtp)
    wb = jnp.exp(log_gb[:, None] * j).astype(dtp)
    kv_f = jnp.einsum('bhnjd,hj,bhnje->nbhde', kc, wf, vc)
    kv_b = jnp.einsum('bhnjd,hj,bhnje->nbhde', kc, wb, vc)
    df = jnp.exp(log_gf * C).astype(dtp)[None, :, None, None]
    db = jnp.exp(log_gb * C).astype(dtp)[None, :, None, None]
    zero = jnp.zeros((Bsz, H, dh, dh), dtp)
    _, r_f = lax.scan(lambda st, kv: (df * st + kv, st), zero, kv_f)
    _, r_b = lax.scan(lambda st, kv: (db * st + kv, st), zero, kv_b, reverse=True)
    inter_f = jnp.einsum('bhncd,nbhde->bhnce', qc, r_f) * jnp.exp(log_gf[:, None] * (j + 1.0)).astype(dtp)[None, :, None, :, None]
    inter_b = jnp.einsum('bhncd,nbhde->bhnce', qc, r_b) * jnp.exp(log_gb[:, None] * (C - j)).astype(dtp)[None, :, None, :, None]
    y = (y + inter_f + inter_b).transpose(0, 2, 3, 1, 4).reshape(Bsz, L, H, dh)
    y = _layer_norm(y)
    return (jax.nn.silu(g) * y).reshape(Bsz, L, H * dh)


def _clamped_swiglu(z):
    z_glu = jnp.minimum(z[..., ::2], SWIGLU_LIMIT)
    z_lin = jnp.clip(z[..., 1::2], -SWIGLU_LIMIT, SWIGLU_LIMIT)
    return z_glu * jax.nn.sigmoid(SWIGLU_ALPHA * z_glu) * (z_lin + 1.0)


def _moe(h, router_w, router_b, w1, b1, w2, b2):
    Bsz, L, D = h.shape
    T = Bsz * L
    hf = h.reshape(T, D)
    logits = (hf @ router_w + router_b).astype(jnp.float32)
    top_val, top_idx = lax.top_k(logits, TOP_K)
    gates = jax.nn.softmax(top_val, axis=-1)
    n_assign = T * TOP_K
    n_blocks = n_assign // EXPERT_BLOCK + N_EXPERTS
    e_flat = top_idx.reshape(-1).astype(jnp.int32)
    tok_flat = jnp.arange(n_assign, dtype=jnp.int32) // TOP_K
    order = jnp.argsort(e_flat)
    e_sorted = e_flat[order]
    counts = jnp.zeros((N_EXPERTS,), jnp.int32).at[e_flat].add(1)
    start = jnp.cumsum(counts) - counts
    padded = (counts + EXPERT_BLOCK - 1) // EXPERT_BLOCK * EXPERT_BLOCK
    pend = jnp.cumsum(padded)
    pstart = pend - padded
    dest = pstart[e_sorted] + jnp.arange(n_assign, dtype=jnp.int32) - start[e_sorted]
    n_slots = n_blocks * EXPERT_BLOCK
    slot_tok = jnp.zeros((n_slots,), jnp.int32).at[dest].set(tok_flat[order])
    slot_gate = jnp.zeros((n_slots,), jnp.float32).at[dest].set(gates.reshape(-1)[order])
    block_e = jnp.minimum(jnp.searchsorted(pend, jnp.arange(n_blocks, dtype=jnp.int32) * EXPERT_BLOCK, side='right'),
                          N_EXPERTS - 1).astype(jnp.int32)

    def expert_block(args):
        tok, e = args
        z = hf[tok] @ w1[e] + b1[e]
        return _clamped_swiglu(z) @ w2[e] + b2[e]

    ys = lax.map(expert_block, (slot_tok.reshape(n_blocks, EXPERT_BLOCK), block_e))
    ys = ys.reshape(n_slots, D) * slot_gate[:, None].astype(h.dtype)
    return jax.ops.segment_sum(ys, slot_tok, num_segments=T).reshape(Bsz, L, D)


def setup_inputs(seed: int = 0) -> dict:
    key = jax.random.key(seed)
    ks = jax.random.split(key, 32)
    f32 = jnp.float32

    def nrm(k, shape, s):
        return jax.random.normal(k, shape, f32) * s

    G, P, N = S5_GROUPS, S5_STATE, S5_GROUP
    E, F, D = N_EXPERTS, EXPERT_FF, D_MODEL
    va0 = 2 * DIFF_QK
    vc0 = 2 * DIFF_QK + DIFF_WIDTH + S5_WIDTH + 2 * RET_WIDTH
    col_scale = jnp.ones((IN_WIDTH,), f32).at[va0:va0 + DIFF_WIDTH].set(DEEPNORM_BETA).at[vc0:vc0 + RET_WIDTH].set(DEEPNORM_BETA)
    log_lo, log_hi = math.log(S5_DT_MIN), math.log(S5_DT_MAX)
    return {
        'x': nrm(ks[0], (BATCH, SEQ, D), 1.0),
        'c': nrm(ks[1], (BATCH, D), 1.0),
        'positions': jnp.tile(jnp.arange(SEQ, dtype=jnp.int32)[None, :], (BATCH, 1)),
        'ada_w': nrm(ks[2], (DEPTH, D, 6 * D), 0.1 * D ** -0.5),
        'ada_b': nrm(ks[3], (DEPTH, 6 * D), 0.01),
        'w_in': nrm(ks[4], (DEPTH, D, IN_WIDTH), D ** -0.5) * col_scale,
        'w_out': nrm(ks[5], (DEPTH, MIX_WIDTH, D), MIX_WIDTH ** -0.5 * DEEPNORM_BETA),
        'diff_lambda_q1': nrm(ks[6], (DEPTH, DIFF_HEAD_DIM), 0.1),
        'diff_lambda_k1': nrm(ks[7], (DEPTH, DIFF_HEAD_DIM), 0.1),
        'diff_lambda_q2': nrm(ks[8], (DEPTH, DIFF_HEAD_DIM), 0.1),
        'diff_lambda_k2': nrm(ks[9], (DEPTH, DIFF_HEAD_DIM), 0.1),
        'diff_subln_g': 1.0 + nrm(ks[10], (DEPTH, DIFF_V_DIM), 0.02),
        's5_lambda_re': -0.5 + nrm(ks[11], (DEPTH, 2, G, P), 0.01),
        's5_lambda_im': math.pi * jnp.arange(P, dtype=f32) + nrm(ks[12], (DEPTH, 2, G, P), 0.01),
        's5_log_step': log_lo + jax.random.uniform(ks[13], (DEPTH, 2, G), f32) * (log_hi - log_lo),
        's5_b_re': nrm(ks[14], (DEPTH, 2, G, P, N), (2 * N) ** -0.5),
        's5_b_im': nrm(ks[15], (DEPTH, 2, G, P, N), (2 * N) ** -0.5),
        's5_c_re': nrm(ks[16], (DEPTH, 2, G, N, P), (2 * P) ** -0.5),
        's5_c_im': nrm(ks[17], (DEPTH, 2, G, N, P), (2 * P) ** -0.5),
        's5_d': nrm(ks[18], (DEPTH, S5_WIDTH), 1.0),
        's5_glu_w': nrm(ks[19], (DEPTH, S5_WIDTH, 2 * S5_WIDTH), S5_WIDTH ** -0.5),
        's5_glu_b': nrm(ks[20], (DEPTH, 2 * S5_WIDTH), 0.01),
        'ln_g': 1.0 + nrm(ks[21], (DEPTH, 2, D), 0.02),
        'ln_b': nrm(ks[22], (DEPTH, 2, D), 0.02),
        'router_w': nrm(ks[23], (DEPTH, D, E), D ** -0.5),
        'router_b': nrm(ks[24], (DEPTH, E), 0.01),
        'exp_w1': nrm(ks[25], (DEPTH, E, D, 2 * F), D ** -0.5),
        'exp_b1': nrm(ks[26], (DEPTH, E, 2 * F), 0.01),
        'exp_w2': nrm(ks[27], (DEPTH, E, F, D), F ** -0.5 * DEEPNORM_BETA),
        'exp_b2': nrm(ks[28], (DEPTH, E, D), 0.01),
    }


def reference(x, c, positions, ada_w, ada_b, w_in, w_out, diff_lambda_q1, diff_lambda_k1, diff_lambda_q2,
              diff_lambda_k2, diff_subln_g, s5_lambda_re, s5_lambda_im, s5_log_step, s5_b_re, s5_b_im, s5_c_re,
              s5_c_im, s5_d, s5_glu_w, s5_glu_b, ln_g, ln_b, router_w, router_b, exp_w1, exp_b1, exp_w2, exp_b2):
    f32 = jnp.float32
    Bsz, L, _ = x.shape
    inv_freq_a = 1.0 / (ROPE_THETA ** (jnp.arange(0, DIFF_HEAD_DIM, 2, dtype=f32) / DIFF_HEAD_DIM))
    cos_a, sin_a = _rotary_tables(positions, inv_freq_a)
    inv_freq_r = 1.0 / (ROPE_THETA ** jnp.linspace(0.0, 1.0, RET_HEAD_DIM // 2, dtype=f32))
    cos_r, sin_r = _rotary_tables(positions, inv_freq_r)
    cond = jax.nn.silu(c)
    rs = (Bsz, L, RET_HEADS, RET_HEAD_DIM)
    for l in range(DEPTH):
        mod = cond @ ada_w[l] + ada_b[l]
        sh1, sc1, g1, sh2, sc2, g2 = jnp.split(mod[:, None, :], 6, axis=-1)
        h = _layer_norm(x) * (1.0 + sc1) + sh1
        qa, ka, va, ub, qr, kr, vr, gr = _split_projection(h @ w_in[l])
        qa = _rotate(qa.reshape(Bsz, L, 2 * DIFF_HEADS, DIFF_HEAD_DIM), cos_a, sin_a).reshape(Bsz, L, DIFF_HEADS, 2, DIFF_HEAD_DIM)
        ka = _rotate(ka.reshape(Bsz, L, 2 * DIFF_HEADS, DIFF_HEAD_DIM), cos_a, sin_a).reshape(Bsz, L, DIFF_HEADS, 2, DIFF_HEAD_DIM)
        va = va.reshape(Bsz, L, DIFF_HEADS, DIFF_V_DIM)
        lam_init = 0.8 - 0.6 * math.exp(-0.3 * l)
        lam = (jnp.exp(jnp.sum(diff_lambda_q1[l].astype(f32) * diff_lambda_k1[l].astype(f32)))
               - jnp.exp(jnp.sum(diff_lambda_q2[l].astype(f32) * diff_lambda_k2[l].astype(f32))) + lam_init)
        ya = _diff_attention(qa, ka, va, lam, diff_subln_g[l], lam_init)
        yb = _s5_mixer(ub, s5_lambda_re[l], s5_lambda_im[l], s5_log_step[l], s5_b_re[l], s5_b_im[l],
                       s5_c_re[l], s5_c_im[l], s5_d[l], s5_glu_w[l], s5_glu_b[l])
        yc = _retention(qr.reshape(rs), kr.reshape(rs), vr.reshape(rs), gr.reshape(rs), cos_r, sin_r)
        mix = jnp.concatenate([ya, yb, yc], axis=-1) @ w_out[l]
        x = _layer_norm(DEEPNORM_ALPHA * x + (1.0 + g1) * mix, ln_g[l, 0], ln_b[l, 0])
        h = _layer_norm(x) * (1.0 + sc2) + sh2
        ff = _moe(h, router_w[l], router_b[l], exp_w1[l], exp_b1[l], exp_w2[l], exp_b2[l])
        x = _layer_norm(DEEPNORM_ALPHA * x + (1.0 + g2) * ff, ln_g[l, 1], ln_b[l, 1])
    return x
```

```cpp
#include <hip/hip_runtime.h>
#include <cstdio>
#include <cstdint>
#include <cmath>

#define LAS __attribute__((address_space(3)))
#define GAS __attribute__((address_space(1)))
typedef unsigned short bf16;
typedef short bf16x8 __attribute__((ext_vector_type(8)));
typedef short s16x4 __attribute__((ext_vector_type(4)));
typedef float f32x4 __attribute__((ext_vector_type(4)));
typedef float f32x2 __attribute__((ext_vector_type(2)));
typedef float f32x16 __attribute__((ext_vector_type(16)));
typedef unsigned u32x4 __attribute__((ext_vector_type(4)));
typedef unsigned u32x2 __attribute__((ext_vector_type(2)));
typedef __bf16 bf16x2_t __attribute__((ext_vector_type(2)));

#ifndef MK_SPLIT
#define MK_SPLIT 0
#endif

constexpr int NB = 4, SEQ = 8192, DM = 1024, T = NB * SEQ, DEPTH = 4;
constexpr int INW = 2816, NE = 32;
constexpr int NTILE_MAX = T * 4 / 256 + NE;
constexpr float LN_EPS = 1e-5f;
constexpr float C2 = 0.125f * 1.4426950408889634f;
constexpr float LOG2E = 1.4426950408889634f;
constexpr float DN_ALPHA = 1.681792830507429f;

constexpr size_t MiB = 1u << 20;
constexpr size_t WS_CTL = 0, CTL_BYTES = 65536;
constexpr size_t WS_MOD = 1 * MiB;
constexpr size_t WS_ROT = 2 * MiB;
constexpr size_t WS_PW = 18 * MiB;
constexpr size_t WS_BB = 23 * MiB;
constexpr size_t WS_WIN = 24 * MiB;
constexpr size_t WS_WOUT = 46 * MiB;
constexpr size_t WS_GLU = 54 * MiB;
constexpr size_t WS_W1S = 56 * MiB;
constexpr size_t WS_TW = 88 * MiB;
constexpr size_t WS_W1 = 248 * MiB;
constexpr size_t WS_W2 = 760 * MiB;
constexpr size_t WS_HB = 1016 * MiB;
constexpr size_t WS_QIMG = 1080 * MiB;
constexpr size_t WS_KIMG = 1112 * MiB;
constexpr size_t WS_VIMG = 1144 * MiB;
constexpr size_t WS_UG2 = 1176 * MiB;
constexpr size_t WS_RET = 1196 * MiB;
constexpr size_t WS_S5S = 1260 * MiB;
constexpr size_t WS_YB = 1268 * MiB;
constexpr size_t WS_RKV = 1284 * MiB;
constexpr size_t WS_RST = 1316 * MiB;
constexpr size_t WS_MIX = 1332 * MiB;
constexpr size_t WS_YPRE = 1396 * MiB;
constexpr size_t WS_X1 = 1524 * MiB;
constexpr size_t WS_XB = 1652 * MiB;
constexpr size_t WS_LIST = 1780 * MiB;
constexpr size_t WS_TOKI = 1784 * MiB;
constexpr size_t WS_GATE = 1785 * MiB;
constexpr size_t WS_A2 = 1786 * MiB;
constexpr size_t WS_YS = 2058 * MiB;
constexpr size_t WS_END = 2330 * MiB;

constexpr int CW_TMO = 0, CW_BAR = 1024, CW_GCNT = 8192;

constexpr int RING_BYTES = 131072;
constexpr int LDSCTL_OFF = RING_BYTES, MISC_OFF = LDSCTL_OFF + 320, TAB_OFF = LDSCTL_OFF + 512;
constexpr int LDS_BYTES = 147456;
constexpr int NWAVES = 8, NTHR = 512;

#define RLX_AGENT __ATOMIC_RELAXED, __HIP_MEMORY_SCOPE_AGENT
__device__ __forceinline__ unsigned pk2(float lo, float hi) { f32x2 v = {lo, hi}; bf16x2_t b = __builtin_convertvector(v, bf16x2_t); return __builtin_bit_cast(unsigned, b); }
__device__ __forceinline__ float bf2f(unsigned short u) { return __uint_as_float(((unsigned)u) << 16); }
__device__ __forceinline__ float bflo(unsigned u) { return __uint_as_float(u << 16); }
__device__ __forceinline__ float bfhi(unsigned u) { return __uint_as_float(u & 0xffff0000u); }
__device__ __forceinline__ float wave_sum(float v) {
#pragma unroll
    for (int o = 1; o < 64; o <<= 1) v += __shfl_xor(v, o);
    return v;
}
__device__ __forceinline__ float half_sum(float v) {
#pragma unroll
    for (int o = 1; o < 32; o <<= 1) v += __shfl_xor(v, o);
    return v;
}
__device__ __forceinline__ float fexp2(float x) { return __builtin_amdgcn_exp2f(x); }
__device__ __forceinline__ float frcp(float x) { return __builtin_amdgcn_rcpf(x); }
__device__ __forceinline__ float sigmoidf_(float x) { return frcp(1.0f + fexp2(-x * LOG2E)); }
__device__ __forceinline__ int otid() { int t = threadIdx.x; asm volatile("" : "+v"(t)); return t; }
__device__ __forceinline__ int crow(int r, int hi) { return (r & 3) + 8 * (r >> 2) + 4 * hi; }
__device__ __forceinline__ s16x4 vtr(const LAS char* p) { return __builtin_bit_cast(s16x4, __builtin_amdgcn_ds_read_tr16_b64_v4i16((LAS s16x4*)p)); }
__device__ __forceinline__ bf16x8 cat8(s16x4 a, s16x4 b) { return (bf16x8){a[0], a[1], a[2], a[3], b[0], b[1], b[2], b[3]}; }
__device__ __forceinline__ bf16x8 pack8(float a0, float a1, float a2, float a3, float a4, float a5, float a6, float a7) {
    u32x4 w = {pk2(a0, a1), pk2(a2, a3), pk2(a4, a5), pk2(a6, a7)}; return __builtin_bit_cast(bf16x8, w);
}
__device__ __forceinline__ u32x4 pack8u(f32x4 a, f32x4 b) { return (u32x4){pk2(a[0], a[1]), pk2(a[2], a[3]), pk2(b[0], b[1]), pk2(b[2], b[3])}; }

#define XB_TMO      128
#define XB_XCNT(j)  (256  + 64 * (j))
#define XB_XSUB(j)  (1280 + 64 * (j))
#define XB_XGEN(j)  (2304 + 64 * (j))
#define XB_TOP      3328
#define XB_TOPGEN   3392
#define XCD_BAR_WORDS 3456
#define XB_SPIN_CAP (1u << 22)
__device__ __forceinline__ unsigned xb_ld(unsigned* p)              { return __hip_atomic_load(p, __ATOMIC_RELAXED, __HIP_MEMORY_SCOPE_AGENT); }
__device__ __forceinline__ unsigned xb_add(unsigned* p, unsigned v) { return __hip_atomic_fetch_add(p, v, __ATOMIC_RELAXED, __HIP_MEMORY_SCOPE_AGENT); }
__device__ __forceinline__ unsigned xb_xcc_id() { return (unsigned)__builtin_amdgcn_s_getreg((3 << 11) | 20) & 0xFu; }
#define XB_SPIN(cond, bar) do { unsigned _sp = 0; while (cond) { __builtin_amdgcn_s_sleep(1); \
    if ((++_sp & 255u) == 0u) { if (xb_ld(&(bar)[XB_TMO])) break; if (_sp > XB_SPIN_CAP) { atomicAdd(&(bar)[XB_TMO], 1u); break; } } } } while (0)
struct XcdBarrier { unsigned* bar; unsigned x; volatile LAS unsigned* st; };
__device__ __forceinline__ XcdBarrier xcd_barrier_post(unsigned* bar, volatile LAS unsigned* st) {
    XcdBarrier b; b.bar = bar; b.x = xb_xcc_id(); b.st = st;
    if (threadIdx.x == 0) (void)xb_add(&bar[XB_XCNT(b.x)], 1u);
    return b;
}
__device__ __forceinline__ void xcd_barrier_complete(unsigned* bar, unsigned x, unsigned& nloc, unsigned& nx) {
    const unsigned G = gridDim.x * gridDim.y * gridDim.z;
    unsigned sum, cnt, mine, sp = 0u;
    for (;;) {
        sum = 0u; cnt = 0u; mine = 0u;
#pragma unroll
        for (unsigned j = 0; j < 16; ++j) { const unsigned c = xb_ld(&bar[XB_XCNT(j)]); sum += c; cnt += (c > 0u) ? 1u : 0u; mine = (j == x) ? c : mine; }
        if (sum == G) break;
        __builtin_amdgcn_s_sleep(1);
        if ((++sp & 255u) == 0u) { if (xb_ld(&bar[XB_TMO])) break; if (sp > XB_SPIN_CAP) { atomicAdd(&bar[XB_TMO], 1u); break; } }
    }
    nloc = mine > 0u ? mine : 1u; nx = cnt > 0u ? cnt : 1u;
}
__device__ __forceinline__ void xcd_barrier(const XcdBarrier& b) {
    asm volatile("s_waitcnt vmcnt(0)" ::: "memory");
    __syncthreads();
    if (threadIdx.x == 0) {
        unsigned* bar = b.bar;
        __builtin_amdgcn_s_waitcnt(0);
        unsigned nloc = b.st[0], nx = b.st[1];
        if (nloc == 0u) { xcd_barrier_complete(bar, b.x, nloc, nx); b.st[0] = nloc; b.st[1] = nx; }
        const unsigned old = xb_add(&bar[XB_XSUB(b.x)], 1u);
        const unsigned gen = old / nloc;
        if (old + 1u == (gen + 1u) * nloc) {
            __builtin_amdgcn_fence(__ATOMIC_RELEASE, "agent");
            asm volatile("s_waitcnt vmcnt(0)" ::: "memory");
            const unsigned og = xb_add(&bar[XB_TOP], 1u);
            const unsigned tg = og / nx;
            if (og + 1u == (tg + 1u) * nx) xb_add(&bar[XB_TOPGEN], 1u);
            else XB_SPIN(xb_ld(&bar[XB_TOPGEN]) == tg, bar);
            __builtin_amdgcn_fence(__ATOMIC_ACQUIRE, "agent");
            xb_add(&bar[XB_XGEN(b.x)], 1u);
            asm volatile("s_waitcnt vmcnt(0)" ::: "memory");
        } else {
            XB_SPIN(xb_ld(&bar[XB_XGEN(b.x)]) == gen, bar);
            __builtin_amdgcn_fence(__ATOMIC_ACQUIRE, "agent");
            asm volatile("s_waitcnt vmcnt(0)" ::: "memory");
        }
    }
    __syncthreads();
}

namespace pg8 {
constexpr int BM = 256, BK = 64, HALF = 128, HTB = HALF * BK * 2, STAGE_BYTES = 8 * HTB, NXCD = 8, WGM = 8;
__device__ __forceinline__ int lds_byte(int r, int c) { const int st = (r >> 4) * 2 + (c >> 5), rr = r & 15, cc = c & 31, ob = rr * 64 + cc * 2; return st * 1024 + (ob ^ (((ob >> 9) & 1) << 5)); }
__device__ __forceinline__ void stage_rc(int b, int& R, int& C) { const int st = b / 1024, sb = b % 1024, swz = sb ^ (((sb >> 9) & 1) << 5); R = (st >> 1) * 16 + swz / 64; C = (st & 1) * 32 + (swz % 64) / 2; }
__device__ __forceinline__ int perm32(int rho) { const int n = rho >> 4, i = rho & 15; return 8 * (i >> 2) + 4 * n + (i & 3); }
struct Unit { int pm, pn, g; };

__device__ __forceinline__ bool static_order(int i, int G, int c, int nM, int nN, int& pm, int& pn) {
    const int nwg = nM * nN; const long L = (long)i * G + c; if (L >= nwg) return false;
    int wgid = (int)L; { const int q = nwg / NXCD, r = nwg % NXCD, xcd = wgid % NXCD, off = wgid / NXCD; wgid = (xcd < r ? xcd * (q + 1) : r * (q + 1) + (xcd - r) * q) + off; }
    const int nig = WGM * nN, gid = wgid / nig, fm = gid * WGM, gsz = (nM - fm) < WGM ? (nM - fm) : WGM;
    pm = fm + ((wgid % nig) % gsz); pn = (wgid % nig) / gsz; return true;
}

template <class Epi, class Sched, bool GATHER>
__device__ __forceinline__ void gemm_phase(LAS unsigned char* lds, const int K, const int lda, const int ldb, const Sched& S, const Epi& E) {
    const int tid = otid(), wid = __builtin_amdgcn_readfirstlane(tid >> 6), lane = tid & 63, wr = wid >> 2, wc = wid & 3, fr = lane & 15, fq = lane >> 4;
    const int nt = K / BK;
    int Rr[2], Cc[2];
    unsigned voffB[2], vAc[2][2];
#pragma unroll
    for (int i = 0; i < 2; ++i) { int R, C; stage_rc(tid * 16 + i * 8192, R, C); Rr[i] = R; Cc[i] = C; const int Rb = (R & ~31) + perm32(R & 31);
        voffB[i] = (unsigned)(Rb * ldb + C) * 2u;
#pragma unroll
        for (int h = 0; h < 2; ++h) vAc[h][i] = (unsigned)((GATHER ? 0 : R) * lda + C) * 2u; }
    const size_t kstep = (size_t)(BK * 2);
    const size_t hstepB = (size_t)HALF * ldb * 2;
    const size_t hstepA = GATHER ? (size_t)0 : (size_t)HALF * lda * 2;
    const unsigned ldsw = (unsigned)wid * 1024u;
    const int aoff = lds_byte(wr * 64 + fr, fq * 8), boff = lds_byte(wc * 32 + fr, fq * 8);
    LAS int* rowtab = (LAS int*)(lds + TAB_OFF + 2048);
#define PG8_SA(b, h) (((b) * 2 + (h)) * HTB)
#define PG8_SB(b, h) ((4 + (b) * 2 + (h)) * HTB)
#define PG8_STAGE(bufoff, gbase, v0, v1) do { \
        __builtin_amdgcn_global_load_lds((const unsigned*)((const char*)(gbase) + (v0)), (LAS unsigned*)(lds + (bufoff) + ldsw), 16, 0, 0); \
        __builtin_amdgcn_global_load_lds((const unsigned*)((const char*)(gbase) + (v1)), (LAS unsigned*)(lds + (bufoff) + ldsw + 8192), 16, 0, 0); } while (0)
#define PG8_STAGEB(bufoff, gbase) PG8_STAGE(bufoff, gbase, voffB[0], voffB[1])
#define PG8_LDA(dst, b, h) do { _Pragma("unroll") for (int m = 0; m < 4; ++m) _Pragma("unroll") for (int k = 0; k < 2; ++k) dst[m][k] = *(const LAS bf16x8*)(lds + PG8_SA(b, h) + aoff + m * 2048 + k * 1024); } while (0)
#define PG8_LDB(dst, b, h) do { _Pragma("unroll") for (int n = 0; n < 2; ++n) _Pragma("unroll") for (int k = 0; k < 2; ++k) dst[n][k] = *(const LAS bf16x8*)(lds + PG8_SB(b, h) + boff + n * 2048 + k * 1024); } while (0)
#define PG8_MMA(ai, bj, At, Bt) do { __builtin_amdgcn_s_setprio(1); _Pragma("unroll") for (int m = 0; m < 4; ++m) _Pragma("unroll") for (int n = 0; n < 2; ++n) _Pragma("unroll") for (int k = 0; k < 2; ++k) \
        acc[ai][bj][m][n] = __builtin_amdgcn_mfma_f32_16x16x32_bf16(Bt[n][k], At[m][k], acc[ai][bj][m][n], 0, 0, 0); __builtin_amdgcn_s_setprio(0); } while (0)
#define PG8_WAIT_V(n) asm volatile("s_waitcnt vmcnt(" #n ")" ::: "memory")
#define PG8_WAIT_L(n) asm volatile("s_waitcnt lgkmcnt(" #n ")" ::: "memory")
#define PG8_BAR __builtin_amdgcn_s_barrier()
#define PG8_SCHED __builtin_amdgcn_sched_barrier(0)
    Unit cur, nxt; int ui = 0;
    if (!S.next(0, cur)) return;
    f32x4 acc[2][2][4][2];
#pragma unroll
    for (int a = 0; a < 2; ++a)
#pragma unroll
        for (int b = 0; b < 2; ++b)
#pragma unroll
            for (int m = 0; m < 4; ++m)
#pragma unroll
                for (int n = 0; n < 2; ++n) acc[a][b][m][n] = (f32x4){0.f, 0.f, 0.f, 0.f};
    bf16x8 At[4][2], B0[2][2], B1[2][2];
    const char* cA = S.a_base(cur); const char* cB = S.b_base(cur);
    if constexpr (GATHER) {
        if (tid < 256) rowtab[tid] = S.a_row(cur, tid);
        PG8_WAIT_V(0); PG8_WAIT_L(0); PG8_BAR;
#pragma unroll
        for (int h = 0; h < 2; ++h)
#pragma unroll
            for (int i = 0; i < 2; ++i) vAc[h][i] = (unsigned)(rowtab[h * HALF + Rr[i]] * lda + Cc[i]) * 2u;
    }
    PG8_STAGEB(PG8_SB(0, 0), cB); PG8_STAGEB(PG8_SB(0, 1), cB + hstepB); PG8_STAGE(PG8_SA(0, 0), cA, vAc[0][0], vAc[0][1]); PG8_STAGE(PG8_SA(0, 1), cA + hstepA, vAc[1][0], vAc[1][1]);
    if (wr == 1) PG8_BAR;
    PG8_WAIT_V(2); PG8_BAR;
    PG8_STAGEB(PG8_SB(1, 0), cB + kstep); PG8_STAGE(PG8_SA(1, 0), cA + kstep, vAc[0][0], vAc[0][1]); PG8_STAGEB(PG8_SB(1, 1), cB + hstepB + kstep);
    PG8_WAIT_V(6); PG8_BAR;
    for (;;) {
        const bool has_next = S.next(ui + 1, nxt);
        const char* nA = has_next ? S.a_base(nxt) : cA; const char* nB = has_next ? S.b_base(nxt) : cB;
        if constexpr (GATHER) {
            if (tid < 256) rowtab[((ui + 1) & 1) * 256 + tid] = has_next ? S.a_row(nxt, tid) : 0;
            PG8_WAIT_V(0);
        }
#pragma unroll 1
        for (int t = 0; t < nt; t += 2) {
            const bool last = (t == nt - 2);
            const char* a1 = cA + (size_t)(t + 1) * kstep;
            const char* a2 = last ? nA : cA + (size_t)(t + 2) * kstep; const char* b2 = last ? nB : cB + (size_t)(t + 2) * kstep;
            const char* a3 = a2 + kstep; const char* b3 = b2 + kstep;
            unsigned v2[2][2];
#pragma unroll
            for (int h = 0; h < 2; ++h)
#pragma unroll
                for (int i = 0; i < 2; ++i) v2[h][i] = vAc[h][i];
            if constexpr (GATHER) { if (last && has_next) {
#pragma unroll
                for (int h = 0; h < 2; ++h)
#pragma unroll
                    for (int i = 0; i < 2; ++i) v2[h][i] = (unsigned)(rowtab[((ui + 1) & 1) * 256 + h * HALF + Rr[i]] * lda + Cc[i]) * 2u; } }
            PG8_LDB(B0, 0, 0); PG8_LDB(B1, 0, 1); PG8_SCHED; PG8_LDA(At, 0, 0); PG8_STAGE(PG8_SA(1, 1), a1 + hstepA, vAc[1][0], vAc[1][1]);
            PG8_WAIT_V(8); PG8_WAIT_L(0); PG8_BAR; PG8_MMA(0, 0, At, B0); PG8_MMA(0, 1, At, B1); PG8_BAR; PG8_SCHED;
            PG8_LDA(At, 0, 1); PG8_STAGEB(PG8_SB(0, 0), b2); PG8_STAGEB(PG8_SB(0, 1), b2 + hstepB); PG8_STAGE(PG8_SA(0, 0), a2, v2[0][0], v2[0][1]);
            PG8_WAIT_V(8); PG8_WAIT_L(0); PG8_BAR; PG8_MMA(1, 0, At, B0); PG8_MMA(1, 1, At, B1); PG8_BAR; PG8_SCHED;
            PG8_LDB(B0, 1, 0); PG8_LDB(B1, 1, 1); PG8_SCHED; PG8_LDA(At, 1, 0); PG8_STAGE(PG8_SA(0, 1), a2 + hstepA, v2[1][0], v2[1][1]);
            PG8_WAIT_V(8); PG8_WAIT_L(0); PG8_BAR; PG8_MMA(0, 0, At, B0); PG8_MMA(0, 1, At, B1); PG8_BAR; PG8_SCHED;
            PG8_LDA(At, 1, 1); PG8_STAGEB(PG8_SB(1, 0), b3); PG8_STAGEB(PG8_SB(1, 1), b3 + hstepB); PG8_STAGE(PG8_SA(1, 0), a3, v2[0][0], v2[0][1]);
            PG8_WAIT_V(8); PG8_WAIT_L(0); PG8_BAR; PG8_MMA(1, 0, At, B0); PG8_MMA(1, 1, At, B1); PG8_BAR; PG8_SCHED;
        }
        if (wr == 0) PG8_BAR;
        { int efr = fr, efq = fq; asm volatile("" : "+v"(efr), "+v"(efq)); E(acc, cur, wr, wc, efr, efq); }
        if (!has_next) break;
#pragma unroll
        for (int a = 0; a < 2; ++a)
#pragma unroll
            for (int b = 0; b < 2; ++b)
#pragma unroll
                for (int m = 0; m < 4; ++m)
#pragma unroll
                    for (int n = 0; n < 2; ++n) acc[a][b][m][n] = (f32x4){0.f, 0.f, 0.f, 0.f};
        cur = nxt; cA = nA; cB = nB; ++ui;
        if constexpr (GATHER) {
#pragma unroll
            for (int h = 0; h < 2; ++h)
#pragma unroll
                for (int i = 0; i < 2; ++i) vAc[h][i] = (unsigned)(rowtab[(ui & 1) * 256 + h * HALF + Rr[i]] * lda + Cc[i]) * 2u;
        }
        if (wr == 1) PG8_BAR;
    }
    PG8_WAIT_V(0);
    PG8_BAR;
#undef PG8_SA
#undef PG8_SB
#undef PG8_STAGE
#undef PG8_STAGEB
#undef PG8_LDA
#undef PG8_LDB
#undef PG8_MMA
#undef PG8_WAIT_V
#undef PG8_WAIT_L
#undef PG8_BAR
#undef PG8_SCHED
}
}
using pg8::Unit;

struct DenseSched {
    int nM, nN, G, c; const char* A; const char* Bt; size_t atile, btile;
    __device__ __forceinline__ bool next(int i, Unit& u) const { u.g = 0; return pg8::static_order(i, G, c, nM, nN, u.pm, u.pn); }
    __device__ __forceinline__ const char* a_base(const Unit& u) const { return A + (size_t)u.pm * atile; }
    __device__ __forceinline__ const char* b_base(const Unit& u) const { return Bt + (size_t)u.pn * btile; }
    __device__ __forceinline__ int a_row(const Unit&, int) const { return 0; }
};
struct GroupSched {
    int nN, G, c; const char* A; const char* Bt; size_t agroup, bgroup, atile, btile;
    __device__ __forceinline__ bool next(int i, Unit& u) const { const long L = (long)i * G + c; if (c < 0 || L >= 16 * 2 * nN) return false; const int per = 2 * nN; u.g = (int)L / per; const int r = (int)L % per; u.pm = r % 2; u.pn = r / 2; return true; }
    __device__ __forceinline__ const char* a_base(const Unit& u) const { return A + (size_t)u.g * agroup + (size_t)u.pm * atile; }
    __device__ __forceinline__ const char* b_base(const Unit& u) const { return Bt + (size_t)u.g * bgroup + (size_t)u.pn * btile; }
    __device__ __forceinline__ int a_row(const Unit&, int) const { return 0; }
};
struct MoeSched {
    int nM, nN, G, c; const char* A; const char* W; size_t wexp, atile, btile;
    const LAS int* cnt; const LAS int* tstart; const LAS unsigned char* tile_e; const int* list;
    __device__ __forceinline__ bool next(int i, Unit& u) const { const bool ok = pg8::static_order(i, G, c, nM, nN, u.pm, u.pn); u.g = ok ? (int)tile_e[u.pm] : 0; return ok; }
    __device__ __forceinline__ const char* a_base(const Unit& u) const { return A + (size_t)u.pm * atile; }
    __device__ __forceinline__ const char* b_base(const Unit& u) const { return W + (size_t)u.g * wexp + (size_t)u.pn * btile; }
    __device__ __forceinline__ int a_row(const Unit& u, int r) const { const int slot = (u.pm - tstart[u.g]) * 256 + r; return slot < cnt[u.g] ? list[(size_t)u.g * T + slot] : 0; }
};

typedef f32x4 Acc[2][2][4][2];
struct EpiProj {
    bf16 *Qimg, *Kimg, *Vimg, *Ug2, *RET; const float *cosA, *sinA, *cosR, *sinR;
    __device__ __forceinline__ void operator()(const Acc& acc, const Unit& u, int wr, int wc, int fr, int fq) const {
        const int pn = u.pn;
#pragma unroll
        for (int ai = 0; ai < 2; ++ai)
#pragma unroll
            for (int m = 0; m < 4; ++m) {
                const int row = u.pm * 256 + ai * 128 + wr * 64 + m * 16 + fr; const int b = row >> 13, t = row & 8191;
                if (pn < 4 || pn == 7 || pn == 8) {
                    const size_t to = (size_t)row * 32 + 8 * fq;
                    const float* ct = (pn < 4 ? cosA : cosR) + to; const float* st = (pn < 4 ? sinA : sinR) + to;
                    const f32x4 c0 = *(const f32x4*)ct, c1 = *(const f32x4*)(ct + 4), s0 = *(const f32x4*)st, s1 = *(const f32x4*)(st + 4);
                    const f32x4 xa0 = acc[ai][0][m][0], xa1 = acc[ai][0][m][1], xb0 = acc[ai][1][m][0], xb1 = acc[ai][1][m][1];
                    const float sc = (pn < 2) ? C2 : (pn == 8 ? 0.125f : 1.0f);
                    const f32x4 o10 = (xa0 * c0 - xb0 * s0) * sc, o11 = (xa1 * c1 - xb1 * s1) * sc, o20 = (xb0 * c0 + xa0 * s0) * sc, o21 = (xb1 * c1 + xa1 * s1) * sc;
                    const u32x4 w1 = pack8u(o10, o11), w2 = pack8u(o20, o21);
                    if (pn < 2) { const int hc = 4 * pn + wc; bf16* p = Qimg + ((size_t)(b * 8 + hc) * 8192 + t) * 64 + 8 * fq; *(u32x4*)p = w1; *(u32x4*)(p + 32) = w2; }
                    else if (pn < 4) { const int hc = 4 * (pn - 2) + wc; bf16* p = Kimg + ((size_t)((b * 8 + hc) * 128 + (t >> 6)) * 8 + fq) * 512 + (t & 63) * 8; *(u32x4*)p = w1; *(u32x4*)(p + 4 * 512) = w2; }
                    else { bf16* p = RET + (size_t)row * 1024 + (pn - 7) * 256 + 64 * wc + 8 * fq; *(u32x4*)p = w1; *(u32x4*)(p + 32) = w2; }
                } else {
#pragma unroll
                    for (int bj = 0; bj < 2; ++bj) {
                        const u32x4 w = pack8u(acc[ai][bj][m][0], acc[ai][bj][m][1]);
                        bf16* p;
                        if (pn < 6) { const int h = 2 * (pn - 4) + bj; p = Vimg + ((size_t)((b * 4 + h) * 128 + (t >> 6)) * 4 + wc) * 2048 + (t & 63) * 32 + 8 * fq; }
                        else if (pn == 6) { const int g = 8 * bj + 2 * wc + (fq >> 1); p = Ug2 + ((size_t)(g * 512 + b * 128 + (t >> 6))) * 1280 + (t & 63) * 16 + 8 * (fq & 1); }
                        else { p = RET + (size_t)row * 1024 + 512 + (pn - 9) * 256 + 128 * bj + 32 * wc + 8 * fq; }
                        *(u32x4*)p = w;
                    }
                }
                asm volatile("" ::: "memory");
            }
    }
};
struct EpiS5S {
    float* S;
    __device__ __forceinline__ void operator()(const Acc& acc, const Unit& u, int wr, int wc, int fr, int fq) const {
#pragma unroll
        for (int ai = 0; ai < 2; ++ai)
#pragma unroll
            for (int m = 0; m < 4; ++m) { float* rowp = S + ((size_t)u.g * 512 + u.pm * 256 + ai * 128 + wr * 64 + m * 16 + fr) * 256 + wc * 32 + 8 * fq;
#pragma unroll
                for (int bj = 0; bj < 2; ++bj) { *(f32x4*)(rowp + bj * 128) = acc[ai][bj][m][0]; *(f32x4*)(rowp + bj * 128 + 4) = acc[ai][bj][m][1]; } }
    }
};
struct EpiS5Y {
    bf16* Yb; const bf16* Ug2; const float* dskip;
    __device__ __forceinline__ void operator()(const Acc& acc, const Unit& u, int wr, int wc, int fr, int fq) const {
#pragma unroll
        for (int ai = 0; ai < 2; ++ai)
#pragma unroll
            for (int m = 0; m < 4; ++m) { const int bc = u.pm * 256 + ai * 128 + wr * 64 + m * 16 + fr;
#pragma unroll
                for (int bj = 0; bj < 2; ++bj) { const int col = u.pn * 256 + bj * 128 + wc * 32 + 8 * fq; const int j = col >> 4, n0 = col & 15;
                    const int tok = bc * 64 + j; const int ch = u.g * 16 + n0;
                    const u32x4 uu = *(const u32x4*)(Ug2 + ((size_t)u.g * 512 + bc) * 1280 + col);
                    const f32x4 d0 = *(const f32x4*)(dskip + ch), d1 = *(const f32x4*)(dskip + ch + 4);
                    float y[8] = {acc[ai][bj][m][0][0] + d0[0] * bflo(uu[0]), acc[ai][bj][m][0][1] + d0[1] * bfhi(uu[0]), acc[ai][bj][m][0][2] + d0[2] * bflo(uu[1]), acc[ai][bj][m][0][3] + d0[3] * bfhi(uu[1]),
                                  acc[ai][bj][m][1][0] + d1[0] * bflo(uu[2]), acc[ai][bj][m][1][1] + d1[1] * bfhi(uu[2]), acc[ai][bj][m][1][2] + d1[2] * bflo(uu[3]), acc[ai][bj][m][1][3] + d1[3] * bfhi(uu[3])};
#pragma unroll
                    for (int e = 0; e < 8; ++e) { const float v = y[e]; const float uarg = 1.5957691216057308f * (v + 0.044715f * v * v * v); y[e] = v * sigmoidf_(uarg); }
                    *(u32x4*)(Yb + (size_t)tok * 256 + ch) = (u32x4){pk2(y[0], y[1]), pk2(y[2], y[3]), pk2(y[4], y[5]), pk2(y[6], y[7])};
                    asm volatile("" ::: "memory");
                } }
    }
};
struct EpiGlu {
    bf16* MIX; const float* bias;
    __device__ __forceinline__ void operator()(const Acc& acc, const Unit& u, int wr, int wc, int fr, int fq) const {
        const int col = u.pn * 128 + wc * 32 + 8 * fq;
#pragma unroll
        for (int ai = 0; ai < 2; ++ai)
#pragma unroll
            for (int m = 0; m < 4; ++m) { const int row = u.pm * 256 + ai * 128 + wr * 64 + m * 16 + fr;
                const f32x4 ba0 = *(const f32x4*)(bias + col), ba1 = *(const f32x4*)(bias + col + 4), bb0 = *(const f32x4*)(bias + 256 + col), bb1 = *(const f32x4*)(bias + 256 + col + 4);
                const f32x4 a0 = acc[ai][0][m][0] + ba0, a1 = acc[ai][0][m][1] + ba1, g0 = acc[ai][1][m][0] + bb0, g1 = acc[ai][1][m][1] + bb1;
                f32x4 o0, o1;
#pragma unroll
                for (int e = 0; e < 4; ++e) { o0[e] = a0[e] * sigmoidf_(g0[e]); o1[e] = a1[e] * sigmoidf_(g1[e]); }
                *(u32x4*)(MIX + (size_t)row * 1024 + 512 + col) = pack8u(o0, o1); asm volatile("" ::: "memory"); }
    }
};
struct EpiOut {
    float* YPRE; const float* x; const float* mod;
    __device__ __forceinline__ void operator()(const Acc& acc, const Unit& u, int wr, int wc, int fr, int fq) const {
#pragma unroll
        for (int ai = 0; ai < 2; ++ai)
#pragma unroll
            for (int m = 0; m < 4; ++m) { const int row = u.pm * 256 + ai * 128 + wr * 64 + m * 16 + fr; const int b = row >> 13;
#pragma unroll
                for (int bj = 0; bj < 2; ++bj) { const int col = u.pn * 256 + bj * 128 + wc * 32 + 8 * fq;
                    const float* gp = mod + (size_t)b * 6144 + 2048 + col; const float* xp = x + (size_t)row * 1024 + col; float* op = YPRE + (size_t)row * 1024 + col;
                    const f32x4 g0 = *(const f32x4*)gp, g1 = *(const f32x4*)(gp + 4), x0 = *(const f32x4*)xp, x1 = *(const f32x4*)(xp + 4);
                    *(f32x4*)op = x0 * DN_ALPHA + (g0 + 1.0f) * acc[ai][bj][m][0]; *(f32x4*)(op + 4) = x1 * DN_ALPHA + (g1 + 1.0f) * acc[ai][bj][m][1]; asm volatile("" ::: "memory"); } }
    }
};
struct EpiMoe1 {
    bf16* A2; const float* b1;
    __device__ __forceinline__ void operator()(const Acc& acc, const Unit& u, int wr, int wc, int fr, int fq) const {
        const int j0 = u.pn * 128 + wc * 32 + 8 * fq;
        const float* bp = b1 + (size_t)u.g * 2048 + 2 * j0;
#pragma unroll
        for (int ai = 0; ai < 2; ++ai)
#pragma unroll
            for (int m = 0; m < 4; ++m) { const size_t slot = (size_t)u.pm * 256 + ai * 128 + wr * 64 + m * 16 + fr;
                const f32x4 q0 = *(const f32x4*)bp, q1 = *(const f32x4*)(bp + 4), q2 = *(const f32x4*)(bp + 8), q3 = *(const f32x4*)(bp + 12);
                const float bg[8] = {q0[0], q0[2], q1[0], q1[2], q2[0], q2[2], q3[0], q3[2]}, bl[8] = {q0[1], q0[3], q1[1], q1[3], q2[1], q2[3], q3[1], q3[3]};
                float o[8];
#pragma unroll
                for (int e = 0; e < 8; ++e) { float zg = acc[ai][0][m][e >> 2][e & 3] + bg[e], zl = acc[ai][1][m][e >> 2][e & 3] + bl[e];
                    zg = fminf(zg, 7.0f); zl = fminf(fmaxf(zl, -7.0f), 7.0f); o[e] = zg * sigmoidf_(1.702f * zg) * (zl + 1.0f); }
                *(u32x4*)(A2 + slot * 1024 + j0) = (u32x4){pk2(o[0], o[1]), pk2(o[2], o[3]), pk2(o[4], o[5]), pk2(o[6], o[7])}; asm volatile("" ::: "memory"); }
    }
};
struct EpiMoe2 {
    bf16* YS; const float* b2;
    __device__ __forceinline__ void operator()(const Acc& acc, const Unit& u, int wr, int wc, int fr, int fq) const {
#pragma unroll
        for (int bj = 0; bj < 2; ++bj) { const int col = u.pn * 256 + bj * 128 + wc * 32 + 8 * fq; const float* bp = b2 + (size_t)u.g * 1024 + col;
            const f32x4 c0 = *(const f32x4*)bp, c1 = *(const f32x4*)(bp + 4);
#pragma unroll
            for (int ai = 0; ai < 2; ++ai)
#pragma unroll
                for (int m = 0; m < 4; ++m) { const size_t slot = (size_t)u.pm * 256 + ai * 128 + wr * 64 + m * 16 + fr;
                    *(u32x4*)(YS + slot * 1024 + col) = pack8u(acc[ai][bj][m][0] + c0, acc[ai][bj][m][1] + c1); } asm volatile("" ::: "memory"); }
    }
};

struct Args {
    const void* in[30]; float* out; unsigned char* ws;
    double invfA[32], invfR[32];
    float lam_init[4];
    float lg2f[4], lg2b[4];
    int ph_lo, ph_hi;
};

template <int PERM>
__device__ __forceinline__ int perm_row(int o) {
    if (PERM == 1) { const int pn = o >> 8; if (pn < 4 || pn == 7 || pn == 8) { const int x = o & 255; return (o & ~255) + 128 * ((x >> 5) & 1) + 32 * (x >> 6) + (x & 31); } return o; }
    if (PERM == 2) return (o >> 8) * 256 + 128 * (o & 1) + ((o >> 1) & 127);
    if (PERM == 3) return 256 * ((o >> 7) & 1) + 128 * (o >> 8) + (o & 127);
    return o;
}
template <int PERM>
__device__ __forceinline__ void transpose_item(const float* W, int K, int N, bf16* WT, LAS float* scr, int item, int lane) {
    const int nblk = N / 32, kb = item / nblk, nb = item % nblk, k0 = 64 * kb, n0 = 32 * nb;
#pragma unroll 8
    for (int i = 0; i < 32; ++i) { const int kk = 2 * i + (lane >> 5); scr[kk * 33 + (lane & 31)] = W[(size_t)(k0 + kk) * N + n0 + (lane & 31)]; }
    asm volatile("s_waitcnt lgkmcnt(0)" ::: "memory");
    const int c = lane & 7;
#pragma unroll
    for (int j = 0; j < 4; ++j) { const int n = (lane >> 3) + 8 * j; const LAS float* s = scr + (8 * c) * 33 + n;
        u32x4 o; o.x = pk2(s[0 * 33], s[1 * 33]); o.y = pk2(s[2 * 33], s[3 * 33]); o.z = pk2(s[4 * 33], s[5 * 33]); o.w = pk2(s[6 * 33], s[7 * 33]);
        *(u32x4*)(WT + (size_t)perm_row<PERM>(n0 + n) * K + k0 + 8 * c) = o; }
    asm volatile("s_waitcnt lgkmcnt(0)" ::: "memory");
}
__device__ __forceinline__ void sincos_rev(double ang, float& c, float& s) {
    double rev = ang * 0.15915494309189535; rev -= __builtin_rint(rev); const float r = (float)rev;
    c = __builtin_amdgcn_cosf(r); s = __builtin_amdgcn_sinf(r);
}

__device__ __forceinline__ void row_stats(const f32x4 (&v)[4], float& mean, float& rstd) {
    float s = 0.f;
#pragma unroll
    for (int j = 0; j < 4; ++j) s += (v[j][0] + v[j][1]) + (v[j][2] + v[j][3]);
    mean = wave_sum(s) * (1.f / DM); float q = 0.f;
#pragma unroll
    for (int j = 0; j < 4; ++j) { const f32x4 d = v[j] - mean; q += (d[0] * d[0] + d[1] * d[1]) + (d[2] * d[2] + d[3] * d[3]); }
    rstd = 1.0f / sqrtf(wave_sum(q) * (1.f / DM) + LN_EPS);
}
__device__ __forceinline__ void mod_row_store(const f32x4 (&v)[4], const float* sh, const float* sc, bf16* orow, int lane) {
    float mean, rstd; row_stats(v, mean, rstd);
#pragma unroll
    for (int j = 0; j < 4; ++j) { const int col = 4 * lane + 256 * j; const f32x4 a = *(const f32x4*)(sc + col), b = *(const f32x4*)(sh + col);
        const f32x4 h = (v[j] - mean) * rstd * (a + 1.0f) + b; *(u32x2*)(orow + col) = (u32x2){pk2(h[0], h[1]), pk2(h[2], h[3])}; }
}

__device__ __forceinline__ void attn_unit(LAS unsigned char* lds, const bf16* Qimg, const bf16* Kimg, const bf16* Vimg, bf16* MIX, const int b, const int h, const int qb,
                                          const float lam, const float* subg, const float outscale) {
    const int tid = otid(), lane = tid & 63, r32 = lane & 31, hi = lane >> 5; const int wid = __builtin_amdgcn_readfirstlane(tid >> 6);
    const int comp = wid & 1, qsub = wid >> 1, hc = 2 * h + comp;
    const bf16* Qw = Qimg + ((size_t)(b * 8 + hc) * 8192 + qb * 128 + qsub * 32 + r32) * 64;
    bf16x8 qr[4];
#pragma unroll
    for (int d0 = 0; d0 < 4; ++d0) qr[d0] = *(const bf16x8*)(Qw + d0 * 16 + hi * 8);
    const bf16* K1 = Kimg + (size_t)((b * 8 + 2 * h) * 128) * 4096 + tid * 8;
    const bf16* K2 = Kimg + (size_t)((b * 8 + 2 * h + 1) * 128) * 4096 + tid * 8;
    const bf16* Vg = Vimg + (size_t)((b * 4 + h) * 128) * 8192 + tid * 8;
    LAS float* wsf = (LAS float*)(lds + 65536) + wid * 64;
    f32x16 o[4];
#pragma unroll
    for (int d = 0; d < 4; ++d) o[d] = (f32x16){};
    float mrow = 0.f, lrow = 0.f;
    u32x4 g0, g1, g2, g3;
    g0 = *(const u32x4*)K1; g1 = *(const u32x4*)K2; g2 = *(const u32x4*)Vg; g3 = *(const u32x4*)(Vg + 4096);
    *(LAS u32x4*)(lds + tid * 16) = g0; *(LAS u32x4*)(lds + 8192 + tid * 16) = g1; *(LAS u32x4*)(lds + 16384 + tid * 16) = g2; *(LAS u32x4*)(lds + 24576 + tid * 16) = g3;
    __syncthreads();
    const int vlane = ((lane & 15) >> 2) * 64 + ((lane >> 4) & 1) * 32 + (lane & 3) * 8 + hi * 256;
    for (int t = 0; t < 128; ++t) {
        const LAS unsigned char* st = lds + (t & 1) * 32768;
        if (t + 1 < 128) { g0 = *(const u32x4*)(K1 + (size_t)(t + 1) * 4096); g1 = *(const u32x4*)(K2 + (size_t)(t + 1) * 4096); g2 = *(const u32x4*)(Vg + (size_t)(t + 1) * 8192); g3 = *(const u32x4*)(Vg + (size_t)(t + 1) * 8192 + 4096); }
        f32x16 p0, p1;
#pragma unroll
        for (int r = 0; r < 16; ++r) { p0[r] = -mrow; p1[r] = -mrow; }
        const LAS unsigned char* Ks = st + comp * 8192 + hi * 1024 + r32 * 16;
#pragma unroll
        for (int d0 = 0; d0 < 4; ++d0) {
            const bf16x8 a0 = *(const LAS bf16x8*)(Ks + d0 * 2048), a1 = *(const LAS bf16x8*)(Ks + d0 * 2048 + 512);
            p0 = __builtin_amdgcn_mfma_f32_32x32x16_bf16(a0, qr[d0], p0, 0, 0, 0);
            p1 = __builtin_amdgcn_mfma_f32_32x32x16_bf16(a1, qr[d0], p1, 0, 0, 0);
        }
        float rm = fmaxf(p0[0], p1[0]);
#pragma unroll
        for (int r = 1; r < 16; ++r) rm = fmaxf(rm, fmaxf(p0[r], p1[r]));
        rm = fmaxf(rm, __shfl_xor(rm, 32));
        const bool need = (t == 0) || (rm > 6.0f);
        if (__any(need)) {
            const float dl = need ? rm : 0.f;
            mrow += dl;
#pragma unroll
            for (int r = 0; r < 16; ++r) { p0[r] -= dl; p1[r] -= dl; }
            if (t > 0) {
                const float f = fexp2(-dl); lrow *= f;
                if (hi == 0) wsf[r32] = f;
                asm volatile("s_waitcnt lgkmcnt(0)" ::: "memory");
#pragma unroll
                for (int r = 0; r < 16; ++r) { const float fr_ = wsf[crow(r, hi)];
#pragma unroll
                    for (int d = 0; d < 4; ++d) o[d][r] *= fr_; }
            }
        }
        float ls = 0.f;
#pragma unroll
        for (int r = 0; r < 16; ++r) { p0[r] = fexp2(p0[r]); p1[r] = fexp2(p1[r]); ls += p0[r] + p1[r]; }
        lrow += ls;
        const bf16x8 pa0 = pack8(p0[0], p0[1], p0[2], p0[3], p0[4], p0[5], p0[6], p0[7]), pa1 = pack8(p0[8], p0[9], p0[10], p0[11], p0[12], p0[13], p0[14], p0[15]);
        const bf16x8 pa2 = pack8(p1[0], p1[1], p1[2], p1[3], p1[4], p1[5], p1[6], p1[7]), pa3 = pack8(p1[8], p1[9], p1[10], p1[11], p1[12], p1[13], p1[14], p1[15]);
        const LAS char* Vs = (const LAS char*)st + 16384 + vlane;
#pragma unroll
        for (int d = 0; d < 4; ++d) {
            const bf16x8 v0 = cat8(vtr(Vs + d * 4096), vtr(Vs + d * 4096 + 512));
            const bf16x8 v1 = cat8(vtr(Vs + d * 4096 + 1024), vtr(Vs + d * 4096 + 1536));
            const bf16x8 v2 = cat8(vtr(Vs + d * 4096 + 2048), vtr(Vs + d * 4096 + 2560));
            const bf16x8 v3 = cat8(vtr(Vs + d * 4096 + 3072), vtr(Vs + d * 4096 + 3584));
            o[d] = __builtin_amdgcn_mfma_f32_32x32x16_bf16(pa0, v0, o[d], 0, 0, 0);
            o[d] = __builtin_amdgcn_mfma_f32_32x32x16_bf16(pa1, v1, o[d], 0, 0, 0);
            o[d] = __builtin_amdgcn_mfma_f32_32x32x16_bf16(pa2, v2, o[d], 0, 0, 0);
            o[d] = __builtin_amdgcn_mfma_f32_32x32x16_bf16(pa3, v3, o[d], 0, 0, 0);
        }
        if (t + 1 < 128) { LAS unsigned char* sn = lds + ((t + 1) & 1) * 32768 + tid * 16;
            *(LAS u32x4*)(sn) = g0; *(LAS u32x4*)(sn + 8192) = g1; *(LAS u32x4*)(sn + 16384) = g2; *(LAS u32x4*)(sn + 24576) = g3; }
        __syncthreads();
    }
    lrow += __shfl_xor(lrow, 32);
    if (hi == 0) wsf[r32] = frcp(lrow);
    asm volatile("s_waitcnt lgkmcnt(0)" ::: "memory");
#pragma unroll
    for (int r = 0; r < 16; ++r) { const float il = wsf[crow(r, hi)];
#pragma unroll
        for (int d = 0; d < 4; ++d) o[d][r] *= il; }
    LAS float* xb = (LAS float*)lds + (size_t)qsub * 4096 + lane;
    if (comp == 1) {
#pragma unroll
        for (int d = 0; d < 4; ++d)
#pragma unroll
            for (int r = 0; r < 16; ++r) xb[(d * 16 + r) * 64] = o[d][r];
    }
    __syncthreads();
    if (comp == 0) {
        float ss[16];
#pragma unroll
        for (int r = 0; r < 16; ++r) { ss[r] = 0.f;
#pragma unroll
            for (int d = 0; d < 4; ++d) { const float v = o[d][r] - lam * xb[(d * 16 + r) * 64]; o[d][r] = v; ss[r] += v * v; } }
        float gcol[4];
#pragma unroll
        for (int d = 0; d < 4; ++d) gcol[d] = subg[d * 32 + r32] * outscale;
#pragma unroll
        for (int r = 0; r < 16; ++r) { const float tot = half_sum(ss[r]); const float rs = 1.0f / sqrtf(tot * (1.f / 128.f) + LN_EPS);
            bf16* orow = MIX + ((size_t)b * 8192 + qb * 128 + qsub * 32 + crow(r, hi)) * 1024 + h * 128 + r32;
#pragma unroll
            for (int d = 0; d < 4; ++d) orow[d * 32] = (bf16)(pk2(o[d][r] * rs * gcol[d], 0.f) & 0xffffu); }
    }
    __syncthreads();
}

__device__ __forceinline__ void ret_kv_pair(LAS unsigned char* lds, const bf16* RET, float* RKV, const int unit0, const float* lg2f, const float* lg2b) {
    const int tid = otid(), lane = tid & 63, r32 = lane & 31, hi = lane >> 5; const int wid = __builtin_amdgcn_readfirstlane(tid >> 6);
    const int wg = wid >> 2, w4 = wid & 3, t4 = tid & 255;
    const int unit = unit0 + wg; const int bh = unit >> 6, n = unit & 63, b = bh >> 2, h = bh & 3;
    LAS unsigned char* base = lds + wg * 49152;
    const float l2f = lg2f[h], l2b = lg2b[h];
    const bf16* src = RET + ((size_t)b * 8192 + n * 128) * 1024 + 64 * h;
#pragma unroll
    for (int i = 0; i < 4; ++i) { const int idx = t4 + 256 * i; const int j = idx >> 3, c = idx & 7;
        const u32x4 kk = *(const u32x4*)(src + (size_t)j * 1024 + 256 + c * 8); const u32x4 vv = *(const u32x4*)(src + (size_t)j * 1024 + 512 + c * 8);
        const float wf = fexp2((float)(127 - j) * l2f), wb = fexp2((float)j * l2b);
        u32x4 vf, vb;
#pragma unroll
        for (int e = 0; e < 4; ++e) { const float lo = bflo(vv[e]), hh = bfhi(vv[e]); vf[e] = pk2(lo * wf, hh * wf); vb[e] = pk2(lo * wb, hh * wb); }
        *(LAS u32x4*)(base + j * 128 + c * 16) = kk; *(LAS u32x4*)(base + 16384 + j * 128 + c * 16) = vf; *(LAS u32x4*)(base + 32768 + j * 128 + c * 16) = vb; }
    __syncthreads();
    const int da = w4 >> 1, eb = w4 & 1;
    const int rowoff = (8 * hi + ((lane & 15) >> 2)) * 128 + (16 * ((lane >> 4) & 1) + 4 * (lane & 3)) * 2;
    f32x16 af = (f32x16){}, ab = (f32x16){};
#pragma unroll
    for (int s = 0; s < 8; ++s) {
        const LAS char* kp = (const LAS char*)base + s * 2048 + rowoff + da * 64;
        const LAS char* vp = (const LAS char*)base + 16384 + s * 2048 + rowoff + eb * 64;
        const bf16x8 ka = cat8(vtr(kp), vtr(kp + 512));
        const bf16x8 vf = cat8(vtr(vp), vtr(vp + 512)), vb = cat8(vtr(vp + 16384), vtr(vp + 16384 + 512));
        af = __builtin_amdgcn_mfma_f32_32x32x16_bf16(ka, vf, af, 0, 0, 0);
        ab = __builtin_amdgcn_mfma_f32_32x32x16_bf16(ka, vb, ab, 0, 0, 0);
    }
    float* of = RKV + ((size_t)(bh * 64 + n) * 2) * 4096 + eb * 32 + r32;
#pragma unroll
    for (int r = 0; r < 16; ++r) { const int d = da * 32 + crow(r, hi); of[d * 64] = af[r]; of[4096 + d * 64] = ab[r]; }
    __syncthreads();
}
__device__ __forceinline__ void ret_out_pair(LAS unsigned char* lds, const bf16* RET, const bf16* RST, bf16* MIX, const int unit0, const float* lg2f, const float* lg2b) {
    const int tid = otid(), lane = tid & 63, r32 = lane & 31, hi = lane >> 5; const int wid = __builtin_amdgcn_readfirstlane(tid >> 6);
    const int wg = wid >> 2, w4 = wid & 3, t4 = tid & 255;
    const int unit = unit0 + wg; const int bh = unit >> 6, n = unit & 63, b = bh >> 2, h = bh & 3;
    LAS unsigned char* base = lds + wg * 49152;
    const float l2f = lg2f[h], l2b = lg2b[h];
    const size_t row0 = (size_t)b * 8192 + n * 128;
    const bf16* src = RET + row0 * 1024 + 64 * h;
#pragma unroll
    for (int i = 0; i < 4; ++i) { const int idx = t4 + 256 * i; const int j = idx >> 3, c = idx & 7;
        *(LAS u32x4*)(base + j * 128 + c * 16) = *(const u32x4*)(src + (size_t)j * 1024 + 256 + c * 8);
        *(LAS u32x4*)(base + 16384 + j * 128 + c * 16) = *(const u32x4*)(src + (size_t)j * 1024 + 512 + c * 8); }
    const bf16* rs = RST + ((size_t)(bh * 64 + n) * 2) * 4096;
#pragma unroll
    for (int i = 0; i < 4; ++i) { const int idx = t4 + 256 * i;
        *(LAS u32x4*)(base + 32768 + idx * 16) = *(const u32x4*)(rs + (size_t)idx * 8); }
    bf16x8 qr[4];
    const bf16* qp = src + (size_t)(32 * w4 + r32) * 1024;
#pragma unroll
    for (int d0 = 0; d0 < 4; ++d0) qr[d0] = *(const bf16x8*)(qp + d0 * 16 + hi * 8);
    __syncthreads();
    const int cq = 32 * w4 + r32;
    f32x16 yi[2] = {(f32x16){}, (f32x16){}}, yf[2] = {(f32x16){}, (f32x16){}}, yb[2] = {(f32x16){}, (f32x16){}};
    const int trl = ((lane & 15) >> 2) * 128 + (16 * ((lane >> 4) & 1) + 4 * (lane & 3)) * 2;
#pragma unroll
    for (int kb = 0; kb < 4; ++kb) {
        f32x16 p = (f32x16){};
#pragma unroll
        for (int d0 = 0; d0 < 4; ++d0) { const bf16x8 a = *(const LAS bf16x8*)(base + (32 * kb + r32) * 128 + (16 * d0 + 8 * hi) * 2); p = __builtin_amdgcn_mfma_f32_32x32x16_bf16(a, qr[d0], p, 0, 0, 0); }
#pragma unroll
        for (int r = 0; r < 16; ++r) { const int j = 32 * kb + crow(r, hi); const int rel = cq - j; p[r] *= fexp2(rel >= 0 ? (float)rel * l2f : (float)(-rel) * l2b); }
        const bf16x8 pa0 = pack8(p[0], p[1], p[2], p[3], p[4], p[5], p[6], p[7]), pa1 = pack8(p[8], p[9], p[10], p[11], p[12], p[13], p[14], p[15]);
#pragma unroll
        for (int eb = 0; eb < 2; ++eb) {
            const LAS char* vp = (const LAS char*)base + 16384 + (32 * kb + 4 * hi) * 128 + trl + eb * 64;
            const bf16x8 v0 = cat8(vtr(vp), vtr(vp + 8 * 128)), v1 = cat8(vtr(vp + 16 * 128), vtr(vp + 24 * 128));
            yi[eb] = __builtin_amdgcn_mfma_f32_32x32x16_bf16(pa0, v0, yi[eb], 0, 0, 0);
            yi[eb] = __builtin_amdgcn_mfma_f32_32x32x16_bf16(pa1, v1, yi[eb], 0, 0, 0);
        }
    }
#pragma unroll
    for (int d0 = 0; d0 < 4; ++d0)
#pragma unroll
        for (int eb = 0; eb < 2; ++eb) {
            const LAS char* rp = (const LAS char*)base + 32768 + (16 * d0 + 8 * hi) * 128 + trl + eb * 64;
            const bf16x8 rf = cat8(vtr(rp), vtr(rp + 4 * 128)), rb = cat8(vtr(rp + 8192), vtr(rp + 8192 + 4 * 128));
            yf[eb] = __builtin_amdgcn_mfma_f32_32x32x16_bf16(qr[d0], rf, yf[eb], 0, 0, 0);
            yb[eb] = __builtin_amdgcn_mfma_f32_32x32x16_bf16(qr[d0], rb, yb[eb], 0, 0, 0);
        }
#pragma unroll
    for (int r = 0; r < 16; ++r) {
        const int c = 32 * w4 + crow(r, hi);
        const float sf = fexp2((float)(c + 1) * l2f), sb = fexp2((float)(128 - c) * l2b);
        const float y0 = yi[0][r] + sf * yf[0][r] + sb * yb[0][r], y1 = yi[1][r] + sf * yf[1][r] + sb * yb[1][r];
        const float mean = half_sum(y0 + y1) * (1.f / 64.f); const float d0_ = y0 - mean, d1_ = y1 - mean;
        const float var = half_sum(d0_ * d0_ + d1_ * d1_) * (1.f / 64.f); const float rstd = 1.0f / sqrtf(var + LN_EPS);
        const bf16* gp = RET + (row0 + c) * 1024 + 768 + 64 * h + r32; bf16* op = MIX + (row0 + c) * 1024 + 768 + 64 * h + r32;
        const float g0 = bf2f(gp[0]), g1 = bf2f(gp[32]);
        op[0] = (bf16)(pk2(g0 * sigmoidf_(g0) * d0_ * rstd, 0.f) & 0xffffu); op[32] = (bf16)(pk2(g1 * sigmoidf_(g1) * d1_ * rstd, 0.f) & 0xffffu);
    }
    __syncthreads();
}

__device__ __forceinline__ int moe_tables(LAS unsigned char* lds, const unsigned* gcnt) {
    LAS int* cnt = (LAS int*)(lds + TAB_OFF); LAS int* tstart = cnt + 32; LAS unsigned char* tile_e = (LAS unsigned char*)(tstart + 36);
    const int tid = otid();
    if (tid < 32) cnt[tid] = (int)gcnt[tid];
    __syncthreads();
    if (tid == 0) { int s = 0; for (int e = 0; e < 32; ++e) { tstart[e] = s; s += (cnt[e] + 255) >> 8; } tstart[32] = s; }
    __syncthreads();
    const int ntile = tstart[32];
    for (int p = tid; p < ntile; p += NTHR) { int e = 0;
#pragma unroll
        for (int k = 1; k < 32; ++k) e += (tstart[k] <= p) ? 1 : 0;
        tile_e[p] = (unsigned char)e; }
    __syncthreads();
    return ntile;
}

constexpr int NPH_LAYER = 10, NPH = 2 + DEPTH * NPH_LAYER;
#ifndef PH_MASK
#define PH_MASK 0x1FFFF
#endif
#define PHM(j) (((PH_MASK) >> (j)) & 1)
__global__ void __launch_bounds__(NTHR, 2) hybrid_fwd(Args args) {
    extern __shared__ __attribute__((aligned(16))) unsigned char lds_raw[];
    LAS unsigned char* lds = (LAS unsigned char*)lds_raw;
    volatile LAS unsigned* MISC = (volatile LAS unsigned*)(lds + MISC_OFF);
    const int G = gridDim.x, bx = blockIdx.x;
    const int NGW = G * NWAVES, NGT = G * NTHR;
#define PH_IDS const int tid = otid(); const int lane = tid & 63; const int wave = __builtin_amdgcn_readfirstlane(tid >> 6); const int gw = bx * NWAVES + wave; const int gt = bx * NTHR + tid; (void)lane; (void)gw; (void)gt; (void)wave;
    unsigned char* ws = args.ws;
    unsigned* ctl = (unsigned*)(ws + WS_CTL);
    for (int u = threadIdx.x; u < (LDS_BYTES - LDSCTL_OFF) / 4; u += NTHR) ((LAS unsigned*)(lds + LDSCTL_OFF))[u] = 0u;
    __syncthreads();
#if MK_SPLIT
    XcdBarrier bar; bar.bar = ctl + CW_BAR; bar.x = 0; bar.st = nullptr;
#define GRID_BAR() do { } while (0)
#else
    XcdBarrier bar = xcd_barrier_post(ctl + CW_BAR, MISC + 8);
#define GRID_BAR() xcd_barrier(bar)
#endif
    const int lo = args.ph_lo, hi_ph = args.ph_hi;
#define IN(k) (lo <= (k) && (k) < hi_ph)
#define SEAM(k) do { if (IN((k) + 1)) GRID_BAR(); } while (0)

    const float* x_in = (const float*)args.in[0]; const float* c_in = (const float*)args.in[1]; const int* pos_in = (const int*)args.in[2];
    const float* ada_w = (const float*)args.in[3]; const float* ada_b = (const float*)args.in[4];
    const float* w_in = (const float*)args.in[5]; const float* w_out = (const float*)args.in[6];
    const float* lq1 = (const float*)args.in[7]; const float* lk1 = (const float*)args.in[8]; const float* lq2 = (const float*)args.in[9]; const float* lk2 = (const float*)args.in[10];
    const float* subln_g = (const float*)args.in[11];
    const float* s5_lre = (const float*)args.in[12]; const float* s5_lim = (const float*)args.in[13]; const float* s5_ls = (const float*)args.in[14];
    const float* s5_bre = (const float*)args.in[15]; const float* s5_bim = (const float*)args.in[16]; const float* s5_cre = (const float*)args.in[17]; const float* s5_cim = (const float*)args.in[18];
    const float* s5_d = (const float*)args.in[19]; const float* glu_w = (const float*)args.in[20]; const float* glu_b = (const float*)args.in[21];
    const float* ln_g = (const float*)args.in[22]; const float* ln_b = (const float*)args.in[23];
    const float* router_w = (const float*)args.in[24]; const float* router_b = (const float*)args.in[25];
    const float* exp_w1 = (const float*)args.in[26]; const float* exp_b1 = (const float*)args.in[27]; const float* exp_w2 = (const float*)args.in[28]; const float* exp_b2 = (const float*)args.in[29];
    float* MOD = (float*)(ws + WS_MOD); float* ROT = (float*)(ws + WS_ROT); float* PW = (float*)(ws + WS_PW); float* BB = (float*)(ws + WS_BB);
    bf16* WIN = (bf16*)(ws + WS_WIN); bf16* WOUT = (bf16*)(ws + WS_WOUT); bf16* GLU = (bf16*)(ws + WS_GLU); bf16* W1S = (bf16*)(ws + WS_W1S); bf16* TW = (bf16*)(ws + WS_TW);
    bf16* W1 = (bf16*)(ws + WS_W1); bf16* W2 = (bf16*)(ws + WS_W2); bf16* HB = (bf16*)(ws + WS_HB);
    bf16* QIMG = (bf16*)(ws + WS_QIMG); bf16* KIMG = (bf16*)(ws + WS_KIMG); bf16* VIMG = (bf16*)(ws + WS_VIMG); bf16* UG2 = (bf16*)(ws + WS_UG2); bf16* RET = (bf16*)(ws + WS_RET);
    float* S5S = (float*)(ws + WS_S5S); bf16* YB = (bf16*)(ws + WS_YB); float* RKV = (float*)(ws + WS_RKV); bf16* RST = (bf16*)(ws + WS_RST); bf16* MIX = (bf16*)(ws + WS_MIX);
    float* YPRE = (float*)(ws + WS_YPRE); float* X1 = (float*)(ws + WS_X1); float* XB = (float*)(ws + WS_XB);
    int* LIST = (int*)(ws + WS_LIST); int* TOKI = (int*)(ws + WS_TOKI); float* GATE = (float*)(ws + WS_GATE); bf16* A2 = (bf16*)(ws + WS_A2); bf16* YS = (bf16*)(ws + WS_YS);
    float* COSA = ROT, *SINA = ROT + (size_t)T * 32, *COSR = ROT + (size_t)T * 64, *SINR = ROT + (size_t)T * 96;

    if (PHM(10) && IN(0)) {
        PH_IDS
        LAS float* cond = (LAS float*)lds; LAS float* red = (LAS float*)(lds + 16384);
        for (int i = tid; i < 4096; i += NTHR) { const float v = c_in[i]; cond[i] = v * sigmoidf_(v); }
        __syncthreads();
        for (int it = bx; it < 4 * 96; it += G) {
            const int l = it / 96, n0 = (it % 96) * 64;
            float a0 = 0.f, a1 = 0.f, a2 = 0.f, a3 = 0.f;
            const float* wp = ada_w + ((size_t)l * 1024 + wave * 128) * 6144 + n0 + lane;
#pragma unroll 8
            for (int kk = 0; kk < 128; ++kk) { const float wv = wp[(size_t)kk * 6144]; const int k = wave * 128 + kk; a0 += cond[k] * wv; a1 += cond[1024 + k] * wv; a2 += cond[2048 + k] * wv; a3 += cond[3072 + k] * wv; }
            red[(wave * 4 + 0) * 64 + lane] = a0; red[(wave * 4 + 1) * 64 + lane] = a1; red[(wave * 4 + 2) * 64 + lane] = a2; red[(wave * 4 + 3) * 64 + lane] = a3;
            __syncthreads();
            if (tid < 256) { const int b = tid >> 6; float s = ada_b[(size_t)l * 6144 + n0 + lane];
#pragma unroll
                for (int w = 0; w < 8; ++w) s += red[(w * 4 + b) * 64 + lane];
                MOD[((size_t)l * 4 + b) * 6144 + n0 + lane] = s; }
            __syncthreads();
        }
        for (int i = gt; i < T * 32; i += NGT) { const int row = i >> 5, f = i & 31; const double p = (double)pos_in[row];
            float c, s; sincos_rev(p * args.invfA[f], c, s); COSA[i] = c; SINA[i] = s; sincos_rev(p * args.invfR[f], c, s); COSR[i] = c; SINR[i] = s; }
        for (int i = gt; i < 4 * 2 * 16 * 64; i += NGT) {
            const int g = (i >> 6) & 15, ld = i >> 10;
            const float lr = fminf(s5_lre[i], -1e-4f), li = s5_lim[i]; const float dt = expf(s5_ls[ld * 16 + g]);
            float* pw = PW + (size_t)i * 130;
            for (int tau = 0; tau <= 64; ++tau) { const float mag = expf((float)tau * lr * dt); float c, s; sincos_rev((double)tau * (double)li * (double)dt, c, s); pw[2 * tau] = mag * c; pw[2 * tau + 1] = mag * s; }
            const float ar = pw[2], ai = pw[3], den = lr * lr + li * li;
            const float fre = ((ar - 1.0f) * lr + ai * li) / den, fim = (ai * lr - (ar - 1.0f) * li) / den;
            for (int n = 0; n < 16; ++n) { const float br = s5_bre[(size_t)i * 16 + n], bi = s5_bim[(size_t)i * 16 + n]; BB[((size_t)i * 16 + n) * 2] = fre * br - fim * bi; BB[((size_t)i * 16 + n) * 2 + 1] = fre * bi + fim * br; }
        }
        {
            LAS float* scr = (LAS float*)(lds + 32768 + wave * 8704);
            constexpr int I_IN = 16 * 88, I_OUT = 16 * 32, I_GLU = 4 * 16, I_W1 = 16 * 64, I_W2 = 16 * 32;
            constexpr int N_SMALL = DEPTH * (I_IN + I_OUT + I_GLU);
            constexpr int N_ALL = N_SMALL + DEPTH * NE * (I_W1 + I_W2);
            for (int it = gw; it < N_ALL; it += NGW) {
                int r = it;
                if (r < N_SMALL) {
                    const int l = r / (I_IN + I_OUT + I_GLU); r %= (I_IN + I_OUT + I_GLU);
                    if (r < I_IN) transpose_item<1>(w_in + (size_t)l * 1024 * INW, 1024, INW, WIN + (size_t)l * INW * 1024, scr, r, lane);
                    else if (r < I_IN + I_OUT) transpose_item<0>(w_out + (size_t)l * 1024 * 1024, 1024, 1024, WOUT + (size_t)l * 1024 * 1024, scr, r - I_IN, lane);
                    else transpose_item<3>(glu_w + (size_t)l * 256 * 512, 256, 512, GLU + (size_t)l * 512 * 256, scr, r - I_IN - I_OUT, lane);
                } else {
                    r -= N_SMALL; const int le = r / (I_W1 + I_W2); r %= (I_W1 + I_W2);
                    if (r < I_W1) transpose_item<2>(exp_w1 + (size_t)le * 1024 * 2048, 1024, 2048, W1 + (size_t)le * 2048 * 1024, scr, r, lane);
                    else transpose_item<0>(exp_w2 + (size_t)le * 1024 * 1024, 1024, 1024, W2 + (size_t)le * 1024 * 1024, scr, r - I_W1, lane);
                }
            }
        }
        SEAM(0);
    }
    if (PHM(11) && IN(1)) {
        PH_IDS
        for (int m = gw; m < T; m += NGW) { const f32x4* xr = (const f32x4*)(x_in + (size_t)m * DM) + lane; f32x4 v[4];
#pragma unroll
            for (int j = 0; j < 4; ++j) v[j] = xr[64 * j];
            const float* md = MOD + (size_t)(m >> 13) * 6144; mod_row_store(v, md, md + 1024, HB + (size_t)m * DM, lane); }
        for (int i = gt; i < 4 * 16 * 64 * 256; i += NGT) {
            const int mm = i & 15, n = (i >> 4) & 15, tau = (i >> 8) & 63, g = (i >> 14) & 15, l = i >> 18;
            float kf = 0.f, kb = 0.f;
#pragma unroll
            for (int dir = 0; dir < 2; ++dir) {
                const size_t pg = ((size_t)(l * 2 + dir) * 16 + g);
                const float* cr = s5_cre + (pg * 16 + n) * 64; const float* ci = s5_cim + (pg * 16 + n) * 64;
                const float* pw = PW + pg * 64 * 130 + 2 * tau; const float* bb = BB + (pg * 64 * 16 + mm) * 2;
                float acc = 0.f;
                for (int p = 0; p < 64; ++p) { const float pr = pw[(size_t)p * 130], pi = pw[(size_t)p * 130 + 1], br = bb[(size_t)p * 32], bi = bb[(size_t)p * 32 + 1];
                    acc += cr[p] * (pr * br - pi * bi) - ci[p] * (pr * bi + pi * br); }
                if (dir == 0) kf = acc; else kb = acc;
            }
            bf16* tw = TW + (size_t)(l * 16 + g) * 1024 * 1280;
            if (tau == 0) { const bf16 v = (bf16)(pk2(kf + kb, 0.f) & 0xffffu); for (int j = 0; j < 64; ++j) tw[(size_t)(j * 16 + n) * 1280 + j * 16 + mm] = v; }
            else { const bf16 vf = (bf16)(pk2(kf, 0.f) & 0xffffu), vb = (bf16)(pk2(kb, 0.f) & 0xffffu);
                for (int j = tau; j < 64; ++j) tw[(size_t)(j * 16 + n) * 1280 + (j - tau) * 16 + mm] = vf;
                for (int j = 0; j + tau < 64; ++j) tw[(size_t)(j * 16 + n) * 1280 + (j + tau) * 16 + mm] = vb; }
        }
        for (int i = gt; i < 4 * 16 * 1024 * 256; i += NGT) {
            const int col = i & 255, rowj = (i >> 8) & 1023, g = (i >> 18) & 15, l = i >> 22;
            const int dir = col >> 7, part = (col >> 6) & 1, p = col & 63;
            const size_t pg = ((size_t)(l * 2 + dir) * 16 + g);
            {
                const int j = rowj >> 4, n = rowj & 15; const int tau = dir == 0 ? j + 1 : 64 - j;
                const float ar = PW[(pg * 64 + p) * 130 + 2 * tau], ai = PW[(pg * 64 + p) * 130 + 2 * tau + 1];
                const float cr = s5_cre[(pg * 16 + n) * 64 + p], ci = s5_cim[(pg * 16 + n) * 64 + p];
                const float v = part == 0 ? (cr * ar - ci * ai) : -(cr * ai + ci * ar);
                TW[((size_t)(l * 16 + g) * 1024 + rowj) * 1280 + 1024 + col] = (bf16)(pk2(v, 0.f) & 0xffffu);
            }
            {
                const int s = rowj >> 4, mm = rowj & 15; const int tau = dir == 0 ? 63 - s : s;
                const float pr = PW[(pg * 64 + p) * 130 + 2 * tau], pi = PW[(pg * 64 + p) * 130 + 2 * tau + 1];
                const float br = BB[((pg * 64 + p) * 16 + mm) * 2], bi = BB[((pg * 64 + p) * 16 + mm) * 2 + 1];
                const float v = part == 0 ? (pr * br - pi * bi) : (pr * bi + pi * br);
                W1S[((size_t)(l * 16 + g) * 256 + col) * 1024 + rowj] = (bf16)(pk2(v, 0.f) & 0xffffu);
            }
        }
        SEAM(1);
    }

    for (int l = 0; l < DEPTH; ++l) {
        const int P = 2 + l * NPH_LAYER;
        const float* xcur = (l == 0) ? x_in : XB;
        float* xnext = (l == DEPTH - 1) ? args.out : XB;
        const float* modl = MOD + (size_t)l * 4 * 6144;
        unsigned* gcnt = ctl + CW_GCNT + 64 * l;
        if (PHM(0) && IN(P + 0)) {
            DenseSched S{T / 256, INW / 256, G, bx, (const char*)HB, (const char*)(WIN + (size_t)l * INW * 1024), (size_t)256 * 1024 * 2, (size_t)256 * 1024 * 2};
            EpiProj E{QIMG, KIMG, VIMG, UG2, RET, COSA, SINA, COSR, SINR};
            pg8::gemm_phase<EpiProj, DenseSched, false>(lds, 1024, 1024, 1024, S, E);
            SEAM(P + 0);
        }
        if (PHM(1) && IN(P + 1)) {
            GroupSched S{1, G, bx, (const char*)UG2, (const char*)(W1S + (size_t)l * 16 * 256 * 1024), (size_t)512 * 1280 * 2, (size_t)256 * 1024 * 2, (size_t)256 * 1280 * 2, (size_t)256 * 1024 * 2};
            EpiS5S E{S5S};
            if (PHM(12)) pg8::gemm_phase<EpiS5S, GroupSched, false>(lds, 1024, 1280, 1024, S, E);
            __syncthreads();
            if (PHM(13)) for (int pr = bx; pr < 512; pr += G) ret_kv_pair(lds, RET, RKV, 2 * pr, args.lg2f, args.lg2b);
            SEAM(P + 1);
        }
        if (PHM(2) && IN(P + 2)) {
            PH_IDS
            if (gw < 128) {
                const int dir = gw & 1, g = (gw >> 1) & 15, b = gw >> 5;
                const size_t pg = ((size_t)(l * 2 + dir) * 16 + g);
                const float aqr = PW[(pg * 64 + lane) * 130 + 128], aqi = PW[(pg * 64 + lane) * 130 + 129];
                float hr = 0.f, hi2 = 0.f;
                const float* sb = S5S + ((size_t)g * 512 + b * 128) * 256 + dir * 128 + lane;
                bf16* ob = UG2 + ((size_t)g * 512 + b * 128) * 1280 + 1024 + dir * 128 + lane;
#pragma unroll 8
                for (int cc = 0; cc < 128; ++cc) { const int c = dir == 0 ? cc : 127 - cc;
                    const float sr = sb[(size_t)c * 256], si = sb[(size_t)c * 256 + 64];
                    ob[(size_t)c * 1280] = (bf16)(pk2(hr, 0.f) & 0xffffu); ob[(size_t)c * 1280 + 64] = (bf16)(pk2(hi2, 0.f) & 0xffffu);
                    const float nr = aqr * hr - aqi * hi2 + sr, ni = aqr * hi2 + aqi * hr + si; hr = nr; hi2 = ni; }
            }
            for (int i = gt; i < 16 * 4096; i += NGT) { const int bh = i >> 12, idx = i & 4095, h = bh & 3;
                const float df = fexp2(128.f * args.lg2f[h]), db = fexp2(128.f * args.lg2b[h]);
                const float* kv = RKV + (size_t)bh * 64 * 2 * 4096 + idx; bf16* rs = RST + (size_t)bh * 64 * 2 * 4096 + idx;
                float st = 0.f;
#pragma unroll 8
                for (int n = 0; n < 64; ++n) { const float v = kv[(size_t)n * 8192]; rs[(size_t)n * 8192] = (bf16)(pk2(st, 0.f) & 0xffffu); st = df * st + v; }
                st = 0.f;
#pragma unroll 8
                for (int n = 63; n >= 0; --n) { const float v = kv[(size_t)n * 8192 + 4096]; rs[(size_t)n * 8192 + 4096] = (bf16)(pk2(st, 0.f) & 0xffffu); st = db * st + v; }
            }
            SEAM(P + 2);
        }
        if (PHM(3) && IN(P + 3)) {
            float lam;
            { float s1 = 0.f, s2 = 0.f; for (int i = 0; i < 64; ++i) { s1 += lq1[l * 64 + i] * lk1[l * 64 + i]; s2 += lq2[l * 64 + i] * lk2[l * 64 + i]; } lam = expf(s1) - expf(s2) + args.lam_init[l]; }
            if (PHM(14)) for (int u = bx; u < 1024; u += G) { const int qb = u & 63, bh = u >> 6; attn_unit(lds, QIMG, KIMG, VIMG, MIX, bh >> 2, bh & 3, qb, lam, subln_g + l * 128, 1.0f - args.lam_init[l]); }
            const int half = G >> 1;
            if (PHM(15)) {
                GroupSched S{4, half, bx < half ? bx : -1, (const char*)UG2, (const char*)(TW + (size_t)l * 16 * 1024 * 1280), (size_t)512 * 1280 * 2, (size_t)1024 * 1280 * 2, (size_t)256 * 1280 * 2, (size_t)256 * 1280 * 2};
                EpiS5Y E{YB, UG2, s5_d + l * 256};
                pg8::gemm_phase<EpiS5Y, GroupSched, false>(lds, 1280, 1280, 1280, S, E);
            }
            __syncthreads();
            if (PHM(16) && bx >= half) for (int pr = bx - half; pr < 512; pr += (G - half)) ret_out_pair(lds, RET, RST, MIX, 2 * pr, args.lg2f, args.lg2b);
            SEAM(P + 3);
        }
        if (PHM(4) && IN(P + 4)) {
            DenseSched S{T / 256, 2, G, bx, (const char*)YB, (const char*)(GLU + (size_t)l * 512 * 256), (size_t)256 * 256 * 2, (size_t)256 * 256 * 2};
            EpiGlu E{MIX, glu_b + l * 512};
            pg8::gemm_phase<EpiGlu, DenseSched, false>(lds, 256, 256, 256, S, E);
            SEAM(P + 4);
        }
        if (PHM(5) && IN(P + 5)) {
            DenseSched S{T / 256, 4, G, bx, (const char*)MIX, (const char*)(WOUT + (size_t)l * 1024 * 1024), (size_t)256 * 1024 * 2, (size_t)256 * 1024 * 2};
            EpiOut E{YPRE, xcur, modl};
            pg8::gemm_phase<EpiOut, DenseSched, false>(lds, 1024, 1024, 1024, S, E);
            SEAM(P + 5);
        }
        if (PHM(6) && IN(P + 6)) {
            PH_IDS
            LAS float* WT = (LAS float*)lds;
            for (int i = tid; i < 1024 * 32; i += NTHR) { const int k = i >> 5, e = i & 31; WT[e * 1024 + k] = router_w[(size_t)l * 1024 * 32 + i]; }
            LAS int* lcnt = (LAS int*)(lds + TAB_OFF); LAS int* lbase = lcnt + 32; LAS int* ent = lbase + 32;
            if (tid < 32) lcnt[tid] = 0;
            __syncthreads();
            int nloc = 0;
            for (int m = gw; m < T; m += NGW, ++nloc) {
                const int b = m >> 13;
                f32x4 v[4];
#pragma unroll
                for (int j = 0; j < 4; ++j) v[j] = *((const f32x4*)(YPRE + (size_t)m * DM) + lane + 64 * j);
                float mean, rstd; row_stats(v, mean, rstd);
#pragma unroll
                for (int j = 0; j < 4; ++j) { const int col = 4 * lane + 256 * j; const f32x4 gg = *(const f32x4*)(ln_g + (size_t)(l * 2) * DM + col), bb = *(const f32x4*)(ln_b + (size_t)(l * 2) * DM + col);
                    v[j] = (v[j] - mean) * rstd * gg + bb; *(f32x4*)(X1 + (size_t)m * DM + col) = v[j]; }
                row_stats(v, mean, rstd);
                const float* sh = modl + (size_t)b * 6144 + 3 * 1024; const float* sc = sh + 1024;
#pragma unroll
                for (int j = 0; j < 4; ++j) { const int col = 4 * lane + 256 * j; const f32x4 a = *(const f32x4*)(sc + col), bb = *(const f32x4*)(sh + col);
                    v[j] = (v[j] - mean) * rstd * (a + 1.0f) + bb; *(u32x2*)(HB + (size_t)m * DM + col) = (u32x2){pk2(v[j][0], v[j][1]), pk2(v[j][2], v[j][3])}; }
                float lg[32];
#pragma unroll
                for (int eg = 0; eg < 8; ++eg) {
#pragma unroll
                    for (int e = 4 * eg; e < 4 * eg + 4; ++e) { float a = 0.f;
#pragma unroll
                        for (int j = 0; j < 4; ++j) { const f32x4 w = *(const LAS f32x4*)(WT + e * 1024 + 4 * lane + 256 * j); a += (v[j][0] * w[0] + v[j][1] * w[1]) + (v[j][2] * w[2] + v[j][3] * w[3]); }
                        lg[e] = wave_sum(a) + router_b[l * 32 + e]; }
                    asm volatile("" ::: "memory");
                }
                int te[4]; float tv[4];
#pragma unroll
                for (int k = 0; k < 4; ++k) { float best = -INFINITY; int bi = 0;
#pragma unroll
                    for (int e = 0; e < 32; ++e) { if (lg[e] > best) { best = lg[e]; bi = e; } }
#pragma unroll
                    for (int e = 0; e < 32; ++e) { if (e == bi) lg[e] = -INFINITY; }
                    te[k] = bi; tv[k] = best; }
                float gs = 0.f, ge[4];
#pragma unroll
                for (int k = 0; k < 4; ++k) { ge[k] = fexp2((tv[k] - tv[0]) * LOG2E); gs += ge[k]; }
                const float ig = 1.0f / gs;
                if (lane < 4) { const int e = lane == 0 ? te[0] : lane == 1 ? te[1] : lane == 2 ? te[2] : te[3]; const float gv = (lane == 0 ? ge[0] : lane == 1 ? ge[1] : lane == 2 ? ge[2] : ge[3]) * ig;
                    const int lp = atomicAdd((int*)&lcnt[e], 1);
                    const int sl = (wave * 32 + nloc) * 4 + lane; ent[sl * 3] = e; ent[sl * 3 + 1] = lp; ent[sl * 3 + 2] = __float_as_int(gv); }
            }
            __syncthreads();
            if (tid < 32) lbase[tid] = (int)atomicAdd(gcnt + tid, (unsigned)lcnt[tid]);
            __syncthreads();
            { int nl = 0; for (int m = gw; m < T; m += NGW, ++nl) { if (lane < 4) { const int sl = (wave * 32 + nl) * 4 + lane; const int e = ent[sl * 3], pos = lbase[e] + ent[sl * 3 + 1];
                    LIST[(size_t)e * T + pos] = m; TOKI[((size_t)m * 4 + lane) * 2] = e; TOKI[((size_t)m * 4 + lane) * 2 + 1] = pos; GATE[(size_t)m * 4 + lane] = __int_as_float(ent[sl * 3 + 2]); } } }
            SEAM(P + 6);
        }
        if (PHM(7) && IN(P + 7)) {
            const int ntile = moe_tables(lds, gcnt);
            LAS int* cnt = (LAS int*)(lds + TAB_OFF);
            MoeSched S{ntile, 8, G, bx, (const char*)HB, (const char*)(W1 + (size_t)l * 32 * 2048 * 1024), (size_t)2048 * 1024 * 2, 0, (size_t)256 * 1024 * 2, cnt, cnt + 32, (const LAS unsigned char*)(cnt + 68), LIST};
            EpiMoe1 E{A2, exp_b1 + (size_t)l * 32 * 2048};
            pg8::gemm_phase<EpiMoe1, MoeSched, true>(lds, 1024, 1024, 1024, S, E);
            SEAM(P + 7);
        }
        if (PHM(8) && IN(P + 8)) {
            const int ntile = moe_tables(lds, gcnt);
            LAS int* cnt = (LAS int*)(lds + TAB_OFF);
            MoeSched S{ntile, 4, G, bx, (const char*)A2, (const char*)(W2 + (size_t)l * 32 * 1024 * 1024), (size_t)1024 * 1024 * 2, (size_t)256 * 1024 * 2, (size_t)256 * 1024 * 2, cnt, cnt + 32, (const LAS unsigned char*)(cnt + 68), LIST};
            EpiMoe2 E{YS, exp_b2 + (size_t)l * 32 * 1024};
            pg8::gemm_phase<EpiMoe2, MoeSched, false>(lds, 1024, 1024, 1024, S, E);
            SEAM(P + 8);
        }
        if (PHM(9) && IN(P + 9)) {
            PH_IDS
            (void)moe_tables(lds, gcnt);
            const LAS int* tstart = (const LAS int*)(lds + TAB_OFF) + 32;
            for (int m = gw; m < T; m += NGW) {
                const int b = m >> 13;
                f32x4 ff[4] = {(f32x4){}, (f32x4){}, (f32x4){}, (f32x4){}};
#pragma unroll
                for (int k = 0; k < 4; ++k) { const int e = TOKI[((size_t)m * 4 + k) * 2], pos = TOKI[((size_t)m * 4 + k) * 2 + 1]; const float gv = GATE[(size_t)m * 4 + k];
                    const bf16* yr = YS + ((size_t)tstart[e] * 256 + pos) * 1024;
#pragma unroll
                    for (int j = 0; j < 4; ++j) { const u32x2 w = *(const u32x2*)(yr + 4 * lane + 256 * j); ff[j] += (f32x4){bflo(w[0]), bfhi(w[0]), bflo(w[1]), bfhi(w[1])} * gv; } }
                f32x4 v[4];
                const float* g2 = modl + (size_t)b * 6144 + 5 * 1024;
#pragma unroll
                for (int j = 0; j < 4; ++j) { const int col = 4 * lane + 256 * j; const f32x4 xx = *(const f32x4*)(X1 + (size_t)m * DM + col), gg = *(const f32x4*)(g2 + col); v[j] = xx * DN_ALPHA + (gg + 1.0f) * ff[j]; }
                float mean, rstd; row_stats(v, mean, rstd);
#pragma unroll
                for (int j = 0; j < 4; ++j) { const int col = 4 * lane + 256 * j; const f32x4 gg = *(const f32x4*)(ln_g + (size_t)(l * 2 + 1) * DM + col), bb = *(const f32x4*)(ln_b + (size_t)(l * 2 + 1) * DM + col);
                    v[j] = (v[j] - mean) * rstd * gg + bb; *(f32x4*)(xnext + (size_t)m * DM + col) = v[j]; }
                if (l + 1 < DEPTH) { const float* md = MOD + ((size_t)(l + 1) * 4 + b) * 6144; mod_row_store(v, md, md + 1024, HB + (size_t)m * DM, lane); }
            }
            SEAM(P + 9);
        }
    }
#undef IN
#undef SEAM
#undef GRID_BAR
}

extern "C" void kernel_launch(void* const* d_in, const int* in_sizes, int n_in, void* d_out, int out_size, void* d_ws, size_t ws_size, hipStream_t stream) {
    static int grid = 0;
    if (grid == 0) {
        if (n_in != 30 || in_sizes[0] != T * DM || out_size != T * DM || ws_size < WS_END) { fprintf(stderr, "kernel_launch: unexpected problem (n_in %d, in0 %d, out %d, ws %zu)\n", n_in, n_in > 0 ? in_sizes[0] : -1, out_size, ws_size); grid = -1; return; }
        int dev = 0, cus = 0, per_cu = 0;
        if (hipGetDevice(&dev) != hipSuccess || hipDeviceGetAttribute(&cus, hipDeviceAttributeMultiprocessorCount, dev) != hipSuccess) { grid = -1; return; }
        if (hipFuncSetAttribute((const void*)hybrid_fwd, hipFuncAttributeMaxDynamicSharedMemorySize, LDS_BYTES) != hipSuccess) { fprintf(stderr, "kernel_launch: hipFuncSetAttribute failed\n"); grid = -1; return; }
        if (hipOccupancyMaxActiveBlocksPerMultiprocessor(&per_cu, (const void*)hybrid_fwd, NTHR, LDS_BYTES) != hipSuccess || per_cu < 1) { fprintf(stderr, "kernel_launch: occupancy query says %d\n", per_cu); (void)hipGetLastError(); if (per_cu < 1) { grid = -1; return; } }
        grid = cus;
        if (grid > 256) grid = 256;
        if (grid < 128) { grid = -1; return; }
    }
    if (grid < 0) return;
    (void)hipMemsetAsync((char*)d_ws + WS_CTL, 0, CTL_BYTES, stream);
    Args a{};
    for (int i = 0; i < 30; ++i) a.in[i] = d_in[i];
    a.out = (float*)d_out; a.ws = (unsigned char*)d_ws;
    for (int i = 0; i < 32; ++i) { a.invfA[i] = std::pow(10000.0, -(double)i / 32.0); a.invfR[i] = std::pow(10000.0, -(double)i / 31.0); }
    for (int l = 0; l < 4; ++l) a.lam_init[l] = (float)(0.8 - 0.6 * std::exp(-0.3 * l));
    for (int h = 0; h < 4; ++h) { a.lg2f[h] = (float)std::log2(1.0 - std::exp2(-5.0 - h)); a.lg2b[h] = (float)std::log2(1.0 - std::exp2(-5.5 - h)); }
#if MK_SPLIT
    for (int p = 0; p < NPH; ++p) { a.ph_lo = p; a.ph_hi = p + 1; hipLaunchKernelGGL(hybrid_fwd, dim3(grid), dim3(NTHR), LDS_BYTES, stream, a); }
#else
    a.ph_lo = 0; a.ph_hi = NPH;
    hipLaunchKernelGGL(hybrid_fwd, dim3(grid), dim3(NTHR), LDS_BYTES, stream, a);
#endif
}
```

```cpp
#include <hip/hip_runtime.h>
#include <cstdio>
#include <cstdint>
#include <cmath>

#define LAS __attribute__((address_space(3)))
#define GAS __attribute__((address_space(1)))
typedef unsigned short bf16;
typedef short bf16x8 __attribute__((ext_vector_type(8)));
typedef short s16x4 __attribute__((ext_vector_type(4)));
typedef float f32x4 __attribute__((ext_vector_type(4)));
typedef float f32x2 __attribute__((ext_vector_type(2)));
typedef float f32x16 __attribute__((ext_vector_type(16)));
typedef unsigned u32x4 __attribute__((ext_vector_type(4)));
typedef unsigned u32x2 __attribute__((ext_vector_type(2)));
typedef __bf16 bf16x2_t __attribute__((ext_vector_type(2)));

#ifndef MK_SPLIT
#define MK_SPLIT 0
#endif

constexpr int NB = 4, SEQ = 8192, DM = 1024, T = NB * SEQ, DEPTH = 4;
constexpr int INW = 2816, NE = 32;
constexpr int NTILE_MAX = T * 4 / 256 + NE;
constexpr float LN_EPS = 1e-5f;
constexpr float C2 = 0.125f * 1.4426950408889634f;
constexpr float LOG2E = 1.4426950408889634f;
constexpr float DN_ALPHA = 1.681792830507429f;

constexpr size_t MiB = 1u << 20;
constexpr size_t WS_CTL = 0, CTL_BYTES = 65536;
constexpr size_t WS_MOD = 1 * MiB;
constexpr size_t WS_ROT = 2 * MiB;
constexpr size_t WS_PW = 18 * MiB;
constexpr size_t WS_BB = 23 * MiB;
constexpr size_t WS_WIN = 24 * MiB;
constexpr size_t WS_WOUT = 46 * MiB;
constexpr size_t WS_GLU = 54 * MiB;
constexpr size_t WS_W1S = 56 * MiB;
constexpr size_t WS_TW = 88 * MiB;
constexpr size_t WS_W1 = 248 * MiB;
constexpr size_t WS_W2 = 760 * MiB;
constexpr size_t WS_HB = 1016 * MiB;
constexpr size_t WS_QIMG = 1080 * MiB;
constexpr size_t WS_KIMG = 1112 * MiB;
constexpr size_t WS_VIMG = 1144 * MiB;
constexpr size_t WS_UG2 = 1176 * MiB;
constexpr size_t WS_RET = 1196 * MiB;
constexpr size_t WS_S5S = 1260 * MiB;
constexpr size_t WS_YB = 1268 * MiB;
constexpr size_t WS_RKV = 1284 * MiB;
constexpr size_t WS_RST = 1316 * MiB;
constexpr size_t WS_MIX = 1332 * MiB;
constexpr size_t WS_YPRE = 1396 * MiB;
constexpr size_t WS_X1 = 1524 * MiB;
constexpr size_t WS_XB = 1652 * MiB;
constexpr size_t WS_LIST = 1780 * MiB;
constexpr size_t WS_TOKI = 1784 * MiB;
constexpr size_t WS_GATE = 1785 * MiB;
constexpr size_t WS_A2 = 1786 * MiB;
constexpr size_t WS_YS = 2058 * MiB;
constexpr size_t WS_END = 2330 * MiB;

constexpr int CW_TMO = 0, CW_BAR = 1024, CW_GCNT = 8192;

constexpr int RING_BYTES = 131072;
constexpr int LDSCTL_OFF = RING_BYTES, MISC_OFF = LDSCTL_OFF + 320, TAB_OFF = LDSCTL_OFF + 512;
constexpr int LDS_BYTES = 147456;
constexpr int NWAVES = 8, NTHR = 512;

#define RLX_AGENT __ATOMIC_RELAXED, __HIP_MEMORY_SCOPE_AGENT
__device__ __forceinline__ unsigned pk2(float lo, float hi) { f32x2 v = {lo, hi}; bf16x2_t b = __builtin_convertvector(v, bf16x2_t); return __builtin_bit_cast(unsigned, b); }
__device__ __forceinline__ float bf2f(unsigned short u) { return __uint_as_float(((unsigned)u) << 16); }
__device__ __forceinline__ float bflo(unsigned u) { return __uint_as_float(u << 16); }
__device__ __forceinline__ float bfhi(unsigned u) { return __uint_as_float(u & 0xffff0000u); }
template <int CTRL> __device__ __forceinline__ float dppadd(float v) { return v + __builtin_bit_cast(float, __builtin_amdgcn_update_dpp(0, __builtin_bit_cast(int, v), CTRL, 0xF, 0xF, true)); }
__device__ __forceinline__ float swap16_add(float v) { float w = v; asm volatile("v_nop\n\tv_nop\n\tv_permlane16_swap_b32 %0, %1\n\tv_nop\n\tv_nop" : "+v"(v), "+v"(w)); return v + w; }
__device__ __forceinline__ float swap32_add(float v) { float w = v; asm volatile("v_nop\n\tv_nop\n\tv_permlane32_swap_b32 %0, %1\n\tv_nop\n\tv_nop" : "+v"(v), "+v"(w)); return v + w; }
__device__ __forceinline__ float swap32_max(float v) { float w = v; asm volatile("v_nop\n\tv_nop\n\tv_permlane32_swap_b32 %0, %1\n\tv_nop\n\tv_nop" : "+v"(v), "+v"(w)); return fmaxf(v, w); }
__device__ __forceinline__ float half_sum(float v) {
    v = dppadd<0xB1>(v); v = dppadd<0x4E>(v); v = dppadd<0x141>(v); v = dppadd<0x140>(v); return swap16_add(v);
}
__device__ __forceinline__ float wave_sum(float v) { return swap32_add(half_sum(v)); }
__device__ __forceinline__ float fexp2(float x) { return __builtin_amdgcn_exp2f(x); }
__device__ __forceinline__ float frcp(float x) { return __builtin_amdgcn_rcpf(x); }
__device__ __forceinline__ float sigmoidf_(float x) { return frcp(1.0f + fexp2(-x * LOG2E)); }
__device__ __forceinline__ int otid() { int t = threadIdx.x; asm volatile("" : "+v"(t)); return t; }
__device__ __forceinline__ int crow(int r, int hi) { return (r & 3) + 8 * (r >> 2) + 4 * hi; }
__device__ __forceinline__ s16x4 vtr(const LAS char* p) { return __builtin_bit_cast(s16x4, __builtin_amdgcn_ds_read_tr16_b64_v4i16((LAS s16x4*)p)); }
__device__ __forceinline__ bf16x8 cat8(s16x4 a, s16x4 b) { return (bf16x8){a[0], a[1], a[2], a[3], b[0], b[1], b[2], b[3]}; }
__device__ __forceinline__ bf16x8 pack8(float a0, float a1, float a2, float a3, float a4, float a5, float a6, float a7) {
    u32x4 w = {pk2(a0, a1), pk2(a2, a3), pk2(a4, a5), pk2(a6, a7)}; return __builtin_bit_cast(bf16x8, w);
}
__device__ __forceinline__ u32x4 pack8u(f32x4 a, f32x4 b) { return (u32x4){pk2(a[0], a[1]), pk2(a[2], a[3]), pk2(b[0], b[1]), pk2(b[2], b[3])}; }

#define XB_TMO      128
#define XB_XCNT(j)  (256  + 64 * (j))
#define XB_XSUB(j)  (1280 + 64 * (j))
#define XB_XGEN(j)  (2304 + 64 * (j))
#define XB_TOP      3328
#define XB_TOPGEN   3392
#define XCD_BAR_WORDS 3456
#define XB_SPIN_CAP (1u << 22)
__device__ __forceinline__ unsigned xb_ld(unsigned* p)              { return __hip_atomic_load(p, __ATOMIC_RELAXED, __HIP_MEMORY_SCOPE_AGENT); }
__device__ __forceinline__ unsigned xb_add(unsigned* p, unsigned v) { return __hip_atomic_fetch_add(p, v, __ATOMIC_RELAXED, __HIP_MEMORY_SCOPE_AGENT); }
__device__ __forceinline__ unsigned xb_xcc_id() { return (unsigned)__builtin_amdgcn_s_getreg((3 << 11) | 20) & 0xFu; }
#define XB_SPIN(cond, bar) do { unsigned _sp = 0; while (cond) { __builtin_amdgcn_s_sleep(1); \
    if ((++_sp & 255u) == 0u) { if (xb_ld(&(bar)[XB_TMO])) break; if (_sp > XB_SPIN_CAP) { atomicAdd(&(bar)[XB_TMO], 1u); break; } } } } while (0)
struct XcdBarrier { unsigned* bar; unsigned x; volatile LAS unsigned* st; };
__device__ __forceinline__ XcdBarrier xcd_barrier_post(unsigned* bar, volatile LAS unsigned* st) {
    XcdBarrier b; b.bar = bar; b.x = xb_xcc_id(); b.st = st;
    if (threadIdx.x == 0) (void)xb_add(&bar[XB_XCNT(b.x)], 1u);
    return b;
}
__device__ __forceinline__ void xcd_barrier_complete(unsigned* bar, unsigned x, unsigned& nloc, unsigned& nx) {
    const unsigned G = gridDim.x * gridDim.y * gridDim.z;
    unsigned sum, cnt, mine, sp = 0u;
    for (;;) {
        sum = 0u; cnt = 0u; mine = 0u;
#pragma unroll
        for (unsigned j = 0; j < 16; ++j) { const unsigned c = xb_ld(&bar[XB_XCNT(j)]); sum += c; cnt += (c > 0u) ? 1u : 0u; mine = (j == x) ? c : mine; }
        if (sum == G) break;
        __builtin_amdgcn_s_sleep(1);
        if ((++sp & 255u) == 0u) { if (xb_ld(&bar[XB_TMO])) break; if (sp > XB_SPIN_CAP) { atomicAdd(&bar[XB_TMO], 1u); break; } }
    }
    nloc = mine > 0u ? mine : 1u; nx = cnt > 0u ? cnt : 1u;
}
__device__ __forceinline__ void xcd_barrier(const XcdBarrier& b) {
    asm volatile("s_waitcnt vmcnt(0)" ::: "memory");
    __syncthreads();
    if (threadIdx.x == 0) {
        unsigned* bar = b.bar;
        __builtin_amdgcn_s_waitcnt(0);
        unsigned nloc = b.st[0], nx = b.st[1];
        if (nloc == 0u) { xcd_barrier_complete(bar, b.x, nloc, nx); b.st[0] = nloc; b.st[1] = nx; }
        const unsigned old = xb_add(&bar[XB_XSUB(b.x)], 1u);
        const unsigned gen = old / nloc;
        if (old + 1u == (gen + 1u) * nloc) {
            __builtin_amdgcn_fence(__ATOMIC_RELEASE, "agent");
            asm volatile("s_waitcnt vmcnt(0)" ::: "memory");
            const unsigned og = xb_add(&bar[XB_TOP], 1u);
            const unsigned tg = og / nx;
            if (og + 1u == (tg + 1u) * nx) xb_add(&bar[XB_TOPGEN], 1u);
            else XB_SPIN(xb_ld(&bar[XB_TOPGEN]) == tg, bar);
            __builtin_amdgcn_fence(__ATOMIC_ACQUIRE, "agent");
            xb_add(&bar[XB_XGEN(b.x)], 1u);
            asm volatile("s_waitcnt vmcnt(0)" ::: "memory");
        } else {
            XB_SPIN(xb_ld(&bar[XB_XGEN(b.x)]) == gen, bar);
            __builtin_amdgcn_fence(__ATOMIC_ACQUIRE, "agent");
            asm volatile("s_waitcnt vmcnt(0)" ::: "memory");
        }
    }
    __syncthreads();
}

namespace pg8 {
constexpr int BM = 256, BK = 64, HALF = 128, HTB = HALF * BK * 2, STAGE_BYTES = 8 * HTB, NXCD = 8, WGM = 8;
__device__ __forceinline__ int lds_byte(int r, int c) { const int st = (r >> 4) * 2 + (c >> 5), rr = r & 15, cc = c & 31, ob = rr * 64 + cc * 2; return st * 1024 + (ob ^ (((ob >> 9) & 1) << 5)); }
__device__ __forceinline__ void stage_rc(int b, int& R, int& C) { const int st = b / 1024, sb = b % 1024, swz = sb ^ (((sb >> 9) & 1) << 5); R = (st >> 1) * 16 + swz / 64; C = (st & 1) * 32 + (swz % 64) / 2; }
__device__ __forceinline__ int perm32(int rho) { const int n = rho >> 4, i = rho & 15; return 8 * (i >> 2) + 4 * n + (i & 3); }
struct Unit { int pm, pn, g; };

__device__ __forceinline__ bool static_order(int i, int G, int c, int nM, int nN, int& pm, int& pn) {
    const int nwg = nM * nN; const long L = (long)i * G + c; if (L >= nwg) return false;
    int wgid = (int)L; { const int q = nwg / NXCD, r = nwg % NXCD, xcd = wgid % NXCD, off = wgid / NXCD; wgid = (xcd < r ? xcd * (q + 1) : r * (q + 1) + (xcd - r) * q) + off; }
    const int nig = WGM * nN, gid = wgid / nig, fm = gid * WGM, gsz = (nM - fm) < WGM ? (nM - fm) : WGM;
    pm = fm + ((wgid % nig) % gsz); pn = (wgid % nig) / gsz; return true;
}

template <class Epi, class Sched, bool GATHER>
__device__ __forceinline__ void gemm_phase(LAS unsigned char* lds, const int K, const int lda, const int ldb, const Sched& S, const Epi& E) {
    const int tid = otid(), wid = __builtin_amdgcn_readfirstlane(tid >> 6), lane = tid & 63, wr = wid >> 2, wc = wid & 3, fr = lane & 15, fq = lane >> 4;
    const int nt = K / BK;
    int Rr[2], Cc[2];
    unsigned voffB[2], vAc[2][2];
#pragma unroll
    for (int i = 0; i < 2; ++i) { int R, C; stage_rc(tid * 16 + i * 8192, R, C); Rr[i] = R; Cc[i] = C; const int Rb = (R & ~31) + perm32(R & 31);
        voffB[i] = (unsigned)(Rb * ldb + C) * 2u;
#pragma unroll
        for (int h = 0; h < 2; ++h) vAc[h][i] = (unsigned)((GATHER ? 0 : R) * lda + C) * 2u; }
    const size_t kstep = (size_t)(BK * 2);
    const size_t hstepB = (size_t)HALF * ldb * 2;
    const size_t hstepA = GATHER ? (size_t)0 : (size_t)HALF * lda * 2;
    const unsigned ldsw = (unsigned)wid * 1024u;
    const int aoff = lds_byte(wr * 64 + fr, fq * 8), boff = lds_byte(wc * 32 + fr, fq * 8);
    LAS int* rowtab = (LAS int*)(lds + TAB_OFF + 2048);
#define PG8_SA(b, h) (((b) * 2 + (h)) * HTB)
#define PG8_SB(b, h) ((4 + (b) * 2 + (h)) * HTB)
#define PG8_STAGE(bufoff, gbase, v0, v1) do { \
        __builtin_amdgcn_global_load_lds((const unsigned*)((const char*)(gbase) + (v0)), (LAS unsigned*)(lds + (bufoff) + ldsw), 16, 0, 0); \
        __builtin_amdgcn_global_load_lds((const unsigned*)((const char*)(gbase) + (v1)), (LAS unsigned*)(lds + (bufoff) + ldsw + 8192), 16, 0, 0); } while (0)
#define PG8_STAGEB(bufoff, gbase) PG8_STAGE(bufoff, gbase, voffB[0], voffB[1])
#define PG8_LDA(dst, b, h) do { _Pragma("unroll") for (int m = 0; m < 4; ++m) _Pragma("unroll") for (int k = 0; k < 2; ++k) dst[m][k] = *(const LAS bf16x8*)(lds + PG8_SA(b, h) + aoff + m * 2048 + k * 1024); } while (0)
#define PG8_LDB(dst, b, h) do { _Pragma("unroll") for (int n = 0; n < 2; ++n) _Pragma("unroll") for (int k = 0; k < 2; ++k) dst[n][k] = *(const LAS bf16x8*)(lds + PG8_SB(b, h) + boff + n * 2048 + k * 1024); } while (0)
#define PG8_MMA(ai, bj, At, Bt) do { __builtin_amdgcn_s_setprio(1); _Pragma("unroll") for (int m = 0; m < 4; ++m) _Pragma("unroll") for (int n = 0; n < 2; ++n) _Pragma("unroll") for (int k = 0; k < 2; ++k) \
        acc[ai][bj][m][n] = __builtin_amdgcn_mfma_f32_16x16x32_bf16(Bt[n][k], At[m][k], acc[ai][bj][m][n], 0, 0, 0); __builtin_amdgcn_s_setprio(0); } while (0)
#define PG8_WAIT_V(n) asm volatile("s_waitcnt vmcnt(" #n ")" ::: "memory")
#define PG8_WAIT_L(n) asm volatile("s_waitcnt lgkmcnt(" #n ")" ::: "memory")
#define PG8_BAR __builtin_amdgcn_s_barrier()
#define PG8_SCHED __builtin_amdgcn_sched_barrier(0)
    Unit cur, nxt; int ui = 0;
    if (!S.next(0, cur)) return;
    f32x4 acc[2][2][4][2];
#pragma unroll
    for (int a = 0; a < 2; ++a)
#pragma unroll
        for (int b = 0; b < 2; ++b)
#pragma unroll
            for (int m = 0; m < 4; ++m)
#pragma unroll
                for (int n = 0; n < 2; ++n) acc[a][b][m][n] = (f32x4){0.f, 0.f, 0.f, 0.f};
    bf16x8 At[4][2], B0[2][2], B1[2][2];
    const char* cA = S.a_base(cur); const char* cB = S.b_base(cur);
    if constexpr (GATHER) {
        if (tid < 256) rowtab[tid] = S.a_row(cur, tid);
        PG8_WAIT_V(0); PG8_WAIT_L(0); PG8_BAR;
#pragma unroll
        for (int h = 0; h < 2; ++h)
#pragma unroll
            for (int i = 0; i < 2; ++i) vAc[h][i] = (unsigned)(rowtab[h * HALF + Rr[i]] * lda + Cc[i]) * 2u;
    }
    PG8_STAGEB(PG8_SB(0, 0), cB); PG8_STAGEB(PG8_SB(0, 1), cB + hstepB); PG8_STAGE(PG8_SA(0, 0), cA, vAc[0][0], vAc[0][1]); PG8_STAGE(PG8_SA(0, 1), cA + hstepA, vAc[1][0], vAc[1][1]);
    if (wr == 1) PG8_BAR;
    PG8_WAIT_V(2); PG8_BAR;
    PG8_STAGEB(PG8_SB(1, 0), cB + kstep); PG8_STAGE(PG8_SA(1, 0), cA + kstep, vAc[0][0], vAc[0][1]); PG8_STAGEB(PG8_SB(1, 1), cB + hstepB + kstep);
    PG8_WAIT_V(6); PG8_BAR;
    for (;;) {
        const bool has_next = S.next(ui + 1, nxt);
        const char* nA = has_next ? S.a_base(nxt) : cA; const char* nB = has_next ? S.b_base(nxt) : cB;
        if constexpr (GATHER) {
            if (tid < 256) rowtab[((ui + 1) & 1) * 256 + tid] = has_next ? S.a_row(nxt, tid) : 0;
            PG8_WAIT_V(0);
        }
#pragma unroll 1
        for (int t = 0; t < nt; t += 2) {
            const bool last = (t == nt - 2);
            const char* a1 = cA + (size_t)(t + 1) * kstep;
            const char* a2 = last ? nA : cA + (size_t)(t + 2) * kstep; const char* b2 = last ? nB : cB + (size_t)(t + 2) * kstep;
            const char* a3 = a2 + kstep; const char* b3 = b2 + kstep;
            unsigned v2[2][2];
#pragma unroll
            for (int h = 0; h < 2; ++h)
#pragma unroll
                for (int i = 0; i < 2; ++i) v2[h][i] = vAc[h][i];
            if constexpr (GATHER) { if (last && has_next) {
#pragma unroll
                for (int h = 0; h < 2; ++h)
#pragma unroll
                    for (int i = 0; i < 2; ++i) v2[h][i] = (unsigned)(rowtab[((ui + 1) & 1) * 256 + h * HALF + Rr[i]] * lda + Cc[i]) * 2u; } }
            PG8_LDB(B0, 0, 0); PG8_LDB(B1, 0, 1); PG8_SCHED; PG8_LDA(At, 0, 0); PG8_STAGE(PG8_SA(1, 1), a1 + hstepA, vAc[1][0], vAc[1][1]);
            PG8_WAIT_V(8); PG8_WAIT_L(0); PG8_BAR; PG8_MMA(0, 0, At, B0); PG8_MMA(0, 1, At, B1); PG8_BAR; PG8_SCHED;
            PG8_LDA(At, 0, 1); PG8_STAGEB(PG8_SB(0, 0), b2); PG8_STAGEB(PG8_SB(0, 1), b2 + hstepB); PG8_STAGE(PG8_SA(0, 0), a2, v2[0][0], v2[0][1]);
            PG8_WAIT_V(8); PG8_WAIT_L(0); PG8_BAR; PG8_MMA(1, 0, At, B0); PG8_MMA(1, 1, At, B1); PG8_BAR; PG8_SCHED;
            PG8_LDB(B0, 1, 0); PG8_LDB(B1, 1, 1); PG8_SCHED; PG8_LDA(At, 1, 0); PG8_STAGE(PG8_SA(0, 1), a2 + hstepA, v2[1][0], v2[1][1]);
            PG8_WAIT_V(8); PG8_WAIT_L(0); PG8_BAR; PG8_MMA(0, 0, At, B0); PG8_MMA(0, 1, At, B1); PG8_BAR; PG8_SCHED;
            PG8_LDA(At, 1, 1); PG8_STAGEB(PG8_SB(1, 0), b3); PG8_STAGEB(PG8_SB(1, 1), b3 + hstepB); PG8_STAGE(PG8_SA(1, 0), a3, v2[0][0], v2[0][1]);
            PG8_WAIT_V(8); PG8_WAIT_L(0); PG8_BAR; PG8_MMA(1, 0, At, B0); PG8_MMA(1, 1, At, B1); PG8_BAR; PG8_SCHED;
        }
        if (wr == 0) PG8_BAR;
        { int efr = fr, efq = fq; asm volatile("" : "+v"(efr), "+v"(efq)); E(acc, cur, wr, wc, efr, efq); }
        if (!has_next) break;
#pragma unroll
        for (int a = 0; a < 2; ++a)
#pragma unroll
            for (int b = 0; b < 2; ++b)
#pragma unroll
                for (int m = 0; m < 4; ++m)
#pragma unroll
                    for (int n = 0; n < 2; ++n) acc[a][b][m][n] = (f32x4){0.f, 0.f, 0.f, 0.f};
        cur = nxt; cA = nA; cB = nB; ++ui;
        if constexpr (GATHER) {
#pragma unroll
            for (int h = 0; h < 2; ++h)
#pragma unroll
                for (int i = 0; i < 2; ++i) vAc[h][i] = (unsigned)(rowtab[(ui & 1) * 256 + h * HALF + Rr[i]] * lda + Cc[i]) * 2u;
        }
        if (wr == 1) PG8_BAR;
    }
    PG8_WAIT_V(0);
    PG8_BAR;
#undef PG8_SA
#undef PG8_SB
#undef PG8_STAGE
#undef PG8_STAGEB
#undef PG8_LDA
#undef PG8_LDB
#undef PG8_MMA
#undef PG8_WAIT_V
#undef PG8_WAIT_L
#undef PG8_BAR
#undef PG8_SCHED
}
}
using pg8::Unit;

struct DenseSched {
    int nM, nN, G, c; const char* A; const char* Bt; size_t atile, btile;
    __device__ __forceinline__ bool next(int i, Unit& u) const { u.g = 0; return pg8::static_order(i, G, c, nM, nN, u.pm, u.pn); }
    __device__ __forceinline__ const char* a_base(const Unit& u) const { return A + (size_t)u.pm * atile; }
    __device__ __forceinline__ const char* b_base(const Unit& u) const { return Bt + (size_t)u.pn * btile; }
    __device__ __forceinline__ int a_row(const Unit&, int) const { return 0; }
};
struct GroupSched {
    int nN, G, c; const char* A; const char* Bt; size_t agroup, bgroup, atile, btile;
    __device__ __forceinline__ bool next(int i, Unit& u) const { const long L = (long)i * G + c; if (c < 0 || L >= 16 * 2 * nN) return false; const int per = 2 * nN; u.g = (int)L / per; const int r = (int)L % per; u.pm = r % 2; u.pn = r / 2; return true; }
    __device__ __forceinline__ const char* a_base(const Unit& u) const { return A + (size_t)u.g * agroup + (size_t)u.pm * atile; }
    __device__ __forceinline__ const char* b_base(const Unit& u) const { return Bt + (size_t)u.g * bgroup + (size_t)u.pn * btile; }
    __device__ __forceinline__ int a_row(const Unit&, int) const { return 0; }
};
struct MoeSched {
    int nM, nN, G, c; const char* A; const char* W; size_t wexp, atile, btile;
    const LAS int* cnt; const LAS int* tstart; const LAS unsigned char* tile_e; const int* list;
    __device__ __forceinline__ bool next(int i, Unit& u) const { const bool ok = pg8::static_order(i, G, c, nM, nN, u.pm, u.pn); u.g = ok ? (int)tile_e[u.pm] : 0; return ok; }
    __device__ __forceinline__ const char* a_base(const Unit& u) const { return A + (size_t)u.pm * atile; }
    __device__ __forceinline__ const char* b_base(const Unit& u) const { return W + (size_t)u.g * wexp + (size_t)u.pn * btile; }
    __device__ __forceinline__ int a_row(const Unit& u, int r) const { const int slot = (u.pm - tstart[u.g]) * 256 + r; return slot < cnt[u.g] ? list[(size_t)u.g * T + slot] : 0; }
};

typedef f32x4 Acc[2][2][4][2];
struct EpiProj {
    bf16 *Qimg, *Kimg, *Vimg, *Ug2, *RET; const float *cosA, *sinA, *cosR, *sinR;
    __device__ __forceinline__ void operator()(const Acc& acc, const Unit& u, int wr, int wc, int fr, int fq) const {
        const int pn = u.pn;
#pragma unroll
        for (int ai = 0; ai < 2; ++ai)
#pragma unroll
            for (int m = 0; m < 4; ++m) {
                const int row = u.pm * 256 + ai * 128 + wr * 64 + m * 16 + fr; const int b = row >> 13, t = row & 8191;
                if (pn < 4 || pn == 7 || pn == 8) {
                    const size_t to = (size_t)row * 32 + 8 * fq;
                    const float* ct = (pn < 4 ? cosA : cosR) + to; const float* st = (pn < 4 ? sinA : sinR) + to;
                    const f32x4 c0 = *(const f32x4*)ct, c1 = *(const f32x4*)(ct + 4), s0 = *(const f32x4*)st, s1 = *(const f32x4*)(st + 4);
                    const f32x4 xa0 = acc[ai][0][m][0], xa1 = acc[ai][0][m][1], xb0 = acc[ai][1][m][0], xb1 = acc[ai][1][m][1];
                    const float sc = (pn < 2) ? C2 : (pn == 8 ? 0.125f : 1.0f);
                    const f32x4 o10 = (xa0 * c0 - xb0 * s0) * sc, o11 = (xa1 * c1 - xb1 * s1) * sc, o20 = (xb0 * c0 + xa0 * s0) * sc, o21 = (xb1 * c1 + xa1 * s1) * sc;
                    const u32x4 w1 = pack8u(o10, o11), w2 = pack8u(o20, o21);
                    if (pn < 2) { const int hc = 4 * pn + wc; bf16* p = Qimg + ((size_t)(b * 8 + hc) * 8192 + t) * 64 + 8 * fq; *(u32x4*)p = w1; *(u32x4*)(p + 32) = w2; }
                    else if (pn < 4) { const int hc = 4 * (pn - 2) + wc; bf16* p = Kimg + ((size_t)((b * 8 + hc) * 128 + (t >> 6)) * 8 + fq) * 512 + (t & 63) * 8; *(u32x4*)p = w1; *(u32x4*)(p + 4 * 512) = w2; }
                    else { bf16* p = RET + (size_t)row * 1024 + (pn - 7) * 256 + 64 * wc + 8 * fq; *(u32x4*)p = w1; *(u32x4*)(p + 32) = w2; }
                } else {
#pragma unroll
                    for (int bj = 0; bj < 2; ++bj) {
                        const u32x4 w = pack8u(acc[ai][bj][m][0], acc[ai][bj][m][1]);
                        bf16* p;
                        if (pn < 6) { const int h = 2 * (pn - 4) + bj; p = Vimg + ((size_t)((b * 4 + h) * 128 + (t >> 6)) * 4 + wc) * 2048 + (t & 63) * 32 + 8 * fq; }
                        else if (pn == 6) { const int g = 8 * bj + 2 * wc + (fq >> 1); p = Ug2 + ((size_t)(g * 512 + b * 128 + (t >> 6))) * 1280 + (t & 63) * 16 + 8 * (fq & 1); }
                        else { p = RET + (size_t)row * 1024 + 512 + (pn - 9) * 256 + 128 * bj + 32 * wc + 8 * fq; }
                        *(u32x4*)p = w;
                    }
                }
                asm volatile("" ::: "memory");
            }
    }
};
struct EpiS5S {
    float* S;
    __device__ __forceinline__ void operator()(const Acc& acc, const Unit& u, int wr, int wc, int fr, int fq) const {
#pragma unroll
        for (int ai = 0; ai < 2; ++ai)
#pragma unroll
            for (int m = 0; m < 4; ++m) { float* rowp = S + ((size_t)u.g * 512 + u.pm * 256 + ai * 128 + wr * 64 + m * 16 + fr) * 256 + wc * 32 + 8 * fq;
#pragma unroll
                for (int bj = 0; bj < 2; ++bj) { *(f32x4*)(rowp + bj * 128) = acc[ai][bj][m][0]; *(f32x4*)(rowp + bj * 128 + 4) = acc[ai][bj][m][1]; } }
    }
};
struct EpiS5Y {
    bf16* Yb; const bf16* Ug2; const float* dskip;
    __device__ __forceinline__ void operator()(const Acc& acc, const Unit& u, int wr, int wc, int fr, int fq) const {
#pragma unroll
        for (int ai = 0; ai < 2; ++ai)
#pragma unroll
            for (int m = 0; m < 4; ++m) { const int bc = u.pm * 256 + ai * 128 + wr * 64 + m * 16 + fr;
#pragma unroll
                for (int bj = 0; bj < 2; ++bj) { const int col = u.pn * 256 + bj * 128 + wc * 32 + 8 * fq; const int j = col >> 4, n0 = col & 15;
                    const int tok = bc * 64 + j; const int ch = u.g * 16 + n0;
                    const u32x4 uu = *(const u32x4*)(Ug2 + ((size_t)u.g * 512 + bc) * 1280 + col);
                    const f32x4 d0 = *(const f32x4*)(dskip + ch), d1 = *(const f32x4*)(dskip + ch + 4);
                    float y[8] = {acc[ai][bj][m][0][0] + d0[0] * bflo(uu[0]), acc[ai][bj][m][0][1] + d0[1] * bfhi(uu[0]), acc[ai][bj][m][0][2] + d0[2] * bflo(uu[1]), acc[ai][bj][m][0][3] + d0[3] * bfhi(uu[1]),
                                  acc[ai][bj][m][1][0] + d1[0] * bflo(uu[2]), acc[ai][bj][m][1][1] + d1[1] * bfhi(uu[2]), acc[ai][bj][m][1][2] + d1[2] * bflo(uu[3]), acc[ai][bj][m][1][3] + d1[3] * bfhi(uu[3])};
#pragma unroll
                    for (int e = 0; e < 8; ++e) { const float v = y[e]; const float uarg = 1.5957691216057308f * (v + 0.044715f * v * v * v); y[e] = v * sigmoidf_(uarg); }
                    *(u32x4*)(Yb + (size_t)tok * 256 + ch) = (u32x4){pk2(y[0], y[1]), pk2(y[2], y[3]), pk2(y[4], y[5]), pk2(y[6], y[7])};
                    asm volatile("" ::: "memory");
                } }
    }
};
struct EpiGlu {
    bf16* MIX; const float* bias;
    __device__ __forceinline__ void operator()(const Acc& acc, const Unit& u, int wr, int wc, int fr, int fq) const {
        const int col = u.pn * 128 + wc * 32 + 8 * fq;
#pragma unroll
        for (int ai = 0; ai < 2; ++ai)
#pragma unroll
            for (int m = 0; m < 4; ++m) { const int row = u.pm * 256 + ai * 128 + wr * 64 + m * 16 + fr;
                const f32x4 ba0 = *(const f32x4*)(bias + col), ba1 = *(const f32x4*)(bias + col + 4), bb0 = *(const f32x4*)(bias + 256 + col), bb1 = *(const f32x4*)(bias + 256 + col + 4);
                const f32x4 a0 = acc[ai][0][m][0] + ba0, a1 = acc[ai][0][m][1] + ba1, g0 = acc[ai][1][m][0] + bb0, g1 = acc[ai][1][m][1] + bb1;
                f32x4 o0, o1;
#pragma unroll
                for (int e = 0; e < 4; ++e) { o0[e] = a0[e] * sigmoidf_(g0[e]); o1[e] = a1[e] * sigmoidf_(g1[e]); }
                *(u32x4*)(MIX + (size_t)row * 1024 + 512 + col) = pack8u(o0, o1); asm volatile("" ::: "memory"); }
    }
};
struct EpiOut {
    float* YPRE; const float* x; const float* mod;
    __device__ __forceinline__ void operator()(const Acc& acc, const Unit& u, int wr, int wc, int fr, int fq) const {
#pragma unroll
        for (int ai = 0; ai < 2; ++ai)
#pragma unroll
            for (int m = 0; m < 4; ++m) { const int row = u.pm * 256 + ai * 128 + wr * 64 + m * 16 + fr; const int b = row >> 13;
#pragma unroll
                for (int bj = 0; bj < 2; ++bj) { const int col = u.pn * 256 + bj * 128 + wc * 32 + 8 * fq;
                    const float* gp = mod + (size_t)b * 6144 + 2048 + col; const float* xp = x + (size_t)row * 1024 + col; float* op = YPRE + (size_t)row * 1024 + col;
                    const f32x4 g0 = *(const f32x4*)gp, g1 = *(const f32x4*)(gp + 4), x0 = *(const f32x4*)xp, x1 = *(const f32x4*)(xp + 4);
                    *(f32x4*)op = x0 * DN_ALPHA + (g0 + 1.0f) * acc[ai][bj][m][0]; *(f32x4*)(op + 4) = x1 * DN_ALPHA + (g1 + 1.0f) * acc[ai][bj][m][1]; asm volatile("" ::: "memory"); } }
    }
};
struct EpiMoe1 {
    bf16* A2; const float* b1;
    __device__ __forceinline__ void operator()(const Acc& acc, const Unit& u, int wr, int wc, int fr, int fq) const {
        const int j0 = u.pn * 128 + wc * 32 + 8 * fq;
        const float* bp = b1 + (size_t)u.g * 2048 + 2 * j0;
#pragma unroll
        for (int ai = 0; ai < 2; ++ai)
#pragma unroll
            for (int m = 0; m < 4; ++m) { const size_t slot = (size_t)u.pm * 256 + ai * 128 + wr * 64 + m * 16 + fr;
                const f32x4 q0 = *(const f32x4*)bp, q1 = *(const f32x4*)(bp + 4), q2 = *(const f32x4*)(bp + 8), q3 = *(const f32x4*)(bp + 12);
                const float bg[8] = {q0[0], q0[2], q1[0], q1[2], q2[0], q2[2], q3[0], q3[2]}, bl[8] = {q0[1], q0[3], q1[1], q1[3], q2[1], q2[3], q3[1], q3[3]};
                float o[8];
#pragma unroll
                for (int e = 0; e < 8; ++e) { float zg = acc[ai][0][m][e >> 2][e & 3] + bg[e], zl = acc[ai][1][m][e >> 2][e & 3] + bl[e];
                    zg = fminf(zg, 7.0f); zl = fminf(fmaxf(zl, -7.0f), 7.0f); o[e] = zg * sigmoidf_(1.702f * zg) * (zl + 1.0f); }
                *(u32x4*)(A2 + slot * 1024 + j0) = (u32x4){pk2(o[0], o[1]), pk2(o[2], o[3]), pk2(o[4], o[5]), pk2(o[6], o[7])}; asm volatile("" ::: "memory"); }
    }
};
struct EpiMoe2 {
    bf16* YS; const float* b2;
    __device__ __forceinline__ void operator()(const Acc& acc, const Unit& u, int wr, int wc, int fr, int fq) const {
#pragma unroll
        for (int bj = 0; bj < 2; ++bj) { const int col = u.pn * 256 + bj * 128 + wc * 32 + 8 * fq; const float* bp = b2 + (size_t)u.g * 1024 + col;
            const f32x4 c0 = *(const f32x4*)bp, c1 = *(const f32x4*)(bp + 4);
#pragma unroll
            for (int ai = 0; ai < 2; ++ai)
#pragma unroll
                for (int m = 0; m < 4; ++m) { const size_t slot = (size_t)u.pm * 256 + ai * 128 + wr * 64 + m * 16 + fr;
                    *(u32x4*)(YS + slot * 1024 + col) = pack8u(acc[ai][bj][m][0] + c0, acc[ai][bj][m][1] + c1); } asm volatile("" ::: "memory"); }
    }
};

struct Args {
    const void* in[30]; float* out; unsigned char* ws;
    double invfA[32], invfR[32];
    float lam_init[4];
    float lg2f[4], lg2b[4];
    int ph_lo, ph_hi;
};

template <int PERM>
__device__ __forceinline__ int perm_row(int o) {
    if (PERM == 1) { const int pn = o >> 8; if (pn < 4 || pn == 7 || pn == 8) { const int x = o & 255; return (o & ~255) + 128 * ((x >> 5) & 1) + 32 * (x >> 6) + (x & 31); } return o; }
    if (PERM == 2) return (o >> 8) * 256 + 128 * (o & 1) + ((o >> 1) & 127);
    if (PERM == 3) return 256 * ((o >> 7) & 1) + 128 * (o >> 8) + (o & 127);
    return o;
}
template <int PERM>
__device__ __forceinline__ void transpose_item(const float* W, int K, int N, bf16* WT, LAS float* scr, int item, int lane) {
    const int nblk = N / 32, kb = item / nblk, nb = item % nblk, k0 = 64 * kb, n0 = 32 * nb;
#pragma unroll 8
    for (int i = 0; i < 32; ++i) { const int kk = 2 * i + (lane >> 5); scr[kk * 33 + (lane & 31)] = W[(size_t)(k0 + kk) * N + n0 + (lane & 31)]; }
    asm volatile("s_waitcnt lgkmcnt(0)" ::: "memory");
    const int c = lane & 7;
#pragma unroll
    for (int j = 0; j < 4; ++j) { const int n = (lane >> 3) + 8 * j; const LAS float* s = scr + (8 * c) * 33 + n;
        u32x4 o; o.x = pk2(s[0 * 33], s[1 * 33]); o.y = pk2(s[2 * 33], s[3 * 33]); o.z = pk2(s[4 * 33], s[5 * 33]); o.w = pk2(s[6 * 33], s[7 * 33]);
        *(u32x4*)(WT + (size_t)perm_row<PERM>(n0 + n) * K + k0 + 8 * c) = o; }
    asm volatile("s_waitcnt lgkmcnt(0)" ::: "memory");
}
__device__ __forceinline__ void sincos_rev(double ang, float& c, float& s) {
    double rev = ang * 0.15915494309189535; rev -= __builtin_rint(rev); const float r = (float)rev;
    c = __builtin_amdgcn_cosf(r); s = __builtin_amdgcn_sinf(r);
}

__device__ __forceinline__ void row_stats(const f32x4 (&v)[4], float& mean, float& rstd) {
    float s = 0.f;
#pragma unroll
    for (int j = 0; j < 4; ++j) s += (v[j][0] + v[j][1]) + (v[j][2] + v[j][3]);
    mean = wave_sum(s) * (1.f / DM); float q = 0.f;
#pragma unroll
    for (int j = 0; j < 4; ++j) { const f32x4 d = v[j] - mean; q += (d[0] * d[0] + d[1] * d[1]) + (d[2] * d[2] + d[3] * d[3]); }
    rstd = 1.0f / sqrtf(wave_sum(q) * (1.f / DM) + LN_EPS);
}
__device__ __forceinline__ void mod_row_store(const f32x4 (&v)[4], const float* sh, const float* sc, bf16* orow, int lane) {
    float mean, rstd; row_stats(v, mean, rstd);
#pragma unroll
    for (int j = 0; j < 4; ++j) { const int col = 4 * lane + 256 * j; const f32x4 a = *(const f32x4*)(sc + col), b = *(const f32x4*)(sh + col);
        const f32x4 h = (v[j] - mean) * rstd * (a + 1.0f) + b; *(u32x2*)(orow + col) = (u32x2){pk2(h[0], h[1]), pk2(h[2], h[3])}; }
}

struct Top4 { float t0, t1, t2, t3; int i0, i1, i2, i3; };
__device__ __forceinline__ void top4_init(Top4& q) { q.t0 = q.t1 = q.t2 = q.t3 = -INFINITY; q.i0 = q.i1 = q.i2 = q.i3 = 0; }
__device__ __forceinline__ void top4_insert(Top4& q, float x, int e) {
    const bool c3 = x > q.t3; q.t3 = c3 ? x : q.t3; q.i3 = c3 ? e : q.i3;
    const bool c2 = q.t3 > q.t2; { const float a = q.t2, b = q.t3; const int ia = q.i2, ib = q.i3; q.t2 = c2 ? b : a; q.t3 = c2 ? a : b; q.i2 = c2 ? ib : ia; q.i3 = c2 ? ia : ib; }
    const bool c1 = q.t2 > q.t1; { const float a = q.t1, b = q.t2; const int ia = q.i1, ib = q.i2; q.t1 = c1 ? b : a; q.t2 = c1 ? a : b; q.i1 = c1 ? ib : ia; q.i2 = c1 ? ia : ib; }
    const bool c0 = q.t1 > q.t0; { const float a = q.t0, b = q.t1; const int ia = q.i0, ib = q.i1; q.t0 = c0 ? b : a; q.t1 = c0 ? a : b; q.i0 = c0 ? ib : ia; q.i1 = c0 ? ia : ib; }
}

__device__ __forceinline__ void attn_unit(LAS unsigned char* lds, const bf16* Qimg, const bf16* Kimg, const bf16* Vimg, bf16* MIX, const int b, const int h, const int qb,
                                          const float lam, const float* subg, const float outscale) {
    const int tid = otid(), lane = tid & 63, r32 = lane & 31, hi = lane >> 5; const int wid = __builtin_amdgcn_readfirstlane(tid >> 6);
    const int comp = wid & 1, qsub = wid >> 1, hc = 2 * h + comp;
    const bf16* Qw = Qimg + ((size_t)(b * 8 + hc) * 8192 + qb * 128 + qsub * 32 + r32) * 64;
    bf16x8 qr[4];
#pragma unroll
    for (int d0 = 0; d0 < 4; ++d0) qr[d0] = *(const bf16x8*)(Qw + d0 * 16 + hi * 8);
    const bf16* K1 = Kimg + (size_t)((b * 8 + 2 * h) * 128) * 4096 + tid * 8;
    const bf16* K2 = Kimg + (size_t)((b * 8 + 2 * h + 1) * 128) * 4096 + tid * 8;
    const bf16* Vg = Vimg + (size_t)((b * 4 + h) * 128) * 8192 + tid * 8;
    LAS float* wsf = (LAS float*)(lds + 65536) + wid * 64;
    f32x16 o[4];
#pragma unroll
    for (int d = 0; d < 4; ++d) o[d] = (f32x16){};
    float mrow = 0.f, lrow = 0.f;
    u32x4 g0, g1, g2, g3;
    g0 = *(const u32x4*)K1; g1 = *(const u32x4*)K2; g2 = *(const u32x4*)Vg; g3 = *(const u32x4*)(Vg + 4096);
    *(LAS u32x4*)(lds + tid * 16) = g0; *(LAS u32x4*)(lds + 8192 + tid * 16) = g1; *(LAS u32x4*)(lds + 16384 + tid * 16) = g2; *(LAS u32x4*)(lds + 24576 + tid * 16) = g3;
    __syncthreads();
    const int vlane = ((lane & 15) >> 2) * 64 + ((lane >> 4) & 1) * 32 + (lane & 3) * 8 + hi * 256;
    for (int t = 0; t < 128; ++t) {
        const LAS unsigned char* st = lds + (t & 1) * 32768;
        if (t + 1 < 128) { g0 = *(const u32x4*)(K1 + (size_t)(t + 1) * 4096); g1 = *(const u32x4*)(K2 + (size_t)(t + 1) * 4096); g2 = *(const u32x4*)(Vg + (size_t)(t + 1) * 8192); g3 = *(const u32x4*)(Vg + (size_t)(t + 1) * 8192 + 4096); }
        f32x16 p0, p1;
#pragma unroll
        for (int r = 0; r < 16; ++r) { p0[r] = -mrow; p1[r] = -mrow; }
        const LAS unsigned char* Ks = st + comp * 8192 + hi * 1024 + r32 * 16;
#pragma unroll
        for (int d0 = 0; d0 < 4; ++d0) {
            const bf16x8 a0 = *(const LAS bf16x8*)(Ks + d0 * 2048), a1 = *(const LAS bf16x8*)(Ks + d0 * 2048 + 512);
            p0 = __builtin_amdgcn_mfma_f32_32x32x16_bf16(a0, qr[d0], p0, 0, 0, 0);
            p1 = __builtin_amdgcn_mfma_f32_32x32x16_bf16(a1, qr[d0], p1, 0, 0, 0);
        }
        float rm = fmaxf(p0[0], p1[0]);
#pragma unroll
        for (int r = 1; r < 16; ++r) rm = fmaxf(rm, fmaxf(p0[r], p1[r]));
        rm = swap32_max(rm);
        const bool need = (t == 0) || (rm > 6.0f);
        if (__any(need)) {
            const float dl = need ? rm : 0.f;
            mrow += dl;
#pragma unroll
            for (int r = 0; r < 16; ++r) { p0[r] -= dl; p1[r] -= dl; }
            if (t > 0) {
                const float f = fexp2(-dl); lrow *= f;
                if (hi == 0) wsf[r32] = f;
                asm volatile("s_waitcnt lgkmcnt(0)" ::: "memory");
#pragma unroll
                for (int r = 0; r < 16; ++r) { const float fr_ = wsf[crow(r, hi)];
#pragma unroll
                    for (int d = 0; d < 4; ++d) o[d][r] *= fr_; }
            }
        }
        float ls = 0.f;
#pragma unroll
        for (int r = 0; r < 16; ++r) { p0[r] = fexp2(p0[r]); p1[r] = fexp2(p1[r]); ls += p0[r] + p1[r]; }
        lrow += ls;
        const bf16x8 pa0 = pack8(p0[0], p0[1], p0[2], p0[3], p0[4], p0[5], p0[6], p0[7]), pa1 = pack8(p0[8], p0[9], p0[10], p0[11], p0[12], p0[13], p0[14], p0[15]);
        const bf16x8 pa2 = pack8(p1[0], p1[1], p1[2], p1[3], p1[4], p1[5], p1[6], p1[7]), pa3 = pack8(p1[8], p1[9], p1[10], p1[11], p1[12], p1[13], p1[14], p1[15]);
        const LAS char* Vs = (const LAS char*)st + 16384 + vlane;
#pragma unroll
        for (int d = 0; d < 4; ++d) {
            const bf16x8 v0 = cat8(vtr(Vs + d * 4096), vtr(Vs + d * 4096 + 512));
            const bf16x8 v1 = cat8(vtr(Vs + d * 4096 + 1024), vtr(Vs + d * 4096 + 1536));
            const bf16x8 v2 = cat8(vtr(Vs + d * 4096 + 2048), vtr(Vs + d * 4096 + 2560));
            const bf16x8 v3 = cat8(vtr(Vs + d * 4096 + 3072), vtr(Vs + d * 4096 + 3584));
            o[d] = __builtin_amdgcn_mfma_f32_32x32x16_bf16(pa0, v0, o[d], 0, 0, 0);
            o[d] = __builtin_amdgcn_mfma_f32_32x32x16_bf16(pa1, v1, o[d], 0, 0, 0);
            o[d] = __builtin_amdgcn_mfma_f32_32x32x16_bf16(pa2, v2, o[d], 0, 0, 0);
            o[d] = __builtin_amdgcn_mfma_f32_32x32x16_bf16(pa3, v3, o[d], 0, 0, 0);
        }
        if (t + 1 < 128) { LAS unsigned char* sn = lds + ((t + 1) & 1) * 32768 + tid * 16;
            *(LAS u32x4*)(sn) = g0; *(LAS u32x4*)(sn + 8192) = g1; *(LAS u32x4*)(sn + 16384) = g2; *(LAS u32x4*)(sn + 24576) = g3; }
        __syncthreads();
    }
    lrow = swap32_add(lrow);
    if (hi == 0) wsf[r32] = frcp(lrow);
    asm volatile("s_waitcnt lgkmcnt(0)" ::: "memory");
#pragma unroll
    for (int r = 0; r < 16; ++r) { const float il = wsf[crow(r, hi)];
#pragma unroll
        for (int d = 0; d < 4; ++d) o[d][r] *= il; }
    LAS float* xb = (LAS float*)lds + (size_t)qsub * 4096 + lane;
    if (comp == 1) {
#pragma unroll
        for (int d = 0; d < 4; ++d)
#pragma unroll
            for (int r = 0; r < 16; ++r) xb[(d * 16 + r) * 64] = o[d][r];
    }
    __syncthreads();
    if (comp == 0) {
        float ss[16];
#pragma unroll
        for (int r = 0; r < 16; ++r) { ss[r] = 0.f;
#pragma unroll
            for (int d = 0; d < 4; ++d) { const float v = o[d][r] - lam * xb[(d * 16 + r) * 64]; o[d][r] = v; ss[r] += v * v; } }
        float gcol[4];
#pragma unroll
        for (int d = 0; d < 4; ++d) gcol[d] = subg[d * 32 + r32] * outscale;
#pragma unroll
        for (int r = 0; r < 16; ++r) { const float tot = half_sum(ss[r]); const float rs = 1.0f / sqrtf(tot * (1.f / 128.f) + LN_EPS);
            bf16* orow = MIX + ((size_t)b * 8192 + qb * 128 + qsub * 32 + crow(r, hi)) * 1024 + h * 128 + r32;
#pragma unroll
            for (int d = 0; d < 4; ++d) orow[d * 32] = (bf16)(pk2(o[d][r] * rs * gcol[d], 0.f) & 0xffffu); }
    }
    __syncthreads();
}

__device__ __forceinline__ void ret_kv_pair(LAS unsigned char* lds, const bf16* RET, float* RKV, const int unit0, const float* lg2f, const float* lg2b) {
    const int tid = otid(), lane = tid & 63, r32 = lane & 31, hi = lane >> 5; const int wid = __builtin_amdgcn_readfirstlane(tid >> 6);
    const int wg = wid >> 2, w4 = wid & 3, t4 = tid & 255;
    const int unit = unit0 + wg; const int bh = unit >> 6, n = unit & 63, b = bh >> 2, h = bh & 3;
    LAS unsigned char* base = lds + wg * 49152;
    const float l2f = lg2f[h], l2b = lg2b[h];
    const bf16* src = RET + ((size_t)b * 8192 + n * 128) * 1024 + 64 * h;
#pragma unroll
    for (int i = 0; i < 4; ++i) { const int idx = t4 + 256 * i; const int j = idx >> 3, c = idx & 7;
        const u32x4 kk = *(const u32x4*)(src + (size_t)j * 1024 + 256 + c * 8); const u32x4 vv = *(const u32x4*)(src + (size_t)j * 1024 + 512 + c * 8);
        const float wf = fexp2((float)(127 - j) * l2f), wb = fexp2((float)j * l2b);
        u32x4 vf, vb;
#pragma unroll
        for (int e = 0; e < 4; ++e) { const float lo = bflo(vv[e]), hh = bfhi(vv[e]); vf[e] = pk2(lo * wf, hh * wf); vb[e] = pk2(lo * wb, hh * wb); }
        *(LAS u32x4*)(base + j * 128 + c * 16) = kk; *(LAS u32x4*)(base + 16384 + j * 128 + c * 16) = vf; *(LAS u32x4*)(base + 32768 + j * 128 + c * 16) = vb; }
    __syncthreads();
    const int da = w4 >> 1, eb = w4 & 1;
    const int rowoff = (8 * hi + ((lane & 15) >> 2)) * 128 + (16 * ((lane >> 4) & 1) + 4 * (lane & 3)) * 2;
    f32x16 af = (f32x16){}, ab = (f32x16){};
#pragma unroll
    for (int s = 0; s < 8; ++s) {
        const LAS char* kp = (const LAS char*)base + s * 2048 + rowoff + da * 64;
        const LAS char* vp = (const LAS char*)base + 16384 + s * 2048 + rowoff + eb * 64;
        const bf16x8 ka = cat8(vtr(kp), vtr(kp + 512));
        const bf16x8 vf = cat8(vtr(vp), vtr(vp + 512)), vb = cat8(vtr(vp + 16384), vtr(vp + 16384 + 512));
        af = __builtin_amdgcn_mfma_f32_32x32x16_bf16(ka, vf, af, 0, 0, 0);
        ab = __builtin_amdgcn_mfma_f32_32x32x16_bf16(ka, vb, ab, 0, 0, 0);
    }
    float* of = RKV + ((size_t)(bh * 64 + n) * 2) * 4096 + eb * 32 + r32;
#pragma unroll
    for (int r = 0; r < 16; ++r) { const int d = da * 32 + crow(r, hi); of[d * 64] = af[r]; of[4096 + d * 64] = ab[r]; }
    __syncthreads();
}
__device__ __forceinline__ void ret_out_pair(LAS unsigned char* lds, const bf16* RET, const bf16* RST, bf16* MIX, const int unit0, const float* lg2f, const float* lg2b) {
    const int tid = otid(), lane = tid & 63, r32 = lane & 31, hi = lane >> 5; const int wid = __builtin_amdgcn_readfirstlane(tid >> 6);
    const int wg = wid >> 2, w4 = wid & 3, t4 = tid & 255;
    const int unit = unit0 + wg; const int bh = unit >> 6, n = unit & 63, b = bh >> 2, h = bh & 3;
    LAS unsigned char* base = lds + wg * 49152;
    const float l2f = lg2f[h], l2b = lg2b[h];
    const size_t row0 = (size_t)b * 8192 + n * 128;
    const bf16* src = RET + row0 * 1024 + 64 * h;
#pragma unroll
    for (int i = 0; i < 4; ++i) { const int idx = t4 + 256 * i; const int j = idx >> 3, c = idx & 7;
        *(LAS u32x4*)(base + j * 128 + c * 16) = *(const u32x4*)(src + (size_t)j * 1024 + 256 + c * 8);
        *(LAS u32x4*)(base + 16384 + j * 128 + c * 16) = *(const u32x4*)(src + (size_t)j * 1024 + 512 + c * 8); }
    const bf16* rs = RST + ((size_t)(bh * 64 + n) * 2) * 4096;
#pragma unroll
    for (int i = 0; i < 4; ++i) { const int idx = t4 + 256 * i;
        *(LAS u32x4*)(base + 32768 + idx * 16) = *(const u32x4*)(rs + (size_t)idx * 8); }
    bf16x8 qr[4];
    const bf16* qp = src + (size_t)(32 * w4 + r32) * 1024;
#pragma unroll
    for (int d0 = 0; d0 < 4; ++d0) qr[d0] = *(const bf16x8*)(qp + d0 * 16 + hi * 8);
    __syncthreads();
    const int cq = 32 * w4 + r32;
    f32x16 yi[2] = {(f32x16){}, (f32x16){}}, yf[2] = {(f32x16){}, (f32x16){}}, yb[2] = {(f32x16){}, (f32x16){}};
    const int trl = ((lane & 15) >> 2) * 128 + (16 * ((lane >> 4) & 1) + 4 * (lane & 3)) * 2;
#pragma unroll
    for (int kb = 0; kb < 4; ++kb) {
        f32x16 p = (f32x16){};
#pragma unroll
        for (int d0 = 0; d0 < 4; ++d0) { const bf16x8 a = *(const LAS bf16x8*)(base + (32 * kb + r32) * 128 + (16 * d0 + 8 * hi) * 2); p = __builtin_amdgcn_mfma_f32_32x32x16_bf16(a, qr[d0], p, 0, 0, 0); }
#pragma unroll
        for (int r = 0; r < 16; ++r) { const int j = 32 * kb + crow(r, hi); const int rel = cq - j; p[r] *= fexp2(rel >= 0 ? (float)rel * l2f : (float)(-rel) * l2b); }
        const bf16x8 pa0 = pack8(p[0], p[1], p[2], p[3], p[4], p[5], p[6], p[7]), pa1 = pack8(p[8], p[9], p[10], p[11], p[12], p[13], p[14], p[15]);
#pragma unroll
        for (int eb = 0; eb < 2; ++eb) {
            const LAS char* vp = (const LAS char*)base + 16384 + (32 * kb + 4 * hi) * 128 + trl + eb * 64;
            const bf16x8 v0 = cat8(vtr(vp), vtr(vp + 8 * 128)), v1 = cat8(vtr(vp + 16 * 128), vtr(vp + 24 * 128));
            yi[eb] = __builtin_amdgcn_mfma_f32_32x32x16_bf16(pa0, v0, yi[eb], 0, 0, 0);
            yi[eb] = __builtin_amdgcn_mfma_f32_32x32x16_bf16(pa1, v1, yi[eb], 0, 0, 0);
        }
    }
#pragma unroll
    for (int d0 = 0; d0 < 4; ++d0)
#pragma unroll
        for (int eb = 0; eb < 2; ++eb) {
            const LAS char* rp = (const LAS char*)base + 32768 + (16 * d0 + 8 * hi) * 128 + trl + eb * 64;
            const bf16x8 rf = cat8(vtr(rp), vtr(rp + 4 * 128)), rb = cat8(vtr(rp + 8192), vtr(rp + 8192 + 4 * 128));
            yf[eb] = __builtin_amdgcn_mfma_f32_32x32x16_bf16(qr[d0], rf, yf[eb], 0, 0, 0);
            yb[eb] = __builtin_amdgcn_mfma_f32_32x32x16_bf16(qr[d0], rb, yb[eb], 0, 0, 0);
        }
#pragma unroll
    for (int r = 0; r < 16; ++r) {
        const int c = 32 * w4 + crow(r, hi);
        const float sf = fexp2((float)(c + 1) * l2f), sb = fexp2((float)(128 - c) * l2b);
        const float y0 = yi[0][r] + sf * yf[0][r] + sb * yb[0][r], y1 = yi[1][r] + sf * yf[1][r] + sb * yb[1][r];
        const float mean = half_sum(y0 + y1) * (1.f / 64.f); const float d0_ = y0 - mean, d1_ = y1 - mean;
        const float var = half_sum(d0_ * d0_ + d1_ * d1_) * (1.f / 64.f); const float rstd = 1.0f / sqrtf(var + LN_EPS);
        const bf16* gp = RET + (row0 + c) * 1024 + 768 + 64 * h + r32; bf16* op = MIX + (row0 + c) * 1024 + 768 + 64 * h + r32;
        const float g0 = bf2f(gp[0]), g1 = bf2f(gp[32]);
        op[0] = (bf16)(pk2(g0 * sigmoidf_(g0) * d0_ * rstd, 0.f) & 0xffffu); op[32] = (bf16)(pk2(g1 * sigmoidf_(g1) * d1_ * rstd, 0.f) & 0xffffu);
    }
    __syncthreads();
}

__device__ __forceinline__ int moe_tables(LAS unsigned char* lds, const unsigned* gcnt) {
    LAS int* cnt = (LAS int*)(lds + TAB_OFF); LAS int* tstart = cnt + 32; LAS unsigned char* tile_e = (LAS unsigned char*)(tstart + 36);
    const int tid = otid();
    if (tid < 32) cnt[tid] = (int)gcnt[tid];
    __syncthreads();
    if (tid == 0) { int s = 0; for (int e = 0; e < 32; ++e) { tstart[e] = s; s += (cnt[e] + 255) >> 8; } tstart[32] = s; }
    __syncthreads();
    const int ntile = tstart[32];
    for (int p = tid; p < ntile; p += NTHR) { int e = 0;
#pragma unroll
        for (int k = 1; k < 32; ++k) e += (tstart[k] <= p) ? 1 : 0;
        tile_e[p] = (unsigned char)e; }
    __syncthreads();
    return ntile;
}

constexpr int NPH_LAYER = 10, NPH = 3 + DEPTH * NPH_LAYER;
#ifndef PH_MASK
#define PH_MASK 0x1FFFF
#endif
#define PHM(j) (((PH_MASK) >> (j)) & 1)
#ifndef DUP_MASK
#define DUP_MASK 0x0
#endif
#define NREP(j) (1 + (((DUP_MASK) >> (j)) & 1))
__global__ void __launch_bounds__(NTHR, 2) hybrid_fwd(Args args) {
    extern __shared__ __attribute__((aligned(16))) unsigned char lds_raw[];
    LAS unsigned char* lds = (LAS unsigned char*)lds_raw;
    volatile LAS unsigned* MISC = (volatile LAS unsigned*)(lds + MISC_OFF);
    const int G = gridDim.x, bx = blockIdx.x;
    const int NGW = G * NWAVES, NGT = G * NTHR;
#define PH_IDS const int tid = otid(); const int lane = tid & 63; const int wave = __builtin_amdgcn_readfirstlane(tid >> 6); const int gw = bx * NWAVES + wave; const int gt = bx * NTHR + tid; (void)lane; (void)gw; (void)gt; (void)wave;
    unsigned char* ws = args.ws;
    unsigned* ctl = (unsigned*)(ws + WS_CTL);
    for (int u = threadIdx.x; u < (LDS_BYTES - LDSCTL_OFF) / 4; u += NTHR) ((LAS unsigned*)(lds + LDSCTL_OFF))[u] = 0u;
    __syncthreads();
#if MK_SPLIT
    XcdBarrier bar; bar.bar = ctl + CW_BAR; bar.x = 0; bar.st = nullptr;
#define GRID_BAR() do { } while (0)
#else
    XcdBarrier bar = xcd_barrier_post(ctl + CW_BAR, MISC + 8);
#define GRID_BAR() xcd_barrier(bar)
#endif
    const int lo = args.ph_lo, hi_ph = args.ph_hi;
#define IN(k) (lo <= (k) && (k) < hi_ph)
#ifndef BAR_REP
#define BAR_REP 1
#endif
#define SEAM(k) do { if (IN((k) + 1)) { for (int br_ = 0; br_ < BAR_REP; ++br_) GRID_BAR(); } } while (0)

    const float* x_in = (const float*)args.in[0]; const float* c_in = (const float*)args.in[1]; const int* pos_in = (const int*)args.in[2];
    const float* ada_w = (const float*)args.in[3]; const float* ada_b = (const float*)args.in[4];
    const float* w_in = (const float*)args.in[5]; const float* w_out = (const float*)args.in[6];
    const float* lq1 = (const float*)args.in[7]; const float* lk1 = (const float*)args.in[8]; const float* lq2 = (const float*)args.in[9]; const float* lk2 = (const float*)args.in[10];
    const float* subln_g = (const float*)args.in[11];
    const float* s5_lre = (const float*)args.in[12]; const float* s5_lim = (const float*)args.in[13]; const float* s5_ls = (const float*)args.in[14];
    const float* s5_bre = (const float*)args.in[15]; const float* s5_bim = (const float*)args.in[16]; const float* s5_cre = (const float*)args.in[17]; const float* s5_cim = (const float*)args.in[18];
    const float* s5_d = (const float*)args.in[19]; const float* glu_w = (const float*)args.in[20]; const float* glu_b = (const float*)args.in[21];
    const float* ln_g = (const float*)args.in[22]; const float* ln_b = (const float*)args.in[23];
    const float* router_w = (const float*)args.in[24]; const float* router_b = (const float*)args.in[25];
    const float* exp_w1 = (const float*)args.in[26]; const float* exp_b1 = (const float*)args.in[27]; const float* exp_w2 = (const float*)args.in[28]; const float* exp_b2 = (const float*)args.in[29];
    float* MOD = (float*)(ws + WS_MOD); float* ROT = (float*)(ws + WS_ROT); float* PW = (float*)(ws + WS_PW); float* BB = (float*)(ws + WS_BB);
    bf16* WIN = (bf16*)(ws + WS_WIN); bf16* WOUT = (bf16*)(ws + WS_WOUT); bf16* GLU = (bf16*)(ws + WS_GLU); bf16* W1S = (bf16*)(ws + WS_W1S); bf16* TW = (bf16*)(ws + WS_TW);
    bf16* W1 = (bf16*)(ws + WS_W1); bf16* W2 = (bf16*)(ws + WS_W2); bf16* HB = (bf16*)(ws + WS_HB);
    bf16* QIMG = (bf16*)(ws + WS_QIMG); bf16* KIMG = (bf16*)(ws + WS_KIMG); bf16* VIMG = (bf16*)(ws + WS_VIMG); bf16* UG2 = (bf16*)(ws + WS_UG2); bf16* RET = (bf16*)(ws + WS_RET);
    float* S5S = (float*)(ws + WS_S5S); bf16* YB = (bf16*)(ws + WS_YB); float* RKV = (float*)(ws + WS_RKV); bf16* RST = (bf16*)(ws + WS_RST); bf16* MIX = (bf16*)(ws + WS_MIX);
    float* YPRE = (float*)(ws + WS_YPRE); float* X1 = (float*)(ws + WS_X1); float* XB = (float*)(ws + WS_XB);
    int* LIST = (int*)(ws + WS_LIST); int* TOKI = (int*)(ws + WS_TOKI); float* GATE = (float*)(ws + WS_GATE); bf16* A2 = (bf16*)(ws + WS_A2); bf16* YS = (bf16*)(ws + WS_YS);
    float* COSA = ROT, *SINA = ROT + (size_t)T * 32, *COSR = ROT + (size_t)T * 64, *SINR = ROT + (size_t)T * 96;

    if (PHM(10) && IN(0)) {
        PH_IDS
        for (int rep = 0; rep < NREP(10); ++rep) {
        LAS float* cond = (LAS float*)lds; LAS float* red = (LAS float*)(lds + 16384);
        for (int i = tid; i < 4096; i += NTHR) { const float v = c_in[i]; cond[i] = v * sigmoidf_(v); }
        __syncthreads();
        for (int it = bx; it < 4 * 96; it += G) {
            const int l = it / 96, n0 = (it % 96) * 64;
            float a0 = 0.f, a1 = 0.f, a2 = 0.f, a3 = 0.f;
            const float* wp = ada_w + ((size_t)l * 1024 + wave * 128) * 6144 + n0 + lane;
#pragma unroll 8
            for (int kk = 0; kk < 128; ++kk) { const float wv = wp[(size_t)kk * 6144]; const int k = wave * 128 + kk; a0 += cond[k] * wv; a1 += cond[1024 + k] * wv; a2 += cond[2048 + k] * wv; a3 += cond[3072 + k] * wv; }
            red[(wave * 4 + 0) * 64 + lane] = a0; red[(wave * 4 + 1) * 64 + lane] = a1; red[(wave * 4 + 2) * 64 + lane] = a2; red[(wave * 4 + 3) * 64 + lane] = a3;
            __syncthreads();
            if (tid < 256) { const int b = tid >> 6; float s = ada_b[(size_t)l * 6144 + n0 + lane];
#pragma unroll
                for (int w = 0; w < 8; ++w) s += red[(w * 4 + b) * 64 + lane];
                MOD[((size_t)l * 4 + b) * 6144 + n0 + lane] = s; }
            __syncthreads();
        }
        for (int i = gt; i < T * 32; i += NGT) { const int row = i >> 5, f = i & 31; const double p = (double)pos_in[row];
            float c, s; sincos_rev(p * args.invfA[f], c, s); COSA[i] = c; SINA[i] = s; sincos_rev(p * args.invfR[f], c, s); COSR[i] = c; SINR[i] = s; }
        for (int i = gt; i < 4 * 2 * 16 * 64; i += NGT) {
            const int g = (i >> 6) & 15, ld = i >> 10;
            const float lr = fminf(s5_lre[i], -1e-4f), li = s5_lim[i]; const float dt = expf(s5_ls[ld * 16 + g]);
            float* pw = PW + (size_t)i * 130;
            for (int tau = 0; tau <= 64; ++tau) { const float mag = expf((float)tau * lr * dt); float c, s; sincos_rev((double)tau * (double)li * (double)dt, c, s); pw[2 * tau] = mag * c; pw[2 * tau + 1] = mag * s; }
            const float ar = pw[2], ai = pw[3], den = lr * lr + li * li;
            const float fre = ((ar - 1.0f) * lr + ai * li) / den, fim = (ai * lr - (ar - 1.0f) * li) / den;
            for (int n = 0; n < 16; ++n) { const float br = s5_bre[(size_t)i * 16 + n], bi = s5_bim[(size_t)i * 16 + n]; BB[((size_t)i * 16 + n) * 2] = fre * br - fim * bi; BB[((size_t)i * 16 + n) * 2 + 1] = fre * bi + fim * br; }
        }
        {
            LAS float* scr = (LAS float*)(lds + 32768 + wave * 8704);
            constexpr int I_IN = 16 * 88, I_OUT = 16 * 32, I_GLU = 4 * 16, I_W1 = 16 * 64, I_W2 = 16 * 32;
            constexpr int N_SMALL = DEPTH * (I_IN + I_OUT + I_GLU);
            constexpr int N_ALL = N_SMALL + DEPTH * NE * (I_W1 + I_W2);
            for (int it = gw; it < N_ALL; it += NGW) {
                int r = it;
                if (r < N_SMALL) {
                    const int l = r / (I_IN + I_OUT + I_GLU); r %= (I_IN + I_OUT + I_GLU);
                    if (r < I_IN) transpose_item<1>(w_in + (size_t)l * 1024 * INW, 1024, INW, WIN + (size_t)l * INW * 1024, scr, r, lane);
                    else if (r < I_IN + I_OUT) transpose_item<0>(w_out + (size_t)l * 1024 * 1024, 1024, 1024, WOUT + (size_t)l * 1024 * 1024, scr, r - I_IN, lane);
                    else transpose_item<3>(glu_w + (size_t)l * 256 * 512, 256, 512, GLU + (size_t)l * 512 * 256, scr, r - I_IN - I_OUT, lane);
                } else {
                    r -= N_SMALL; const int le = r / (I_W1 + I_W2); r %= (I_W1 + I_W2);
                    if (r < I_W1) transpose_item<2>(exp_w1 + (size_t)le * 1024 * 2048, 1024, 2048, W1 + (size_t)le * 2048 * 1024, scr, r, lane);
                    else transpose_item<0>(exp_w2 + (size_t)le * 1024 * 1024, 1024, 1024, W2 + (size_t)le * 1024 * 1024, scr, r - I_W1, lane);
                }
            }
        }
        __syncthreads(); }
        SEAM(0);
    }
    if (PHM(11) && IN(1)) {
        PH_IDS
        for (int rep = 0; rep < NREP(11); ++rep) {
        for (int m0 = gw; m0 < T; m0 += 4 * NGW) { f32x4 v[4][4];
#pragma unroll
            for (int r = 0; r < 4; ++r) { const f32x4* xr = (const f32x4*)(x_in + (size_t)(m0 + r * NGW) * DM) + lane;
#pragma unroll
                for (int j = 0; j < 4; ++j) v[r][j] = xr[64 * j]; }
#pragma unroll
            for (int r = 0; r < 4; ++r) { const int m = m0 + r * NGW; const float* md = MOD + (size_t)(m >> 13) * 6144; mod_row_store(v[r], md, md + 1024, HB + (size_t)m * DM, lane); } }
        float* KT = S5S;
#pragma unroll 2
        for (int i = gt; i < 4 * 16 * 2 * 64 * 256; i += NGT) {
            const int mm = i & 15, n = (i >> 4) & 15, tau = (i >> 8) & 63, dir = (i >> 14) & 1, g = (i >> 15) & 15, l = i >> 19;
            const size_t pg = ((size_t)(l * 2 + dir) * 16 + g);
            const float* cr = s5_cre + (pg * 16 + n) * 64; const float* ci = s5_cim + (pg * 16 + n) * 64;
            const float* pw = PW + pg * 64 * 130 + 2 * tau; const float* bb = BB + (pg * 64 * 16 + mm) * 2;
            float acc = 0.f;
#pragma unroll 8
            for (int p = 0; p < 64; ++p) { const float pr = pw[(size_t)p * 130], pi = pw[(size_t)p * 130 + 1], br = bb[(size_t)p * 32], bi = bb[(size_t)p * 32 + 1];
                acc += cr[p] * (pr * br - pi * bi) - ci[p] * (pr * bi + pi * br); }
            KT[i] = acc;
        }
#pragma unroll 2
        for (int i = gt; i < 4 * 16 * 1024 * 32; i += NGT) {
            const int c8 = i & 31, rowj = (i >> 5) & 1023, g = (i >> 15) & 15, l = i >> 19;
            const int col = c8 * 8, dir = col >> 7, part = (col >> 6) & 1, p0 = col & 63;
            const size_t pg = ((size_t)(l * 2 + dir) * 16 + g);
            const int j = rowj >> 4, n = rowj & 15; const int tau = dir == 0 ? j + 1 : 64 - j;
            const float* cp = s5_cre + (pg * 16 + n) * 64 + p0; const float* cq = s5_cim + (pg * 16 + n) * 64 + p0;
            const f32x4 cr0 = *(const f32x4*)cp, cr1 = *(const f32x4*)(cp + 4), ci0 = *(const f32x4*)cq, ci1 = *(const f32x4*)(cq + 4);
            float v[8];
#pragma unroll
            for (int e = 0; e < 8; ++e) { const f32x2 a = *(const f32x2*)(PW + (pg * 64 + p0 + e) * 130 + 2 * tau); const float cr = e < 4 ? cr0[e & 3] : cr1[e & 3], ci = e < 4 ? ci0[e & 3] : ci1[e & 3];
                v[e] = part == 0 ? (cr * a[0] - ci * a[1]) : -(cr * a[1] + ci * a[0]); }
            *(u32x4*)(TW + ((size_t)(l * 16 + g) * 1024 + rowj) * 1280 + 1024 + col) = (u32x4){pk2(v[0], v[1]), pk2(v[2], v[3]), pk2(v[4], v[5]), pk2(v[6], v[7])};
        }
#pragma unroll 2
        for (int i = gt; i < 4 * 16 * 256 * 128; i += NGT) {
            const int c8 = i & 127, p2 = (i >> 7) & 255, g = (i >> 15) & 15, l = i >> 19;
            const int dir = p2 >> 7, part = (p2 >> 6) & 1, p = p2 & 63;
            const size_t pg = ((size_t)(l * 2 + dir) * 16 + g);
            const int sidx = c8 >> 1, m0 = (c8 & 1) * 8; const int tau = dir == 0 ? 63 - sidx : sidx;
            const f32x2 pwv = *(const f32x2*)(PW + (pg * 64 + p) * 130 + 2 * tau);
            const float* bp = BB + ((pg * 64 + p) * 16 + m0) * 2;
            const f32x4 b0 = *(const f32x4*)bp, b1 = *(const f32x4*)(bp + 4), b2 = *(const f32x4*)(bp + 8), b3 = *(const f32x4*)(bp + 12);
            const float br[8] = {b0[0], b0[2], b1[0], b1[2], b2[0], b2[2], b3[0], b3[2]}, bi[8] = {b0[1], b0[3], b1[1], b1[3], b2[1], b2[3], b3[1], b3[3]};
            float v[8];
#pragma unroll
            for (int e = 0; e < 8; ++e) v[e] = part == 0 ? (pwv[0] * br[e] - pwv[1] * bi[e]) : (pwv[0] * bi[e] + pwv[1] * br[e]);
            *(u32x4*)(W1S + (size_t)i * 8) = (u32x4){pk2(v[0], v[1]), pk2(v[2], v[3]), pk2(v[4], v[5]), pk2(v[6], v[7])};
        }
        }
        SEAM(1);
    }
    if (PHM(11) && IN(2)) {
        PH_IDS
        const float* KT = S5S;
#pragma unroll 4
        for (int i = gt; i < 4 * 16 * 1024 * 128; i += NGT) {
            const int c8 = i & 127, rowj = (i >> 7) & 1023, lg = i >> 17;
            const int sidx = c8 >> 1, m0 = (c8 & 1) * 8, j = rowj >> 4, n = rowj & 15;
            const int d = j - sidx; const int tau = d >= 0 ? d : -d;
            const float* kf = KT + ((((size_t)lg * 2 + (d >= 0 ? 0 : 1)) * 64 + tau) * 16 + n) * 16 + m0;
            f32x4 a0 = *(const f32x4*)kf, a1 = *(const f32x4*)(kf + 4);
            if (d == 0) { const float* kb = kf + (size_t)64 * 256; a0 += *(const f32x4*)kb; a1 += *(const f32x4*)(kb + 4); }
            *(u32x4*)(TW + ((size_t)lg * 1024 + rowj) * 1280 + sidx * 16 + m0) = pack8u(a0, a1);
        }
        SEAM(2);
    }

    for (int l = 0; l < DEPTH; ++l) {
        const int P = 3 + l * NPH_LAYER;
        const float* xcur = (l == 0) ? x_in : XB;
        float* xnext = (l == DEPTH - 1) ? args.out : XB;
        const float* modl = MOD + (size_t)l * 4 * 6144;
        unsigned* gcnt = ctl + CW_GCNT + 64 * l;
        if (PHM(0) && IN(P + 0)) {
            DenseSched S{T / 256, INW / 256, G, bx, (const char*)HB, (const char*)(WIN + (size_t)l * INW * 1024), (size_t)256 * 1024 * 2, (size_t)256 * 1024 * 2};
            EpiProj E{QIMG, KIMG, VIMG, UG2, RET, COSA, SINA, COSR, SINR};
            for (int rep = 0; rep < NREP(0); ++rep) pg8::gemm_phase<EpiProj, DenseSched, false>(lds, 1024, 1024, 1024, S, E);
            SEAM(P + 0);
        }
        if (PHM(1) && IN(P + 1)) {
            GroupSched S{1, G, bx, (const char*)UG2, (const char*)(W1S + (size_t)l * 16 * 256 * 1024), (size_t)512 * 1280 * 2, (size_t)256 * 1024 * 2, (size_t)256 * 1280 * 2, (size_t)256 * 1024 * 2};
            EpiS5S E{S5S};
            for (int rep = 0; rep < NREP(1); ++rep) {
            if (PHM(12)) pg8::gemm_phase<EpiS5S, GroupSched, false>(lds, 1024, 1280, 1024, S, E);
            __syncthreads();
            if (PHM(13)) for (int pr = bx; pr < 512; pr += G) ret_kv_pair(lds, RET, RKV, 2 * pr, args.lg2f, args.lg2b);
            }
            SEAM(P + 1);
        }
        if (PHM(2) && IN(P + 2)) {
            PH_IDS
            for (int rep = 0; rep < NREP(2); ++rep) {
            if (gw < 128) {
                const int dir = gw & 1, g = (gw >> 1) & 15, b = gw >> 5;
                const size_t pg = ((size_t)(l * 2 + dir) * 16 + g);
                const float aqr = PW[(pg * 64 + lane) * 130 + 128], aqi = PW[(pg * 64 + lane) * 130 + 129];
                float hr = 0.f, hi2 = 0.f;
                const float* sb = S5S + ((size_t)g * 512 + b * 128) * 256 + dir * 128 + lane;
                bf16* ob = UG2 + ((size_t)g * 512 + b * 128) * 1280 + 1024 + dir * 128 + lane;
#pragma unroll 8
                for (int cc = 0; cc < 128; ++cc) { const int c = dir == 0 ? cc : 127 - cc;
                    const float sr = sb[(size_t)c * 256], si = sb[(size_t)c * 256 + 64];
                    ob[(size_t)c * 1280] = (bf16)(pk2(hr, 0.f) & 0xffffu); ob[(size_t)c * 1280 + 64] = (bf16)(pk2(hi2, 0.f) & 0xffffu);
                    const float nr = aqr * hr - aqi * hi2 + sr, ni = aqr * hi2 + aqi * hr + si; hr = nr; hi2 = ni; }
            }
            for (int i = gt; i < 16 * 4096; i += NGT) { const int bh = i >> 12, idx = i & 4095, h = bh & 3;
                const float df = fexp2(128.f * args.lg2f[h]), db = fexp2(128.f * args.lg2b[h]);
                const float* kv = RKV + (size_t)bh * 64 * 2 * 4096 + idx; bf16* rs = RST + (size_t)bh * 64 * 2 * 4096 + idx;
                float st = 0.f;
#pragma unroll 8
                for (int n = 0; n < 64; ++n) { const float v = kv[(size_t)n * 8192]; rs[(size_t)n * 8192] = (bf16)(pk2(st, 0.f) & 0xffffu); st = df * st + v; }
                st = 0.f;
#pragma unroll 8
                for (int n = 63; n >= 0; --n) { const float v = kv[(size_t)n * 8192 + 4096]; rs[(size_t)n * 8192 + 4096] = (bf16)(pk2(st, 0.f) & 0xffffu); st = db * st + v; }
            }
            }
            SEAM(P + 2);
        }
        if (PHM(3) && IN(P + 3)) {
            float lam;
            { float s1 = 0.f, s2 = 0.f; for (int i = 0; i < 64; ++i) { s1 += lq1[l * 64 + i] * lk1[l * 64 + i]; s2 += lq2[l * 64 + i] * lk2[l * 64 + i]; } lam = expf(s1) - expf(s2) + args.lam_init[l]; }
            if (PHM(14)) for (int rep = 0; rep < NREP(14); ++rep) for (int u = bx; u < 1024; u += G) { const int qb = u & 63, bh = u >> 6; attn_unit(lds, QIMG, KIMG, VIMG, MIX, bh >> 2, bh & 3, qb, lam, subln_g + l * 128, 1.0f - args.lam_init[l]); }
            const int half = G >> 1;
            if (PHM(15)) {
                GroupSched S{4, half, bx < half ? bx : -1, (const char*)UG2, (const char*)(TW + (size_t)l * 16 * 1024 * 1280), (size_t)512 * 1280 * 2, (size_t)1024 * 1280 * 2, (size_t)256 * 1280 * 2, (size_t)256 * 1280 * 2};
                EpiS5Y E{YB, UG2, s5_d + l * 256};
                for (int rep = 0; rep < NREP(15); ++rep) pg8::gemm_phase<EpiS5Y, GroupSched, false>(lds, 1280, 1280, 1280, S, E);
            }
            __syncthreads();
            if (PHM(16) && bx >= half) for (int rep = 0; rep < NREP(16); ++rep) for (int pr = bx - half; pr < 512; pr += (G - half)) ret_out_pair(lds, RET, RST, MIX, 2 * pr, args.lg2f, args.lg2b);
            SEAM(P + 3);
        }
        if (PHM(4) && IN(P + 4)) {
            DenseSched S{T / 256, 2, G, bx, (const char*)YB, (const char*)(GLU + (size_t)l * 512 * 256), (size_t)256 * 256 * 2, (size_t)256 * 256 * 2};
            EpiGlu E{MIX, glu_b + l * 512};
            for (int rep = 0; rep < NREP(4); ++rep) pg8::gemm_phase<EpiGlu, DenseSched, false>(lds, 256, 256, 256, S, E);
            SEAM(P + 4);
        }
        if (PHM(5) && IN(P + 5)) {
            DenseSched S{T / 256, 4, G, bx, (const char*)MIX, (const char*)(WOUT + (size_t)l * 1024 * 1024), (size_t)256 * 1024 * 2, (size_t)256 * 1024 * 2};
            EpiOut E{YPRE, xcur, modl};
            for (int rep = 0; rep < NREP(5); ++rep) pg8::gemm_phase<EpiOut, DenseSched, false>(lds, 1024, 1024, 1024, S, E);
            SEAM(P + 5);
        }
        if (PHM(6) && IN(P + 6)) {
            PH_IDS
            for (int rep = 0; rep < NREP(6); ++rep) { const bool commit = (rep == NREP(6) - 1);
            __syncthreads();
            LAS float* WT = (LAS float*)lds;
            for (int i = tid; i < 1024 * 32; i += NTHR) { const int k = i >> 5, e = i & 31; WT[e * 1024 + k] = router_w[(size_t)l * 1024 * 32 + i]; }
            LAS int* lcnt = (LAS int*)(lds + TAB_OFF); LAS int* lbase = lcnt + 32; LAS int* ent = lbase + 32;
            if (tid < 32) lcnt[tid] = 0;
            __syncthreads();
            const float rbv = router_b[l * 32 + (lane & 31)];
            int it = 0;
            for (int m0 = gw; m0 < T; m0 += 2 * NGW, ++it) {
                f32x4 v[2][4]; float mean[2], rstd[2];
#pragma unroll
                for (int r = 0; r < 2; ++r)
#pragma unroll
                    for (int j = 0; j < 4; ++j) v[r][j] = *((const f32x4*)(YPRE + (size_t)(m0 + r * NGW) * DM) + lane + 64 * j);
#pragma unroll
                for (int r = 0; r < 2; ++r) row_stats(v[r], mean[r], rstd[r]);
#pragma unroll
                for (int j = 0; j < 4; ++j) { const int col = 4 * lane + 256 * j; const f32x4 gg = *(const f32x4*)(ln_g + (size_t)(l * 2) * DM + col), bb = *(const f32x4*)(ln_b + (size_t)(l * 2) * DM + col);
#pragma unroll
                    for (int r = 0; r < 2; ++r) { v[r][j] = (v[r][j] - mean[r]) * rstd[r] * gg + bb; *(f32x4*)(X1 + (size_t)(m0 + r * NGW) * DM + col) = v[r][j]; } }
#pragma unroll
                for (int r = 0; r < 2; ++r) row_stats(v[r], mean[r], rstd[r]);
#pragma unroll
                for (int r = 0; r < 2; ++r) { const int m = m0 + r * NGW; const float* sh = modl + (size_t)(m >> 13) * 6144 + 3 * 1024; const float* sc = sh + 1024;
#pragma unroll
                    for (int j = 0; j < 4; ++j) { const int col = 4 * lane + 256 * j; const f32x4 a = *(const f32x4*)(sc + col), bb = *(const f32x4*)(sh + col);
                        v[r][j] = (v[r][j] - mean[r]) * rstd[r] * (a + 1.0f) + bb; *(u32x2*)(HB + (size_t)m * DM + col) = (u32x2){pk2(v[r][j][0], v[r][j][1]), pk2(v[r][j][2], v[r][j][3])}; } }
#pragma unroll
                for (int r = 0; r < 2; ++r) {
                    Top4 tq; top4_init(tq);
#pragma unroll
                    for (int eg = 0; eg < 8; ++eg) {
#pragma unroll
                        for (int e = 4 * eg; e < 4 * eg + 4; ++e) { float a0 = 0.f;
#pragma unroll
                            for (int j = 0; j < 4; ++j) { const f32x4 w = *(const LAS f32x4*)(WT + e * 1024 + 4 * lane + 256 * j);
                                a0 += (v[r][j][0] * w[0] + v[r][j][1] * w[1]) + (v[r][j][2] * w[2] + v[r][j][3] * w[3]); }
                            top4_insert(tq, wave_sum(a0) + __builtin_bit_cast(float, __builtin_amdgcn_readlane(__builtin_bit_cast(int, rbv), e)), e); }
                        asm volatile("" ::: "memory");
                    }
                    const int te[4] = {tq.i0, tq.i1, tq.i2, tq.i3}; const float tv[4] = {tq.t0, tq.t1, tq.t2, tq.t3};
                    float gs = 0.f, ge[4];
#pragma unroll
                    for (int k = 0; k < 4; ++k) { ge[k] = fexp2((tv[k] - tv[0]) * LOG2E); gs += ge[k]; }
                    const float ig = 1.0f / gs;
                    if (lane < 4 && commit) { const int e = lane == 0 ? te[0] : lane == 1 ? te[1] : lane == 2 ? te[2] : te[3]; const float gv = (lane == 0 ? ge[0] : lane == 1 ? ge[1] : lane == 2 ? ge[2] : ge[3]) * ig;
                        const int lp = atomicAdd((int*)&lcnt[e], 1);
                        const int sl = (wave * 32 + it * 2 + r) * 4 + lane; ent[sl * 3] = e; ent[sl * 3 + 1] = lp; ent[sl * 3 + 2] = __float_as_int(gv); }
                }
            }
            if (!commit) continue;
            __syncthreads();
            if (tid < 32) lbase[tid] = (int)atomicAdd(gcnt + tid, (unsigned)lcnt[tid]);
            __syncthreads();
            { int nl = 0; for (int m = gw; m < T; m += NGW, ++nl) { if (lane < 4) { const int sl = (wave * 32 + nl) * 4 + lane; const int e = ent[sl * 3], pos = lbase[e] + ent[sl * 3 + 1];
                    LIST[(size_t)e * T + pos] = m; TOKI[((size_t)m * 4 + lane) * 2] = e; TOKI[((size_t)m * 4 + lane) * 2 + 1] = pos; GATE[(size_t)m * 4 + lane] = __int_as_float(ent[sl * 3 + 2]); } } }
            }
            SEAM(P + 6);
        }
        if (PHM(7) && IN(P + 7)) {
            const int ntile = moe_tables(lds, gcnt);
            LAS int* cnt = (LAS int*)(lds + TAB_OFF);
            MoeSched S{ntile, 8, G, bx, (const char*)HB, (const char*)(W1 + (size_t)l * 32 * 2048 * 1024), (size_t)2048 * 1024 * 2, 0, (size_t)256 * 1024 * 2, cnt, cnt + 32, (const LAS unsigned char*)(cnt + 68), LIST};
            EpiMoe1 E{A2, exp_b1 + (size_t)l * 32 * 2048};
            for (int rep = 0; rep < NREP(7); ++rep) pg8::gemm_phase<EpiMoe1, MoeSched, true>(lds, 1024, 1024, 1024, S, E);
            SEAM(P + 7);
        }
        if (PHM(8) && IN(P + 8)) {
            const int ntile = moe_tables(lds, gcnt);
            LAS int* cnt = (LAS int*)(lds + TAB_OFF);
            MoeSched S{ntile, 4, G, bx, (const char*)A2, (const char*)(W2 + (size_t)l * 32 * 1024 * 1024), (size_t)1024 * 1024 * 2, (size_t)256 * 1024 * 2, (size_t)256 * 1024 * 2, cnt, cnt + 32, (const LAS unsigned char*)(cnt + 68), LIST};
            EpiMoe2 E{YS, exp_b2 + (size_t)l * 32 * 1024};
            for (int rep = 0; rep < NREP(8); ++rep) pg8::gemm_phase<EpiMoe2, MoeSched, false>(lds, 1024, 1024, 1024, S, E);
            SEAM(P + 8);
        }
        if (PHM(9) && IN(P + 9)) {
            PH_IDS
            (void)moe_tables(lds, gcnt);
            const LAS int* tstart = (const LAS int*)(lds + TAB_OFF) + 32;
            for (int rep = 0; rep < NREP(9); ++rep)
            for (int m0 = gw; m0 < T; m0 += 2 * NGW) {
                int te[2][4], tp[2][4]; float tg[2][4];
#pragma unroll
                for (int r = 0; r < 2; ++r) { const int m = m0 + r * NGW; const u32x4 q0 = *(const u32x4*)(TOKI + (size_t)m * 8), q1 = *(const u32x4*)(TOKI + (size_t)m * 8 + 4); const f32x4 gq = *(const f32x4*)(GATE + (size_t)m * 4);
                    te[r][0] = q0[0]; tp[r][0] = q0[1]; te[r][1] = q0[2]; tp[r][1] = q0[3]; te[r][2] = q1[0]; tp[r][2] = q1[1]; te[r][3] = q1[2]; tp[r][3] = q1[3];
                    tg[r][0] = gq[0]; tg[r][1] = gq[1]; tg[r][2] = gq[2]; tg[r][3] = gq[3]; }
                u32x2 yw[2][4][4]; f32x4 xx[2][4];
#pragma unroll
                for (int r = 0; r < 2; ++r) {
#pragma unroll
                    for (int k = 0; k < 4; ++k) { const bf16* yr = YS + ((size_t)tstart[te[r][k]] * 256 + tp[r][k]) * 1024;
#pragma unroll
                        for (int j = 0; j < 4; ++j) yw[r][k][j] = *(const u32x2*)(yr + 4 * lane + 256 * j); }
#pragma unroll
                    for (int j = 0; j < 4; ++j) xx[r][j] = *(const f32x4*)(X1 + (size_t)(m0 + r * NGW) * DM + 4 * lane + 256 * j); }
#pragma unroll
                for (int r = 0; r < 2; ++r) {
                    const int m = m0 + r * NGW, b = m >> 13;
                    const float* g2 = modl + (size_t)b * 6144 + 5 * 1024;
                    f32x4 v[4];
#pragma unroll
                    for (int j = 0; j < 4; ++j) { f32x4 ff = (f32x4){0.f, 0.f, 0.f, 0.f};
#pragma unroll
                        for (int k = 0; k < 4; ++k) { const u32x2 w = yw[r][k][j]; ff += (f32x4){bflo(w[0]), bfhi(w[0]), bflo(w[1]), bfhi(w[1])} * tg[r][k]; }
                        const f32x4 gg = *(const f32x4*)(g2 + 4 * lane + 256 * j); v[j] = xx[r][j] * DN_ALPHA + (gg + 1.0f) * ff; }
                    float mean, rstd; row_stats(v, mean, rstd);
#pragma unroll
                    for (int j = 0; j < 4; ++j) { const int col = 4 * lane + 256 * j; const f32x4 gg = *(const f32x4*)(ln_g + (size_t)(l * 2 + 1) * DM + col), bb = *(const f32x4*)(ln_b + (size_t)(l * 2 + 1) * DM + col);
                        v[j] = (v[j] - mean) * rstd * gg + bb; *(f32x4*)(xnext + (size_t)m * DM + col) = v[j]; }
                    if (l + 1 < DEPTH) { const float* md = MOD + ((size_t)(l + 1) * 4 + b) * 6144; mod_row_store(v, md, md + 1024, HB + (size_t)m * DM, lane); }
                }
            }
            SEAM(P + 9);
        }
    }
#undef IN
#undef SEAM
#undef GRID_BAR
}

extern "C" void kernel_launch(void* const* d_in, const int* in_sizes, int n_in, void* d_out, int out_size, void* d_ws, size_t ws_size, hipStream_t stream) {
    static int grid = 0;
    if (grid == 0) {
        if (n_in != 30 || in_sizes[0] != T * DM || out_size != T * DM || ws_size < WS_END) { fprintf(stderr, "kernel_launch: unexpected problem (n_in %d, in0 %d, out %d, ws %zu)\n", n_in, n_in > 0 ? in_sizes[0] : -1, out_size, ws_size); grid = -1; return; }
        int dev = 0, cus = 0, per_cu = 0;
        if (hipGetDevice(&dev) != hipSuccess || hipDeviceGetAttribute(&cus, hipDeviceAttributeMultiprocessorCount, dev) != hipSuccess) { grid = -1; return; }
        if (hipFuncSetAttribute((const void*)hybrid_fwd, hipFuncAttributeMaxDynamicSharedMemorySize, LDS_BYTES) != hipSuccess) { fprintf(stderr, "kernel_launch: hipFuncSetAttribute failed\n"); grid = -1; return; }
        if (hipOccupancyMaxActiveBlocksPerMultiprocessor(&per_cu, (const void*)hybrid_fwd, NTHR, LDS_BYTES) != hipSuccess || per_cu < 1) { fprintf(stderr, "kernel_launch: occupancy query says %d\n", per_cu); (void)hipGetLastError(); if (per_cu < 1) { grid = -1; return; } }
        grid = cus;
        if (grid > 256) grid = 256;
        if (grid < 128) { grid = -1; return; }
    }
    if (grid < 0) return;
    (void)hipMemsetAsync((char*)d_ws + WS_CTL, 0, CTL_BYTES, stream);
    Args a{};
    for (int i = 0; i < 30; ++i) a.in[i] = d_in[i];
    a.out = (float*)d_out; a.ws = (unsigned char*)d_ws;
    for (int i = 0; i < 32; ++i) { a.invfA[i] = std::pow(10000.0, -(double)i / 32.0); a.invfR[i] = std::pow(10000.0, -(double)i / 31.0); }
    for (int l = 0; l < 4; ++l) a.lam_init[l] = (float)(0.8 - 0.6 * std::exp(-0.3 * l));
    for (int h = 0; h < 4; ++h) { a.lg2f[h] = (float)std::log2(1.0 - std::exp2(-5.0 - h)); a.lg2b[h] = (float)std::log2(1.0 - std::exp2(-5.5 - h)); }
#if MK_SPLIT
    for (int p = 0; p < NPH; ++p) { a.ph_lo = p; a.ph_hi = p + 1; hipLaunchKernelGGL(hybrid_fwd, dim3(grid), dim3(NTHR), LDS_BYTES, stream, a); }
#else
    a.ph_lo = 0; a.ph_hi = NPH;
    hipLaunchKernelGGL(hybrid_fwd, dim3(grid), dim3(NTHR), LDS_BYTES, stream, a);
#endif
}
```

```cpp
#include <hip/hip_runtime.h>
#include <cstdio>
#include <cstdint>
#include <cmath>

#define LAS __attribute__((address_space(3)))
#define GAS __attribute__((address_space(1)))
typedef unsigned short bf16;
typedef short bf16x8 __attribute__((ext_vector_type(8)));
typedef short s16x4 __attribute__((ext_vector_type(4)));
typedef float f32x4 __attribute__((ext_vector_type(4)));
typedef float f32x2 __attribute__((ext_vector_type(2)));
typedef float f32x16 __attribute__((ext_vector_type(16)));
typedef unsigned u32x4 __attribute__((ext_vector_type(4)));
typedef unsigned u32x2 __attribute__((ext_vector_type(2)));
typedef __bf16 bf16x2_t __attribute__((ext_vector_type(2)));

#ifndef STAMP_SEL
#define STAMP_SEL -1
#endif
#ifndef MK_SPLIT
#define MK_SPLIT 0
#endif

constexpr int NB = 4, SEQ = 8192, DM = 1024, T = NB * SEQ, DEPTH = 4;
constexpr int INW = 2816, NE = 32;
constexpr int NTILE_MAX = T * 4 / 256 + NE;
constexpr float LN_EPS = 1e-5f;
constexpr float C2 = 0.125f * 1.4426950408889634f;
constexpr float LOG2E = 1.4426950408889634f;
constexpr float DN_ALPHA = 1.681792830507429f;

constexpr size_t MiB = 1u << 20;
constexpr size_t WS_CTL = 0, CTL_BYTES = 65536;
constexpr size_t WS_MOD = 1 * MiB;
constexpr size_t WS_ROUTW = 1 * MiB + 512 * 1024;
constexpr size_t WS_ROT = 2 * MiB;
constexpr size_t WS_PW = 18 * MiB;
constexpr size_t WS_BB = 23 * MiB;
constexpr size_t WS_WIN = 24 * MiB;
constexpr size_t WS_WOUT = 46 * MiB;
constexpr size_t WS_GLU = 54 * MiB;
constexpr size_t WS_W1S = 56 * MiB;
constexpr size_t WS_TW = 88 * MiB;
constexpr size_t WS_W1 = 248 * MiB;
constexpr size_t WS_W2 = 760 * MiB;
constexpr size_t WS_HB = 1016 * MiB;
constexpr size_t WS_QIMG = 1080 * MiB;
constexpr size_t WS_KIMG = 1112 * MiB;
constexpr size_t WS_VIMG = 1144 * MiB;
constexpr size_t WS_UG2 = 1176 * MiB;
constexpr size_t WS_RET = 1196 * MiB;
constexpr size_t WS_S5S = 1260 * MiB;
constexpr size_t WS_YB = 1268 * MiB;
constexpr size_t WS_RKV = 1284 * MiB;
constexpr size_t WS_RST = 1316 * MiB;
constexpr size_t WS_MIX = 1332 * MiB;
constexpr size_t WS_YPRE = 1396 * MiB;
constexpr size_t WS_X1 = 1524 * MiB;
constexpr size_t WS_XB = 1652 * MiB;
constexpr size_t WS_LIST = 1780 * MiB;
constexpr size_t WS_TOKI = 1784 * MiB;
constexpr size_t WS_GATE = 1785 * MiB;
constexpr size_t WS_A2 = 1786 * MiB;
constexpr size_t WS_YS = 2058 * MiB;
constexpr size_t WS_END = 2330 * MiB;

constexpr int CW_TMO = 0, CW_BAR = 1024, CW_CONV = 4608, CW_GCNT = 8192;

constexpr int RING_BYTES = 131072;
constexpr int LDSCTL_OFF = RING_BYTES, MISC_OFF = LDSCTL_OFF + 320, TAB_OFF = LDSCTL_OFF + 512;
constexpr int LDS_BYTES = 147456;
constexpr int NWAVES = 8, NTHR = 512;

#define RLX_AGENT __ATOMIC_RELAXED, __HIP_MEMORY_SCOPE_AGENT
__device__ __forceinline__ unsigned pk2(float lo, float hi) { f32x2 v = {lo, hi}; bf16x2_t b = __builtin_convertvector(v, bf16x2_t); return __builtin_bit_cast(unsigned, b); }
__device__ __forceinline__ float bf2f(unsigned short u) { return __uint_as_float(((unsigned)u) << 16); }
__device__ __forceinline__ float bflo(unsigned u) { return __uint_as_float(u << 16); }
__device__ __forceinline__ float bfhi(unsigned u) { return __uint_as_float(u & 0xffff0000u); }
template <int CTRL> __device__ __forceinline__ float dppadd(float v) { return v + __builtin_bit_cast(float, __builtin_amdgcn_update_dpp(0, __builtin_bit_cast(int, v), CTRL, 0xF, 0xF, true)); }
__device__ __forceinline__ float swap16_add(float v) { float w = v; asm volatile("v_nop\n\tv_nop\n\tv_permlane16_swap_b32 %0, %1\n\tv_nop\n\tv_nop" : "+v"(v), "+v"(w)); return v + w; }
__device__ __forceinline__ float swap32_add(float v) { float w = v; asm volatile("v_nop\n\tv_nop\n\tv_permlane32_swap_b32 %0, %1\n\tv_nop\n\tv_nop" : "+v"(v), "+v"(w)); return v + w; }
__device__ __forceinline__ float swap32_max(float v) { float w = v; asm volatile("v_nop\n\tv_nop\n\tv_permlane32_swap_b32 %0, %1\n\tv_nop\n\tv_nop" : "+v"(v), "+v"(w)); return fmaxf(v, w); }
__device__ __forceinline__ float half_sum(float v) {
    v = dppadd<0xB1>(v); v = dppadd<0x4E>(v); v = dppadd<0x141>(v); v = dppadd<0x140>(v); return swap16_add(v);
}
__device__ __forceinline__ float wave_sum(float v) { return swap32_add(half_sum(v)); }
__device__ __forceinline__ float fexp2(float x) { return __builtin_amdgcn_exp2f(x); }
__device__ __forceinline__ float frcp(float x) { return __builtin_amdgcn_rcpf(x); }
__device__ __forceinline__ float sigmoidf_(float x) { return frcp(1.0f + fexp2(-x * LOG2E)); }
__device__ __forceinline__ int otid() { int t = threadIdx.x; asm volatile("" : "+v"(t)); return t; }
__device__ __forceinline__ int crow(int r, int hi) { return (r & 3) + 8 * (r >> 2) + 4 * hi; }
__device__ __forceinline__ s16x4 vtr(const LAS char* p) { return __builtin_bit_cast(s16x4, __builtin_amdgcn_ds_read_tr16_b64_v4i16((LAS s16x4*)p)); }
__device__ __forceinline__ bf16x8 cat8(s16x4 a, s16x4 b) { return (bf16x8){a[0], a[1], a[2], a[3], b[0], b[1], b[2], b[3]}; }
__device__ __forceinline__ bf16x8 pack8(float a0, float a1, float a2, float a3, float a4, float a5, float a6, float a7) {
    u32x4 w = {pk2(a0, a1), pk2(a2, a3), pk2(a4, a5), pk2(a6, a7)}; return __builtin_bit_cast(bf16x8, w);
}
__device__ __forceinline__ u32x4 pack8u(f32x4 a, f32x4 b) { return (u32x4){pk2(a[0], a[1]), pk2(a[2], a[3]), pk2(b[0], b[1]), pk2(b[2], b[3])}; }

#define XB_TMO      128
#define XB_XCNT(j)  (256  + 64 * (j))
#define XB_XSUB(j)  (1280 + 64 * (j))
#define XB_XGEN(j)  (2304 + 64 * (j))
#define XB_TOP      3328
#define XB_TOPGEN   3392
#define XCD_BAR_WORDS 3456
#define XB_SPIN_CAP (1u << 22)
__device__ __forceinline__ unsigned xb_ld(unsigned* p)              { return __hip_atomic_load(p, __ATOMIC_RELAXED, __HIP_MEMORY_SCOPE_AGENT); }
__device__ __forceinline__ unsigned xb_add(unsigned* p, unsigned v) { return __hip_atomic_fetch_add(p, v, __ATOMIC_RELAXED, __HIP_MEMORY_SCOPE_AGENT); }
__device__ __forceinline__ unsigned xb_xcc_id() { return (unsigned)__builtin_amdgcn_s_getreg((3 << 11) | 20) & 0xFu; }
#define XB_SPIN(cond, bar) do { unsigned _sp = 0; while (cond) { __builtin_amdgcn_s_sleep(1); \
    if ((++_sp & 255u) == 0u) { if (xb_ld(&(bar)[XB_TMO])) break; if (_sp > XB_SPIN_CAP) { atomicAdd(&(bar)[XB_TMO], 1u); break; } } } } while (0)
struct XcdBarrier { unsigned* bar; unsigned x; volatile LAS unsigned* st; };
__device__ __forceinline__ XcdBarrier xcd_barrier_post(unsigned* bar, volatile LAS unsigned* st) {
    XcdBarrier b; b.bar = bar; b.x = xb_xcc_id(); b.st = st;
    if (threadIdx.x == 0) (void)xb_add(&bar[XB_XCNT(b.x)], 1u);
    return b;
}
__device__ __forceinline__ void xcd_barrier_complete(unsigned* bar, unsigned x, unsigned& nloc, unsigned& nx) {
    const unsigned G = gridDim.x * gridDim.y * gridDim.z;
    unsigned sum, cnt, mine, sp = 0u;
    for (;;) {
        sum = 0u; cnt = 0u; mine = 0u;
#pragma unroll
        for (unsigned j = 0; j < 16; ++j) { const unsigned c = xb_ld(&bar[XB_XCNT(j)]); sum += c; cnt += (c > 0u) ? 1u : 0u; mine = (j == x) ? c : mine; }
        if (sum == G) break;
        __builtin_amdgcn_s_sleep(1);
        if ((++sp & 255u) == 0u) { if (xb_ld(&bar[XB_TMO])) break; if (sp > XB_SPIN_CAP) { atomicAdd(&bar[XB_TMO], 1u); break; } }
    }
    nloc = mine > 0u ? mine : 1u; nx = cnt > 0u ? cnt : 1u;
}
__device__ __forceinline__ void xcd_barrier(const XcdBarrier& b) {
    asm volatile("s_waitcnt vmcnt(0)" ::: "memory");
    __syncthreads();
    if (threadIdx.x == 0) {
        unsigned* bar = b.bar;
        __builtin_amdgcn_s_waitcnt(0);
        unsigned nloc = b.st[0], nx = b.st[1];
        if (nloc == 0u) { xcd_barrier_complete(bar, b.x, nloc, nx); b.st[0] = nloc; b.st[1] = nx; }
        const unsigned old = xb_add(&bar[XB_XSUB(b.x)], 1u);
        const unsigned gen = old / nloc;
        if (old + 1u == (gen + 1u) * nloc) {
            __builtin_amdgcn_fence(__ATOMIC_RELEASE, "agent");
            asm volatile("s_waitcnt vmcnt(0)" ::: "memory");
            const unsigned og = xb_add(&bar[XB_TOP], 1u);
            const unsigned tg = og / nx;
            if (og + 1u == (tg + 1u) * nx) xb_add(&bar[XB_TOPGEN], 1u);
            else XB_SPIN(xb_ld(&bar[XB_TOPGEN]) == tg, bar);
            __builtin_amdgcn_fence(__ATOMIC_ACQUIRE, "agent");
            xb_add(&bar[XB_XGEN(b.x)], 1u);
            asm volatile("s_waitcnt vmcnt(0)" ::: "memory");
        } else {
            XB_SPIN(xb_ld(&bar[XB_XGEN(b.x)]) == gen, bar);
            __builtin_amdgcn_fence(__ATOMIC_ACQUIRE, "agent");
            asm volatile("s_waitcnt vmcnt(0)" ::: "memory");
        }
    }
    __syncthreads();
}

namespace pg8 {
constexpr int BM = 256, BK = 64, HALF = 128, HTB = HALF * BK * 2, STAGE_BYTES = 8 * HTB, NXCD = 8, WGM = 8;
__device__ __forceinline__ int lds_byte(int r, int c) { const int st = (r >> 4) * 2 + (c >> 5), rr = r & 15, cc = c & 31, ob = rr * 64 + cc * 2; return st * 1024 + (ob ^ (((ob >> 9) & 1) << 5)); }
__device__ __forceinline__ void stage_rc(int b, int& R, int& C) { const int st = b / 1024, sb = b % 1024, swz = sb ^ (((sb >> 9) & 1) << 5); R = (st >> 1) * 16 + swz / 64; C = (st & 1) * 32 + (swz % 64) / 2; }
__device__ __forceinline__ int perm32(int rho) { const int n = rho >> 4, i = rho & 15; return 8 * (i >> 2) + 4 * n + (i & 3); }
struct Unit { int pm, pn, g; };

__device__ __forceinline__ bool static_order(int i, int G, int c, int nM, int nN, int& pm, int& pn) {
    const int nwg = nM * nN; const long L = (long)i * G + c; if (L >= nwg) return false;
    int wgid = (int)L; { const int q = nwg / NXCD, r = nwg % NXCD, xcd = wgid % NXCD, off = wgid / NXCD; wgid = (xcd < r ? xcd * (q + 1) : r * (q + 1) + (xcd - r) * q) + off; }
    const int nig = WGM * nN, gid = wgid / nig, fm = gid * WGM, gsz = (nM - fm) < WGM ? (nM - fm) : WGM;
    pm = fm + ((wgid % nig) % gsz); pn = (wgid % nig) / gsz; return true;
}

template <class Epi, class Sched, bool GATHER>
__device__ __forceinline__ void gemm_phase(LAS unsigned char* lds, const int K, const int lda, const int ldb, const Sched& S, const Epi& E) {
    const int tid = otid(), wid = __builtin_amdgcn_readfirstlane(tid >> 6), lane = tid & 63, wr = wid >> 2, wc = wid & 3, fr = lane & 15, fq = lane >> 4;
    const int nt = K / BK;
    int Rr[2], Cc[2];
    unsigned voffB[2], vAc[2][2];
#pragma unroll
    for (int i = 0; i < 2; ++i) { int R, C; stage_rc(tid * 16 + i * 8192, R, C); Rr[i] = R; Cc[i] = C; const int Rb = (R & ~31) + perm32(R & 31);
        voffB[i] = (unsigned)(Rb * ldb + C) * 2u;
#pragma unroll
        for (int h = 0; h < 2; ++h) vAc[h][i] = (unsigned)((GATHER ? 0 : R) * lda + C) * 2u; }
    const size_t kstep = (size_t)(BK * 2);
    const size_t hstepB = (size_t)HALF * ldb * 2;
    const size_t hstepA = GATHER ? (size_t)0 : (size_t)HALF * lda * 2;
    const unsigned ldsw = (unsigned)wid * 1024u;
    const int aoff = lds_byte(wr * 64 + fr, fq * 8), boff = lds_byte(wc * 32 + fr, fq * 8);
    LAS int* rowtab = (LAS int*)(lds + TAB_OFF + 2048);
#define PG8_SA(b, h) (((b) * 2 + (h)) * HTB)
#define PG8_SB(b, h) ((4 + (b) * 2 + (h)) * HTB)
#define PG8_STAGE(bufoff, gbase, v0, v1) do { \
        __builtin_amdgcn_global_load_lds((const unsigned*)((const char*)(gbase) + (v0)), (LAS unsigned*)(lds + (bufoff) + ldsw), 16, 0, 0); \
        __builtin_amdgcn_global_load_lds((const unsigned*)((const char*)(gbase) + (v1)), (LAS unsigned*)(lds + (bufoff) + ldsw + 8192), 16, 0, 0); } while (0)
#define PG8_STAGEB(bufoff, gbase) PG8_STAGE(bufoff, gbase, voffB[0], voffB[1])
#define PG8_LDA(dst, b, h) do { _Pragma("unroll") for (int m = 0; m < 4; ++m) _Pragma("unroll") for (int k = 0; k < 2; ++k) dst[m][k] = *(const LAS bf16x8*)(lds + PG8_SA(b, h) + aoff + m * 2048 + k * 1024); } while (0)
#define PG8_LDB(dst, b, h) do { _Pragma("unroll") for (int n = 0; n < 2; ++n) _Pragma("unroll") for (int k = 0; k < 2; ++k) dst[n][k] = *(const LAS bf16x8*)(lds + PG8_SB(b, h) + boff + n * 2048 + k * 1024); } while (0)
#define PG8_MMA(ai, bj, At, Bt) do { __builtin_amdgcn_s_setprio(1); _Pragma("unroll") for (int m = 0; m < 4; ++m) _Pragma("unroll") for (int n = 0; n < 2; ++n) _Pragma("unroll") for (int k = 0; k < 2; ++k) \
        acc[ai][bj][m][n] = __builtin_amdgcn_mfma_f32_16x16x32_bf16(Bt[n][k], At[m][k], acc[ai][bj][m][n], 0, 0, 0); __builtin_amdgcn_s_setprio(0); } while (0)
#define PG8_WAIT_V(n) asm volatile("s_waitcnt vmcnt(" #n ")" ::: "memory")
#define PG8_WAIT_L(n) asm volatile("s_waitcnt lgkmcnt(" #n ")" ::: "memory")
#define PG8_BAR __builtin_amdgcn_s_barrier()
#define PG8_SCHED __builtin_amdgcn_sched_barrier(0)
    Unit cur, nxt; int ui = 0;
    if (!S.next(0, cur)) return;
    f32x4 acc[2][2][4][2];
#pragma unroll
    for (int a = 0; a < 2; ++a)
#pragma unroll
        for (int b = 0; b < 2; ++b)
#pragma unroll
            for (int m = 0; m < 4; ++m)
#pragma unroll
                for (int n = 0; n < 2; ++n) acc[a][b][m][n] = (f32x4){0.f, 0.f, 0.f, 0.f};
    bf16x8 At[4][2], B0[2][2], B1[2][2];
    const char* cA = S.a_base(cur); const char* cB = S.b_base(cur);
    if constexpr (GATHER) {
        if (tid < 256) rowtab[tid] = S.a_row(cur, tid);
        PG8_WAIT_V(0); PG8_WAIT_L(0); PG8_BAR;
#pragma unroll
        for (int h = 0; h < 2; ++h)
#pragma unroll
            for (int i = 0; i < 2; ++i) vAc[h][i] = (unsigned)(rowtab[h * HALF + Rr[i]] * lda + Cc[i]) * 2u;
    }
    PG8_STAGEB(PG8_SB(0, 0), cB); PG8_STAGEB(PG8_SB(0, 1), cB + hstepB); PG8_STAGE(PG8_SA(0, 0), cA, vAc[0][0], vAc[0][1]); PG8_STAGE(PG8_SA(0, 1), cA + hstepA, vAc[1][0], vAc[1][1]);
    if (wr == 1) PG8_BAR;
    PG8_WAIT_V(2); PG8_BAR;
    PG8_STAGEB(PG8_SB(1, 0), cB + kstep); PG8_STAGE(PG8_SA(1, 0), cA + kstep, vAc[0][0], vAc[0][1]); PG8_STAGEB(PG8_SB(1, 1), cB + hstepB + kstep);
    PG8_WAIT_V(6); PG8_BAR;
    for (;;) {
        const bool has_next = S.next(ui + 1, nxt);
        const char* nA = has_next ? S.a_base(nxt) : cA; const char* nB = has_next ? S.b_base(nxt) : cB;
        if constexpr (GATHER) {
            if (tid < 256) rowtab[((ui + 1) & 1) * 256 + tid] = has_next ? S.a_row(nxt, tid) : 0;
            PG8_WAIT_V(0);
        }
#pragma unroll 1
        for (int t = 0; t < nt; t += 2) {
            const bool last = (t == nt - 2);
            const char* a1 = cA + (size_t)(t + 1) * kstep;
            const char* a2 = last ? nA : cA + (size_t)(t + 2) * kstep; const char* b2 = last ? nB : cB + (size_t)(t + 2) * kstep;
            const char* a3 = a2 + kstep; const char* b3 = b2 + kstep;
            unsigned v2[2][2];
#pragma unroll
            for (int h = 0; h < 2; ++h)
#pragma unroll
                for (int i = 0; i < 2; ++i) v2[h][i] = vAc[h][i];
            if constexpr (GATHER) { if (last && has_next) {
#pragma unroll
                for (int h = 0; h < 2; ++h)
#pragma unroll
                    for (int i = 0; i < 2; ++i) v2[h][i] = (unsigned)(rowtab[((ui + 1) & 1) * 256 + h * HALF + Rr[i]] * lda + Cc[i]) * 2u; } }
            PG8_LDB(B0, 0, 0); PG8_LDB(B1, 0, 1); PG8_SCHED; PG8_LDA(At, 0, 0); PG8_STAGE(PG8_SA(1, 1), a1 + hstepA, vAc[1][0], vAc[1][1]);
            PG8_WAIT_V(8); PG8_WAIT_L(0); PG8_BAR; PG8_MMA(0, 0, At, B0); PG8_MMA(0, 1, At, B1); PG8_BAR; PG8_SCHED;
            PG8_LDA(At, 0, 1); PG8_STAGEB(PG8_SB(0, 0), b2); PG8_STAGEB(PG8_SB(0, 1), b2 + hstepB); PG8_STAGE(PG8_SA(0, 0), a2, v2[0][0], v2[0][1]);
            PG8_WAIT_V(8); PG8_WAIT_L(0); PG8_BAR; PG8_MMA(1, 0, At, B0); PG8_MMA(1, 1, At, B1); PG8_BAR; PG8_SCHED;
            PG8_LDB(B0, 1, 0); PG8_LDB(B1, 1, 1); PG8_SCHED; PG8_LDA(At, 1, 0); PG8_STAGE(PG8_SA(0, 1), a2 + hstepA, v2[1][0], v2[1][1]);
            PG8_WAIT_V(8); PG8_WAIT_L(0); PG8_BAR; PG8_MMA(0, 0, At, B0); PG8_MMA(0, 1, At, B1); PG8_BAR; PG8_SCHED;
            PG8_LDA(At, 1, 1); PG8_STAGEB(PG8_SB(1, 0), b3); PG8_STAGEB(PG8_SB(1, 1), b3 + hstepB); PG8_STAGE(PG8_SA(1, 0), a3, v2[0][0], v2[0][1]);
            PG8_WAIT_V(8); PG8_WAIT_L(0); PG8_BAR; PG8_MMA(1, 0, At, B0); PG8_MMA(1, 1, At, B1); PG8_BAR; PG8_SCHED;
        }
        if (wr == 0) PG8_BAR;
        { int efr = fr, efq = fq; asm volatile("" : "+v"(efr), "+v"(efq)); E(acc, cur, wr, wc, efr, efq); }
        if (!has_next) break;
#pragma unroll
        for (int a = 0; a < 2; ++a)
#pragma unroll
            for (int b = 0; b < 2; ++b)
#pragma unroll
                for (int m = 0; m < 4; ++m)
#pragma unroll
                    for (int n = 0; n < 2; ++n) acc[a][b][m][n] = (f32x4){0.f, 0.f, 0.f, 0.f};
        cur = nxt; cA = nA; cB = nB; ++ui;
        if constexpr (GATHER) {
#pragma unroll
            for (int h = 0; h < 2; ++h)
#pragma unroll
                for (int i = 0; i < 2; ++i) vAc[h][i] = (unsigned)(rowtab[(ui & 1) * 256 + h * HALF + Rr[i]] * lda + Cc[i]) * 2u;
        }
        if (wr == 1) PG8_BAR;
    }
    PG8_WAIT_V(0);
    PG8_BAR;
#undef PG8_SA
#undef PG8_SB
#undef PG8_STAGE
#undef PG8_STAGEB
#undef PG8_LDA
#undef PG8_LDB
#undef PG8_MMA
#undef PG8_WAIT_V
#undef PG8_WAIT_L
#undef PG8_BAR
#undef PG8_SCHED
}
}
using pg8::Unit;

struct DenseSched {
    int nM, nN, G, c; const char* A; const char* Bt; size_t atile, btile;
    __device__ __forceinline__ bool next(int i, Unit& u) const { u.g = 0; return pg8::static_order(i, G, c, nM, nN, u.pm, u.pn); }
    __device__ __forceinline__ const char* a_base(const Unit& u) const { return A + (size_t)u.pm * atile; }
    __device__ __forceinline__ const char* b_base(const Unit& u) const { return Bt + (size_t)u.pn * btile; }
    __device__ __forceinline__ int a_row(const Unit&, int) const { return 0; }
};
struct GroupSched {
    int nN, G, c; const char* A; const char* Bt; size_t agroup, bgroup, atile, btile;
    __device__ __forceinline__ bool next(int i, Unit& u) const { const long L = (long)i * G + c; if (c < 0 || L >= 16 * 2 * nN) return false; const int per = 2 * nN; u.g = (int)L / per; const int r = (int)L % per; u.pm = r % 2; u.pn = r / 2; return true; }
    __device__ __forceinline__ const char* a_base(const Unit& u) const { return A + (size_t)u.g * agroup + (size_t)u.pm * atile; }
    __device__ __forceinline__ const char* b_base(const Unit& u) const { return Bt + (size_t)u.g * bgroup + (size_t)u.pn * btile; }
    __device__ __forceinline__ int a_row(const Unit&, int) const { return 0; }
};
struct MoeSched {
    int nM, nN, G, c; const char* A; const char* W; size_t wexp, atile, btile;
    const LAS int* cnt; const LAS int* tstart; const LAS unsigned char* tile_e; const int* list;
    __device__ __forceinline__ bool next(int i, Unit& u) const { const bool ok = pg8::static_order(i, G, c, nM, nN, u.pm, u.pn); u.g = ok ? (int)tile_e[u.pm] : 0; return ok; }
    __device__ __forceinline__ const char* a_base(const Unit& u) const { return A + (size_t)u.pm * atile; }
    __device__ __forceinline__ const char* b_base(const Unit& u) const { return W + (size_t)u.g * wexp + (size_t)u.pn * btile; }
    __device__ __forceinline__ int a_row(const Unit& u, int r) const { const int slot = (u.pm - tstart[u.g]) * 256 + r; return slot < cnt[u.g] ? list[(size_t)u.g * T + slot] : 0; }
};

typedef f32x4 Acc[2][2][4][2];
struct EpiProj {
    bf16 *Qimg, *Kimg, *Vimg, *Ug2, *RET; const float *cosA, *sinA, *cosR, *sinR;
    __device__ __forceinline__ void operator()(const Acc& acc, const Unit& u, int wr, int wc, int fr, int fq) const {
        const int pn = u.pn;
#pragma unroll
        for (int ai = 0; ai < 2; ++ai)
#pragma unroll
            for (int m = 0; m < 4; ++m) {
                const int row = u.pm * 256 + ai * 128 + wr * 64 + m * 16 + fr; const int b = row >> 13, t = row & 8191;
                if (pn < 4 || pn == 7 || pn == 8) {
                    const size_t to = (size_t)row * 32 + 8 * fq;
                    const float* ct = (pn < 4 ? cosA : cosR) + to; const float* st = (pn < 4 ? sinA : sinR) + to;
                    const f32x4 c0 = *(const f32x4*)ct, c1 = *(const f32x4*)(ct + 4), s0 = *(const f32x4*)st, s1 = *(const f32x4*)(st + 4);
                    const f32x4 xa0 = acc[ai][0][m][0], xa1 = acc[ai][0][m][1], xb0 = acc[ai][1][m][0], xb1 = acc[ai][1][m][1];
                    const float sc = (pn < 2) ? C2 : (pn == 8 ? 0.125f : 1.0f);
                    const f32x4 o10 = (xa0 * c0 - xb0 * s0) * sc, o11 = (xa1 * c1 - xb1 * s1) * sc, o20 = (xb0 * c0 + xa0 * s0) * sc, o21 = (xb1 * c1 + xa1 * s1) * sc;
                    const u32x4 w1 = pack8u(o10, o11), w2 = pack8u(o20, o21);
                    if (pn < 2) { const int hc = 4 * pn + wc; bf16* p = Qimg + ((size_t)(b * 8 + hc) * 8192 + t) * 64 + 8 * fq; *(u32x4*)p = w1; *(u32x4*)(p + 32) = w2; }
                    else if (pn < 4) { const int hc = 4 * (pn - 2) + wc; bf16* p = Kimg + ((size_t)((b * 8 + hc) * 128 + (t >> 6)) * 8 + fq) * 512 + (t & 63) * 8; *(u32x4*)p = w1; *(u32x4*)(p + 4 * 512) = w2; }
                    else { bf16* p = RET + (size_t)row * 1024 + (pn - 7) * 256 + 64 * wc + 8 * fq; *(u32x4*)p = w1; *(u32x4*)(p + 32) = w2; }
                } else {
#pragma unroll
                    for (int bj = 0; bj < 2; ++bj) {
                        const u32x4 w = pack8u(acc[ai][bj][m][0], acc[ai][bj][m][1]);
                        bf16* p;
                        if (pn < 6) { const int h = 2 * (pn - 4) + bj; p = Vimg + ((size_t)((b * 4 + h) * 128 + (t >> 6)) * 4 + wc) * 2048 + (t & 63) * 32 + 8 * fq; }
                        else if (pn == 6) { const int g = 8 * bj + 2 * wc + (fq >> 1); p = Ug2 + ((size_t)(g * 512 + b * 128 + (t >> 6))) * 1280 + (t & 63) * 16 + 8 * (fq & 1); }
                        else { p = RET + (size_t)row * 1024 + 512 + (pn - 9) * 256 + 128 * bj + 32 * wc + 8 * fq; }
                        *(u32x4*)p = w;
                    }
                }
                asm volatile("" ::: "memory");
            }
    }
};
struct EpiS5S {
    float* S;
    __device__ __forceinline__ void operator()(const Acc& acc, const Unit& u, int wr, int wc, int fr, int fq) const {
#pragma unroll
        for (int ai = 0; ai < 2; ++ai)
#pragma unroll
            for (int m = 0; m < 4; ++m) { float* rowp = S + ((size_t)u.g * 512 + u.pm * 256 + ai * 128 + wr * 64 + m * 16 + fr) * 256 + wc * 32 + 8 * fq;
#pragma unroll
                for (int bj = 0; bj < 2; ++bj) { *(f32x4*)(rowp + bj * 128) = acc[ai][bj][m][0]; *(f32x4*)(rowp + bj * 128 + 4) = acc[ai][bj][m][1]; } }
    }
};
struct EpiS5Y {
    bf16* Yb; const bf16* Ug2; const float* dskip;
    __device__ __forceinline__ void operator()(const Acc& acc, const Unit& u, int wr, int wc, int fr, int fq) const {
#pragma unroll
        for (int ai = 0; ai < 2; ++ai)
#pragma unroll
            for (int m = 0; m < 4; ++m) { const int bc = u.pm * 256 + ai * 128 + wr * 64 + m * 16 + fr;
#pragma unroll
                for (int bj = 0; bj < 2; ++bj) { const int col = u.pn * 256 + bj * 128 + wc * 32 + 8 * fq; const int j = col >> 4, n0 = col & 15;
                    const int tok = bc * 64 + j; const int ch = u.g * 16 + n0;
                    const u32x4 uu = *(const u32x4*)(Ug2 + ((size_t)u.g * 512 + bc) * 1280 + col);
                    const f32x4 d0 = *(const f32x4*)(dskip + ch), d1 = *(const f32x4*)(dskip + ch + 4);
                    float y[8] = {acc[ai][bj][m][0][0] + d0[0] * bflo(uu[0]), acc[ai][bj][m][0][1] + d0[1] * bfhi(uu[0]), acc[ai][bj][m][0][2] + d0[2] * bflo(uu[1]), acc[ai][bj][m][0][3] + d0[3] * bfhi(uu[1]),
                                  acc[ai][bj][m][1][0] + d1[0] * bflo(uu[2]), acc[ai][bj][m][1][1] + d1[1] * bfhi(uu[2]), acc[ai][bj][m][1][2] + d1[2] * bflo(uu[3]), acc[ai][bj][m][1][3] + d1[3] * bfhi(uu[3])};
#pragma unroll
                    for (int e = 0; e < 8; ++e) { const float v = y[e]; const float uarg = 1.5957691216057308f * (v + 0.044715f * v * v * v); y[e] = v * sigmoidf_(uarg); }
                    *(u32x4*)(Yb + (size_t)tok * 256 + ch) = (u32x4){pk2(y[0], y[1]), pk2(y[2], y[3]), pk2(y[4], y[5]), pk2(y[6], y[7])};
                    asm volatile("" ::: "memory");
                } }
    }
};
struct EpiGlu {
    bf16* MIX; const float* bias;
    __device__ __forceinline__ void operator()(const Acc& acc, const Unit& u, int wr, int wc, int fr, int fq) const {
        const int col = u.pn * 128 + wc * 32 + 8 * fq;
#pragma unroll
        for (int ai = 0; ai < 2; ++ai)
#pragma unroll
            for (int m = 0; m < 4; ++m) { const int row = u.pm * 256 + ai * 128 + wr * 64 + m * 16 + fr;
                const f32x4 ba0 = *(const f32x4*)(bias + col), ba1 = *(const f32x4*)(bias + col + 4), bb0 = *(const f32x4*)(bias + 256 + col), bb1 = *(const f32x4*)(bias + 256 + col + 4);
                const f32x4 a0 = acc[ai][0][m][0] + ba0, a1 = acc[ai][0][m][1] + ba1, g0 = acc[ai][1][m][0] + bb0, g1 = acc[ai][1][m][1] + bb1;
                f32x4 o0, o1;
#pragma unroll
                for (int e = 0; e < 4; ++e) { o0[e] = a0[e] * sigmoidf_(g0[e]); o1[e] = a1[e] * sigmoidf_(g1[e]); }
                *(u32x4*)(MIX + (size_t)row * 1024 + 512 + col) = pack8u(o0, o1); asm volatile("" ::: "memory"); }
    }
};
struct EpiOut {
    bf16* YM; const float* mod;
    __device__ __forceinline__ void operator()(const Acc& acc, const Unit& u, int wr, int wc, int fr, int fq) const {
        const int b = (u.pm * 256) >> 13;
#pragma unroll
        for (int bj = 0; bj < 2; ++bj) { const int col = u.pn * 256 + bj * 128 + wc * 32 + 8 * fq; const float* gp = mod + (size_t)b * 6144 + 2048 + col;
            const f32x4 g0 = *(const f32x4*)gp + 1.0f, g1 = *(const f32x4*)(gp + 4) + 1.0f;
#pragma unroll
            for (int ai = 0; ai < 2; ++ai)
#pragma unroll
                for (int m = 0; m < 4; ++m) { const int row = u.pm * 256 + ai * 128 + wr * 64 + m * 16 + fr;
                    *(u32x4*)(YM + (size_t)row * 1024 + col) = pack8u(g0 * acc[ai][bj][m][0], g1 * acc[ai][bj][m][1]); } }
    }
};
struct EpiMoe1 {
    bf16* A2; const float* b1;
    __device__ __forceinline__ void operator()(const Acc& acc, const Unit& u, int wr, int wc, int fr, int fq) const {
        const int j0 = u.pn * 128 + wc * 32 + 8 * fq;
        const float* bp = b1 + (size_t)u.g * 2048 + 2 * j0;
#pragma unroll
        for (int ai = 0; ai < 2; ++ai)
#pragma unroll
            for (int m = 0; m < 4; ++m) { const size_t slot = (size_t)u.pm * 256 + ai * 128 + wr * 64 + m * 16 + fr;
                const f32x4 q0 = *(const f32x4*)bp, q1 = *(const f32x4*)(bp + 4), q2 = *(const f32x4*)(bp + 8), q3 = *(const f32x4*)(bp + 12);
                const float bg[8] = {q0[0], q0[2], q1[0], q1[2], q2[0], q2[2], q3[0], q3[2]}, bl[8] = {q0[1], q0[3], q1[1], q1[3], q2[1], q2[3], q3[1], q3[3]};
                float o[8];
#pragma unroll
                for (int e = 0; e < 8; ++e) { float zg = acc[ai][0][m][e >> 2][e & 3] + bg[e], zl = acc[ai][1][m][e >> 2][e & 3] + bl[e];
                    zg = fminf(zg, 7.0f); zl = fminf(fmaxf(zl, -7.0f), 7.0f); o[e] = zg * sigmoidf_(1.702f * zg) * (zl + 1.0f); }
                *(u32x4*)(A2 + slot * 1024 + j0) = (u32x4){pk2(o[0], o[1]), pk2(o[2], o[3]), pk2(o[4], o[5]), pk2(o[6], o[7])}; asm volatile("" ::: "memory"); }
    }
};
struct EpiMoe2 {
    bf16* YS; const float* b2;
    __device__ __forceinline__ void operator()(const Acc& acc, const Unit& u, int wr, int wc, int fr, int fq) const {
#pragma unroll
        for (int bj = 0; bj < 2; ++bj) { const int col = u.pn * 256 + bj * 128 + wc * 32 + 8 * fq; const float* bp = b2 + (size_t)u.g * 1024 + col;
            const f32x4 c0 = *(const f32x4*)bp, c1 = *(const f32x4*)(bp + 4);
#pragma unroll
            for (int ai = 0; ai < 2; ++ai)
#pragma unroll
                for (int m = 0; m < 4; ++m) { const size_t slot = (size_t)u.pm * 256 + ai * 128 + wr * 64 + m * 16 + fr;
                    *(u32x4*)(YS + slot * 1024 + col) = pack8u(acc[ai][bj][m][0] + c0, acc[ai][bj][m][1] + c1); } asm volatile("" ::: "memory"); }
    }
};

struct Args {
    const void* in[30]; float* out; unsigned char* ws;
    double invfA[32], invfR[32];
    float lam_init[4];
    float lg2f[4], lg2b[4];
    int ph_lo, ph_hi;
};

template <int PERM>
__device__ __forceinline__ int perm_row(int o) {
    if (PERM == 1) { const int pn = o >> 8; if (pn < 4 || pn == 7 || pn == 8) { const int x = o & 255; return (o & ~255) + 128 * ((x >> 5) & 1) + 32 * (x >> 6) + (x & 31); } return o; }
    if (PERM == 2) return (o >> 8) * 256 + 128 * (o & 1) + ((o >> 1) & 127);
    if (PERM == 3) return 256 * ((o >> 7) & 1) + 128 * (o >> 8) + (o & 127);
    return o;
}
template <int PERM>
__device__ __forceinline__ void transpose_item(const float* W, int K, int N, bf16* WT, LAS float* scr, int item, int lane) {
    const int nblk = N / 32, kb = item / nblk, nb = item % nblk, k0 = 64 * kb, n0 = 32 * nb;
#pragma unroll 8
    for (int i = 0; i < 32; ++i) { const int kk = 2 * i + (lane >> 5); scr[kk * 33 + (lane & 31)] = W[(size_t)(k0 + kk) * N + n0 + (lane & 31)]; }
    asm volatile("s_waitcnt lgkmcnt(0)" ::: "memory");
    const int c = lane & 7;
#pragma unroll
    for (int j = 0; j < 4; ++j) { const int n = (lane >> 3) + 8 * j; const LAS float* s = scr + (8 * c) * 33 + n;
        u32x4 o; o.x = pk2(s[0 * 33], s[1 * 33]); o.y = pk2(s[2 * 33], s[3 * 33]); o.z = pk2(s[4 * 33], s[5 * 33]); o.w = pk2(s[6 * 33], s[7 * 33]);
        *(u32x4*)(WT + (size_t)perm_row<PERM>(n0 + n) * K + k0 + 8 * c) = o; }
    asm volatile("s_waitcnt lgkmcnt(0)" ::: "memory");
}
__device__ __forceinline__ void sincos_rev(double ang, float& c, float& s) {
    double rev = ang * 0.15915494309189535; rev -= __builtin_rint(rev); const float r = (float)rev;
    c = __builtin_amdgcn_cosf(r); s = __builtin_amdgcn_sinf(r);
}

__device__ __forceinline__ void row_stats(const f32x4 (&v)[4], float& mean, float& rstd) {
    float s = 0.f;
#pragma unroll
    for (int j = 0; j < 4; ++j) s += (v[j][0] + v[j][1]) + (v[j][2] + v[j][3]);
    mean = wave_sum(s) * (1.f / DM); float q = 0.f;
#pragma unroll
    for (int j = 0; j < 4; ++j) { const f32x4 d = v[j] - mean; q += (d[0] * d[0] + d[1] * d[1]) + (d[2] * d[2] + d[3] * d[3]); }
    rstd = 1.0f / sqrtf(wave_sum(q) * (1.f / DM) + LN_EPS);
}
__device__ __forceinline__ void mod_row_store(const f32x4 (&v)[4], const float* sh, const float* sc, bf16* orow, int lane) {
    float mean, rstd; row_stats(v, mean, rstd);
#pragma unroll
    for (int j = 0; j < 4; ++j) { const int col = 4 * lane + 256 * j; const f32x4 a = *(const f32x4*)(sc + col), b = *(const f32x4*)(sh + col);
        const f32x4 h = (v[j] - mean) * rstd * (a + 1.0f) + b; *(u32x2*)(orow + col) = (u32x2){pk2(h[0], h[1]), pk2(h[2], h[3])}; }
}

__device__ __forceinline__ void swap32x4(float& a0, float& b0, float& a1, float& b1, float& a2, float& b2, float& a3, float& b3) {
    asm volatile("v_nop\n\tv_nop\n\tv_permlane32_swap_b32 %0, %1\n\tv_permlane32_swap_b32 %2, %3\n\tv_permlane32_swap_b32 %4, %5\n\tv_permlane32_swap_b32 %6, %7\n\tv_nop\n\tv_nop"
                 : "+v"(a0), "+v"(b0), "+v"(a1), "+v"(b1), "+v"(a2), "+v"(b2), "+v"(a3), "+v"(b3)); }
__device__ __forceinline__ void swap16x4(float& a0, float& b0, float& a1, float& b1, float& a2, float& b2, float& a3, float& b3) {
    asm volatile("v_nop\n\tv_nop\n\tv_permlane16_swap_b32 %0, %1\n\tv_permlane16_swap_b32 %2, %3\n\tv_permlane16_swap_b32 %4, %5\n\tv_permlane16_swap_b32 %6, %7\n\tv_nop\n\tv_nop"
                 : "+v"(a0), "+v"(b0), "+v"(a1), "+v"(b1), "+v"(a2), "+v"(b2), "+v"(a3), "+v"(b3)); }
template <int CTRL> __device__ __forceinline__ float dppmov(float v) { return __builtin_bit_cast(float, __builtin_amdgcn_update_dpp(0, __builtin_bit_cast(int, v), CTRL, 0xF, 0xF, true)); }
__device__ __forceinline__ float wave_max(float v) {
    v = fmaxf(v, dppmov<0xB1>(v)); v = fmaxf(v, dppmov<0x4E>(v)); v = fmaxf(v, dppmov<0x141>(v)); v = fmaxf(v, dppmov<0x140>(v));
    { float w = v; asm volatile("v_nop\n\tv_nop\n\tv_permlane16_swap_b32 %0, %1\n\tv_nop\n\tv_nop" : "+v"(v), "+v"(w)); v = fmaxf(v, w); }
    return swap32_max(v);
}
struct Top4 { float t0, t1, t2, t3; int i0, i1, i2, i3; };
__device__ __forceinline__ void top4_init(Top4& q) { q.t0 = q.t1 = q.t2 = q.t3 = -INFINITY; q.i0 = q.i1 = q.i2 = q.i3 = 0; }
__device__ __forceinline__ void top4_insert(Top4& q, float x, int e) {
    const bool c3 = x > q.t3; q.t3 = c3 ? x : q.t3; q.i3 = c3 ? e : q.i3;
    const bool c2 = q.t3 > q.t2; { const float a = q.t2, b = q.t3; const int ia = q.i2, ib = q.i3; q.t2 = c2 ? b : a; q.t3 = c2 ? a : b; q.i2 = c2 ? ib : ia; q.i3 = c2 ? ia : ib; }
    const bool c1 = q.t2 > q.t1; { const float a = q.t1, b = q.t2; const int ia = q.i1, ib = q.i2; q.t1 = c1 ? b : a; q.t2 = c1 ? a : b; q.i1 = c1 ? ib : ia; q.i2 = c1 ? ia : ib; }
    const bool c0 = q.t1 > q.t0; { const float a = q.t0, b = q.t1; const int ia = q.i0, ib = q.i1; q.t0 = c0 ? b : a; q.t1 = c0 ? a : b; q.i0 = c0 ? ib : ia; q.i1 = c0 ? ia : ib; }
}

__device__ __forceinline__ void attn_unit(LAS unsigned char* lds, const bf16* Qimg, const bf16* Kimg, const bf16* Vimg, bf16* MIX, const int b, const int h, const int qb,
                                          const float lam, const float* subg, const float outscale) {
    const int tid = otid(), lane = tid & 63, r32 = lane & 31, hi = lane >> 5; const int wid = __builtin_amdgcn_readfirstlane(tid >> 6);
    const int comp = wid & 1, qsub = (wid >> 1) & 3, grp = wid >> 2, hc = 2 * h + comp;
    const bf16* Qw = Qimg + ((size_t)(b * 8 + hc) * 8192 + qb * 128 + qsub * 32 + r32) * 64;
    bf16x8 qr[4];
#pragma unroll
    for (int d0 = 0; d0 < 4; ++d0) qr[d0] = *(const bf16x8*)(Qw + d0 * 16 + hi * 8);
    asm volatile("s_waitcnt vmcnt(0)" ::: "memory");
    const bf16* K1 = Kimg + (size_t)((b * 8 + 2 * h) * 128) * 4096 + tid * 8;
    const bf16* K2 = Kimg + (size_t)((b * 8 + 2 * h + 1) * 128) * 4096 + tid * 8;
    const bf16* Vg = Vimg + (size_t)((b * 4 + h) * 128) * 8192 + tid * 8;
    LAS float* wsf = (LAS float*)(lds + TAB_OFF) + wid * 64;
    f32x16 o[4];
#pragma unroll
    for (int d = 0; d < 4; ++d) o[d] = (f32x16){};
    float mrow = 0.f, lrow = 0.f;
    const unsigned ldsw = (unsigned)wid * 1024u;
#define ATT_DMA(tt) do { const size_t tt_ = (size_t)(tt); LAS unsigned char* sb_ = lds + ((tt) & 3) * 32768 + ldsw; \
        __builtin_amdgcn_global_load_lds((const unsigned*)(K1 + tt_ * 4096), (LAS unsigned*)(sb_), 16, 0, 0); \
        __builtin_amdgcn_global_load_lds((const unsigned*)(K2 + tt_ * 4096), (LAS unsigned*)(sb_ + 8192), 16, 0, 0); \
        __builtin_amdgcn_global_load_lds((const unsigned*)(Vg + tt_ * 8192), (LAS unsigned*)(sb_ + 16384), 16, 0, 0); \
        __builtin_amdgcn_global_load_lds((const unsigned*)(Vg + tt_ * 8192 + 4096), (LAS unsigned*)(sb_ + 24576), 16, 0, 0); } while (0)
#define ATT_QK(P0, P1, tt) do { const LAS unsigned char* Ks_ = lds + ((tt) & 3) * 32768 + comp * 8192 + hi * 1024 + r32 * 16; \
        { const bf16x8 a0_ = *(const LAS bf16x8*)(Ks_), a1_ = *(const LAS bf16x8*)(Ks_ + 512); \
          P0 = __builtin_amdgcn_mfma_f32_32x32x16_bf16(a0_, qr[0], negm, 0, 0, 0); P1 = __builtin_amdgcn_mfma_f32_32x32x16_bf16(a1_, qr[0], negm, 0, 0, 0); } \
        _Pragma("unroll") for (int d0_ = 1; d0_ < 4; ++d0_) { const bf16x8 a0_ = *(const LAS bf16x8*)(Ks_ + d0_ * 2048), a1_ = *(const LAS bf16x8*)(Ks_ + d0_ * 2048 + 512); \
          P0 = __builtin_amdgcn_mfma_f32_32x32x16_bf16(a0_, qr[d0_], P0, 0, 0, 0); P1 = __builtin_amdgcn_mfma_f32_32x32x16_bf16(a1_, qr[d0_], P1, 0, 0, 0); } } while (0)
    ATT_DMA(0); ATT_DMA(1); ATT_DMA(2);
    asm volatile("s_waitcnt vmcnt(8)" ::: "memory");
    __builtin_amdgcn_s_barrier();
    const int vlane = ((lane & 15) >> 2) * 64 + ((lane >> 4) & 1) * 32 + (lane & 3) * 8 + hi * 256;
    f32x16 p0, p1;
    { const f32x16 negm = (f32x16){}; ATT_QK(p0, p1, 0); }
    asm volatile("s_waitcnt vmcnt(4) lgkmcnt(0)" ::: "memory");
    __builtin_amdgcn_s_barrier();
    if (grp == 1) { __builtin_amdgcn_s_setprio(1); __builtin_amdgcn_s_barrier(); }
    for (int i = 0; i < 128; ++i) {
        float rm, rm2;
        asm("v_max3_f32 %0, %1, %2, %3" : "=v"(rm) : "v"(p0[0]), "v"(p0[1]), "v"(p0[2]));
        asm("v_max3_f32 %0, %1, %2, %3" : "=v"(rm2) : "v"(p1[0]), "v"(p1[1]), "v"(p1[2]));
#pragma unroll
        for (int r = 3; r < 15; r += 2) { asm("v_max3_f32 %0, %1, %2, %3" : "=v"(rm) : "v"(rm), "v"(p0[r]), "v"(p0[r + 1])); asm("v_max3_f32 %0, %1, %2, %3" : "=v"(rm2) : "v"(rm2), "v"(p1[r]), "v"(p1[r + 1])); }
        asm("v_max3_f32 %0, %1, %2, %3" : "=v"(rm) : "v"(rm), "v"(p0[15]), "v"(p1[15]));
        rm = swap32_max(fmaxf(rm, rm2));
        const bool need = (i == 0) || (rm > 6.0f);
        if (__any(need)) {
            const float dl = need ? rm : 0.f;
            mrow += dl;
#pragma unroll
            for (int r = 0; r < 16; ++r) { p0[r] -= dl; p1[r] -= dl; }
            if (i > 0) {
                const float f = fexp2(-dl); lrow *= f;
                if (hi == 0) wsf[r32] = f;
                asm volatile("s_waitcnt lgkmcnt(0)" ::: "memory");
#pragma unroll
                for (int r = 0; r < 16; ++r) { const float fr_ = wsf[crow(r, hi)];
#pragma unroll
                    for (int d = 0; d < 4; ++d) o[d][r] *= fr_; }
            }
        }
        float ls0 = 0.f, ls1 = 0.f;
#pragma unroll
        for (int r = 0; r < 16; ++r) { p0[r] = fexp2(p0[r]); p1[r] = fexp2(p1[r]); ls0 += p0[r]; ls1 += p1[r]; }
        lrow += ls0 + ls1;
        const bf16x8 pa0 = pack8(p0[0], p0[1], p0[2], p0[3], p0[4], p0[5], p0[6], p0[7]), pa1 = pack8(p0[8], p0[9], p0[10], p0[11], p0[12], p0[13], p0[14], p0[15]);
        const bf16x8 pa2 = pack8(p1[0], p1[1], p1[2], p1[3], p1[4], p1[5], p1[6], p1[7]), pa3 = pack8(p1[8], p1[9], p1[10], p1[11], p1[12], p1[13], p1[14], p1[15]);
        bf16x8 kf[4], kg[4];
        const LAS unsigned char* Ks_ = lds + ((i + 1) & 3) * 32768 + comp * 8192 + hi * 1024 + r32 * 16;
        kf[0] = *(const LAS bf16x8*)(Ks_); kf[1] = *(const LAS bf16x8*)(Ks_ + 512); kf[2] = *(const LAS bf16x8*)(Ks_ + 2048); kf[3] = *(const LAS bf16x8*)(Ks_ + 2560);
        asm volatile("s_waitcnt vmcnt(0) lgkmcnt(0)" ::: "memory");
        __builtin_amdgcn_s_barrier();
        __builtin_amdgcn_sched_barrier(0);
        const LAS char* Vs = (const LAS char*)lds + (i & 3) * 32768 + 16384 + vlane;
#define ATT_LDV(dst, d) do { dst[0] = cat8(vtr(Vs + (d) * 4096), vtr(Vs + (d) * 4096 + 512)); dst[1] = cat8(vtr(Vs + (d) * 4096 + 1024), vtr(Vs + (d) * 4096 + 1536)); \
        dst[2] = cat8(vtr(Vs + (d) * 4096 + 2048), vtr(Vs + (d) * 4096 + 2560)); dst[3] = cat8(vtr(Vs + (d) * 4096 + 3072), vtr(Vs + (d) * 4096 + 3584)); } while (0)
#define ATT_PV(d, vv) do { asm volatile("" : "+v"(o[d])); o[d] = __builtin_amdgcn_mfma_f32_32x32x16_bf16(pa0, vv[0], o[d], 0, 0, 0); o[d] = __builtin_amdgcn_mfma_f32_32x32x16_bf16(pa1, vv[1], o[d], 0, 0, 0); \
        o[d] = __builtin_amdgcn_mfma_f32_32x32x16_bf16(pa2, vv[2], o[d], 0, 0, 0); o[d] = __builtin_amdgcn_mfma_f32_32x32x16_bf16(pa3, vv[3], o[d], 0, 0, 0); } while (0)
        bf16x8 va[4], vb[4];
        kg[0] = *(const LAS bf16x8*)(Ks_ + 4096); kg[1] = *(const LAS bf16x8*)(Ks_ + 4608); kg[2] = *(const LAS bf16x8*)(Ks_ + 6144); kg[3] = *(const LAS bf16x8*)(Ks_ + 6656);
        ATT_LDV(va, 0);
        __builtin_amdgcn_sched_barrier(0);
        if (i + 1 < 128) {
            f32x16 negm; { const float nm_ = -mrow;
#pragma unroll
                for (int r = 0; r < 16; ++r) negm[r] = nm_; }
            p0 = __builtin_amdgcn_mfma_f32_32x32x16_bf16(kf[0], qr[0], negm, 0, 0, 0); p1 = __builtin_amdgcn_mfma_f32_32x32x16_bf16(kf[1], qr[0], negm, 0, 0, 0);
            p0 = __builtin_amdgcn_mfma_f32_32x32x16_bf16(kf[2], qr[1], p0, 0, 0, 0); p1 = __builtin_amdgcn_mfma_f32_32x32x16_bf16(kf[3], qr[1], p1, 0, 0, 0);
            asm volatile("s_waitcnt lgkmcnt(8)" ::: "memory"); __builtin_amdgcn_sched_barrier(0);
            p0 = __builtin_amdgcn_mfma_f32_32x32x16_bf16(kg[0], qr[2], p0, 0, 0, 0); p1 = __builtin_amdgcn_mfma_f32_32x32x16_bf16(kg[1], qr[2], p1, 0, 0, 0);
            p0 = __builtin_amdgcn_mfma_f32_32x32x16_bf16(kg[2], qr[3], p0, 0, 0, 0); p1 = __builtin_amdgcn_mfma_f32_32x32x16_bf16(kg[3], qr[3], p1, 0, 0, 0);
        }
        __builtin_amdgcn_sched_barrier(0);
        ATT_LDV(vb, 1);
        asm volatile("s_waitcnt lgkmcnt(8)" ::: "memory"); __builtin_amdgcn_sched_barrier(0);
        ATT_PV(0, va);
        __builtin_amdgcn_sched_barrier(0);
        ATT_LDV(va, 2);
        asm volatile("s_waitcnt lgkmcnt(8)" ::: "memory"); __builtin_amdgcn_sched_barrier(0);
        ATT_PV(1, vb);
        __builtin_amdgcn_sched_barrier(0);
        ATT_LDV(vb, 3);
        asm volatile("s_waitcnt lgkmcnt(8)" ::: "memory"); __builtin_amdgcn_sched_barrier(0);
        ATT_PV(2, va);
        asm volatile("s_waitcnt lgkmcnt(0)" ::: "memory"); __builtin_amdgcn_sched_barrier(0);
        ATT_PV(3, vb);
        __builtin_amdgcn_sched_barrier(0);
#undef ATT_LDV
#undef ATT_PV
        if (i + 3 < 128) { ATT_DMA(i + 3); asm volatile("s_waitcnt vmcnt(4) lgkmcnt(0)" ::: "memory"); }
        else asm volatile("s_waitcnt vmcnt(0) lgkmcnt(0)" ::: "memory");
        __builtin_amdgcn_s_barrier();
        __builtin_amdgcn_sched_barrier(0);
    }
    if (grp == 0) __builtin_amdgcn_s_barrier(); else __builtin_amdgcn_s_setprio(0);
#undef ATT_DMA
#undef ATT_QK
    lrow = swap32_add(lrow);
    if (hi == 0) wsf[r32] = frcp(lrow);
    asm volatile("s_waitcnt lgkmcnt(0)" ::: "memory");
#pragma unroll
    for (int r = 0; r < 16; ++r) { const float il = wsf[crow(r, hi)];
#pragma unroll
        for (int d = 0; d < 4; ++d) o[d][r] *= il; }
    LAS float* xb = (LAS float*)lds + (size_t)qsub * 4096 + lane;
    if (comp == 1) {
#pragma unroll
        for (int d = 0; d < 4; ++d)
#pragma unroll
            for (int r = 0; r < 16; ++r) xb[(d * 16 + r) * 64] = o[d][r];
    }
    __syncthreads();
    if (comp == 0) {
        float ss[16];
#pragma unroll
        for (int r = 0; r < 16; ++r) { ss[r] = 0.f;
#pragma unroll
            for (int d = 0; d < 4; ++d) { const float v = o[d][r] - lam * xb[(d * 16 + r) * 64]; o[d][r] = v; ss[r] += v * v; } }
        float gcol[4];
#pragma unroll
        for (int d = 0; d < 4; ++d) gcol[d] = subg[d * 32 + r32] * outscale;
#pragma unroll
        for (int r = 0; r < 16; ++r) { const float tot = half_sum(ss[r]); const float rs = 1.0f / sqrtf(tot * (1.f / 128.f) + LN_EPS);
            bf16* orow = MIX + ((size_t)b * 8192 + qb * 128 + qsub * 32 + crow(r, hi)) * 1024 + h * 128 + r32;
#pragma unroll
            for (int d = 0; d < 4; ++d) orow[d * 32] = (bf16)(pk2(o[d][r] * rs * gcol[d], 0.f) & 0xffffu); }
    }
    __syncthreads();
}

__device__ __forceinline__ void ret_kv_pair(LAS unsigned char* lds, const bf16* RET, float* RKV, const int unit0, const float* lg2f, const float* lg2b) {
    const int tid = otid(), lane = tid & 63, r32 = lane & 31, hi = lane >> 5; const int wid = __builtin_amdgcn_readfirstlane(tid >> 6);
    const int wg = wid >> 2, w4 = wid & 3, t4 = tid & 255;
    const int unit = unit0 + wg; const int bh = unit >> 6, n = unit & 63, b = bh >> 2, h = bh & 3;
    LAS unsigned char* base = lds + wg * 49152;
    const float l2f = lg2f[h], l2b = lg2b[h];
    const bf16* src = RET + ((size_t)b * 8192 + n * 128) * 1024 + 64 * h;
#pragma unroll
    for (int i = 0; i < 4; ++i) { const int idx = t4 + 256 * i; const int j = idx >> 3, c = idx & 7;
        const u32x4 kk = *(const u32x4*)(src + (size_t)j * 1024 + 256 + c * 8); const u32x4 vv = *(const u32x4*)(src + (size_t)j * 1024 + 512 + c * 8);
        const float wf = fexp2((float)(127 - j) * l2f), wb = fexp2((float)j * l2b);
        u32x4 vf, vb;
#pragma unroll
        for (int e = 0; e < 4; ++e) { const float lo = bflo(vv[e]), hh = bfhi(vv[e]); vf[e] = pk2(lo * wf, hh * wf); vb[e] = pk2(lo * wb, hh * wb); }
        *(LAS u32x4*)(base + j * 128 + c * 16) = kk; *(LAS u32x4*)(base + 16384 + j * 128 + c * 16) = vf; *(LAS u32x4*)(base + 32768 + j * 128 + c * 16) = vb; }
    __syncthreads();
    const int da = w4 >> 1, eb = w4 & 1;
    const int rowoff = (8 * hi + ((lane & 15) >> 2)) * 128 + (16 * ((lane >> 4) & 1) + 4 * (lane & 3)) * 2;
    f32x16 af = (f32x16){}, ab = (f32x16){};
#pragma unroll
    for (int s = 0; s < 8; ++s) {
        const LAS char* kp = (const LAS char*)base + s * 2048 + rowoff + da * 64;
        const LAS char* vp = (const LAS char*)base + 16384 + s * 2048 + rowoff + eb * 64;
        const bf16x8 ka = cat8(vtr(kp), vtr(kp + 512));
        const bf16x8 vf = cat8(vtr(vp), vtr(vp + 512)), vb = cat8(vtr(vp + 16384), vtr(vp + 16384 + 512));
        af = __builtin_amdgcn_mfma_f32_32x32x16_bf16(ka, vf, af, 0, 0, 0);
        ab = __builtin_amdgcn_mfma_f32_32x32x16_bf16(ka, vb, ab, 0, 0, 0);
    }
    float* of = RKV + ((size_t)(bh * 64 + n) * 2) * 4096 + eb * 32 + r32;
#pragma unroll
    for (int r = 0; r < 16; ++r) { const int d = da * 32 + crow(r, hi); of[d * 64] = af[r]; of[4096 + d * 64] = ab[r]; }
    __syncthreads();
}
__device__ __forceinline__ void ret_out_pair(LAS unsigned char* lds, const bf16* RET, const bf16* RST, bf16* MIX, const int unit0, const float* lg2f, const float* lg2b) {
    const int tid = otid(), lane = tid & 63, r32 = lane & 31, hi = lane >> 5; const int wid = __builtin_amdgcn_readfirstlane(tid >> 6);
    const int wg = wid >> 2, w4 = wid & 3, t4 = tid & 255;
    const int unit = unit0 + wg; const int bh = unit >> 6, n = unit & 63, b = bh >> 2, h = bh & 3;
    LAS unsigned char* base = lds + wg * 49152;
    const float l2f = lg2f[h], l2b = lg2b[h];
    const size_t row0 = (size_t)b * 8192 + n * 128;
    const bf16* src = RET + row0 * 1024 + 64 * h;
#pragma unroll
    for (int i = 0; i < 4; ++i) { const int idx = t4 + 256 * i; const int j = idx >> 3, c = idx & 7;
        *(LAS u32x4*)(base + j * 128 + c * 16) = *(const u32x4*)(src + (size_t)j * 1024 + 256 + c * 8);
        *(LAS u32x4*)(base + 16384 + j * 128 + c * 16) = *(const u32x4*)(src + (size_t)j * 1024 + 512 + c * 8); }
    const bf16* rs = RST + ((size_t)(bh * 64 + n) * 2) * 4096;
#pragma unroll
    for (int i = 0; i < 4; ++i) { const int idx = t4 + 256 * i;
        *(LAS u32x4*)(base + 32768 + idx * 16) = *(const u32x4*)(rs + (size_t)idx * 8); }
    bf16x8 qr[4];
    const bf16* qp = src + (size_t)(32 * w4 + r32) * 1024;
#pragma unroll
    for (int d0 = 0; d0 < 4; ++d0) qr[d0] = *(const bf16x8*)(qp + d0 * 16 + hi * 8);
    __syncthreads();
    const int cq = 32 * w4 + r32;
    f32x16 yi[2] = {(f32x16){}, (f32x16){}}, yf[2] = {(f32x16){}, (f32x16){}}, yb[2] = {(f32x16){}, (f32x16){}};
    const int trl = ((lane & 15) >> 2) * 128 + (16 * ((lane >> 4) & 1) + 4 * (lane & 3)) * 2;
#pragma unroll
    for (int kb = 0; kb < 4; ++kb) {
        f32x16 p = (f32x16){};
#pragma unroll
        for (int d0 = 0; d0 < 4; ++d0) { const bf16x8 a = *(const LAS bf16x8*)(base + (32 * kb + r32) * 128 + (16 * d0 + 8 * hi) * 2); p = __builtin_amdgcn_mfma_f32_32x32x16_bf16(a, qr[d0], p, 0, 0, 0); }
#pragma unroll
        for (int r = 0; r < 16; ++r) { const int j = 32 * kb + crow(r, hi); const int rel = cq - j; p[r] *= fexp2(rel >= 0 ? (float)rel * l2f : (float)(-rel) * l2b); }
        const bf16x8 pa0 = pack8(p[0], p[1], p[2], p[3], p[4], p[5], p[6], p[7]), pa1 = pack8(p[8], p[9], p[10], p[11], p[12], p[13], p[14], p[15]);
#pragma unroll
        for (int eb = 0; eb < 2; ++eb) {
            const LAS char* vp = (const LAS char*)base + 16384 + (32 * kb + 4 * hi) * 128 + trl + eb * 64;
            const bf16x8 v0 = cat8(vtr(vp), vtr(vp + 8 * 128)), v1 = cat8(vtr(vp + 16 * 128), vtr(vp + 24 * 128));
            yi[eb] = __builtin_amdgcn_mfma_f32_32x32x16_bf16(pa0, v0, yi[eb], 0, 0, 0);
            yi[eb] = __builtin_amdgcn_mfma_f32_32x32x16_bf16(pa1, v1, yi[eb], 0, 0, 0);
        }
    }
#pragma unroll
    for (int d0 = 0; d0 < 4; ++d0)
#pragma unroll
        for (int eb = 0; eb < 2; ++eb) {
            const LAS char* rp = (const LAS char*)base + 32768 + (16 * d0 + 8 * hi) * 128 + trl + eb * 64;
            const bf16x8 rf = cat8(vtr(rp), vtr(rp + 4 * 128)), rb = cat8(vtr(rp + 8192), vtr(rp + 8192 + 4 * 128));
            yf[eb] = __builtin_amdgcn_mfma_f32_32x32x16_bf16(qr[d0], rf, yf[eb], 0, 0, 0);
            yb[eb] = __builtin_amdgcn_mfma_f32_32x32x16_bf16(qr[d0], rb, yb[eb], 0, 0, 0);
        }
#pragma unroll
    for (int r = 0; r < 16; ++r) {
        const int c = 32 * w4 + crow(r, hi);
        const float sf = fexp2((float)(c + 1) * l2f), sb = fexp2((float)(128 - c) * l2b);
        const float y0 = yi[0][r] + sf * yf[0][r] + sb * yb[0][r], y1 = yi[1][r] + sf * yf[1][r] + sb * yb[1][r];
        const float mean = half_sum(y0 + y1) * (1.f / 64.f); const float d0_ = y0 - mean, d1_ = y1 - mean;
        const float var = half_sum(d0_ * d0_ + d1_ * d1_) * (1.f / 64.f); const float rstd = 1.0f / sqrtf(var + LN_EPS);
        const bf16* gp = RET + (row0 + c) * 1024 + 768 + 64 * h + r32; bf16* op = MIX + (row0 + c) * 1024 + 768 + 64 * h + r32;
        const float g0 = bf2f(gp[0]), g1 = bf2f(gp[32]);
        op[0] = (bf16)(pk2(g0 * sigmoidf_(g0) * d0_ * rstd, 0.f) & 0xffffu); op[32] = (bf16)(pk2(g1 * sigmoidf_(g1) * d1_ * rstd, 0.f) & 0xffffu);
    }
    __syncthreads();
}

__device__ __forceinline__ int moe_tables(LAS unsigned char* lds, const unsigned* gcnt) {
    LAS int* cnt = (LAS int*)(lds + TAB_OFF); LAS int* tstart = cnt + 32; LAS unsigned char* tile_e = (LAS unsigned char*)(tstart + 36);
    const int tid = otid();
    if (tid < 32) cnt[tid] = (int)gcnt[tid];
    __syncthreads();
    if (tid == 0) { int s = 0; for (int e = 0; e < 32; ++e) { tstart[e] = s; s += (cnt[e] + 255) >> 8; } tstart[32] = s; }
    __syncthreads();
    const int ntile = tstart[32];
    for (int p = tid; p < ntile; p += NTHR) { int e = 0;
#pragma unroll
        for (int k = 1; k < 32; ++k) e += (tstart[k] <= p) ? 1 : 0;
        tile_e[p] = (unsigned char)e; }
    __syncthreads();
    return ntile;
}

constexpr int NPH_LAYER = 10, NPH = 3 + DEPTH * NPH_LAYER;
#ifndef PH_MASK
#define PH_MASK 0x1FFFF
#endif
#define PHM(j) (((PH_MASK) >> (j)) & 1)
#ifndef DUP_MASK
#define DUP_MASK 0x0
#endif
#define NREP(j) (1 + (((DUP_MASK) >> (j)) & 1))
__global__ void __launch_bounds__(NTHR, 2) hybrid_fwd(Args args) {
    extern __shared__ __attribute__((aligned(16))) unsigned char lds_raw[];
    LAS unsigned char* lds = (LAS unsigned char*)lds_raw;
    volatile LAS unsigned* MISC = (volatile LAS unsigned*)(lds + MISC_OFF);
    const int G = gridDim.x, bx = blockIdx.x;
    const int NGW = G * NWAVES, NGT = G * NTHR;
#define PH_IDS const int tid = otid(); const int lane = tid & 63; const int wave = __builtin_amdgcn_readfirstlane(tid >> 6); const int gw = bx * NWAVES + wave; const int gt = bx * NTHR + tid; (void)lane; (void)gw; (void)gt; (void)wave;
    unsigned char* ws = args.ws;
    unsigned* ctl = (unsigned*)(ws + WS_CTL);
    for (int u = threadIdx.x; u < (LDS_BYTES - LDSCTL_OFF) / 4; u += NTHR) ((LAS unsigned*)(lds + LDSCTL_OFF))[u] = 0u;
    __syncthreads();
#if MK_SPLIT
    XcdBarrier bar; bar.bar = ctl + CW_BAR; bar.x = 0; bar.st = nullptr;
#define GRID_BAR() do { } while (0)
#else
    XcdBarrier bar = xcd_barrier_post(ctl + CW_BAR, MISC + 8);
#define GRID_BAR() xcd_barrier(bar)
#endif
    const int lo = args.ph_lo, hi_ph = args.ph_hi;
#define IN(k) (lo <= (k) && (k) < hi_ph)
#ifndef BAR_REP
#define BAR_REP 1
#endif
#define SEAM(k) do { if (IN((k) + 1)) { for (int br_ = 0; br_ < BAR_REP; ++br_) GRID_BAR(); } STAMP(k); } while (0)
#if STAMP_SEL >= 0
    if (threadIdx.x == 0) { const unsigned long long t0_ = __builtin_amdgcn_s_memrealtime(); MISC[16] = (unsigned)t0_; MISC[17] = (unsigned)(t0_ >> 32); MISC[18] = 0u; }
#define STAMP(k) do { if (threadIdx.x == 0) { const unsigned long long now_ = __builtin_amdgcn_s_memrealtime(); const unsigned long long last_ = (unsigned long long)MISC[16] | ((unsigned long long)MISC[17] << 32); \
        if ((k) == STAMP_SEL) MISC[18] = __float_as_uint((float)(now_ - last_) * 0.0002f); MISC[16] = (unsigned)now_; MISC[17] = (unsigned)(now_ >> 32); } } while (0)
#else
#define STAMP(k) do { } while (0)
#endif

    const float* x_in = (const float*)args.in[0]; const float* c_in = (const float*)args.in[1]; const int* pos_in = (const int*)args.in[2];
    const float* ada_w = (const float*)args.in[3]; const float* ada_b = (const float*)args.in[4];
    const float* w_in = (const float*)args.in[5]; const float* w_out = (const float*)args.in[6];
    const float* lq1 = (const float*)args.in[7]; const float* lk1 = (const float*)args.in[8]; const float* lq2 = (const float*)args.in[9]; const float* lk2 = (const float*)args.in[10];
    const float* subln_g = (const float*)args.in[11];
    const float* s5_lre = (const float*)args.in[12]; const float* s5_lim = (const float*)args.in[13]; const float* s5_ls = (const float*)args.in[14];
    const float* s5_bre = (const float*)args.in[15]; const float* s5_bim = (const float*)args.in[16]; const float* s5_cre = (const float*)args.in[17]; const float* s5_cim = (const float*)args.in[18];
    const float* s5_d = (const float*)args.in[19]; const float* glu_w = (const float*)args.in[20]; const float* glu_b = (const float*)args.in[21];
    const float* ln_g = (const float*)args.in[22]; const float* ln_b = (const float*)args.in[23];
    const float* router_w = (const float*)args.in[24]; const float* router_b = (const float*)args.in[25];
    const float* exp_w1 = (const float*)args.in[26]; const float* exp_b1 = (const float*)args.in[27]; const float* exp_w2 = (const float*)args.in[28]; const float* exp_b2 = (const float*)args.in[29];
    float* MOD = (float*)(ws + WS_MOD); float* ROT = (float*)(ws + WS_ROT); float* PW = (float*)(ws + WS_PW); float* BB = (float*)(ws + WS_BB);
    bf16* WIN = (bf16*)(ws + WS_WIN); bf16* WOUT = (bf16*)(ws + WS_WOUT); bf16* GLU = (bf16*)(ws + WS_GLU); bf16* W1S = (bf16*)(ws + WS_W1S); bf16* TW = (bf16*)(ws + WS_TW);
    bf16* W1 = (bf16*)(ws + WS_W1); bf16* W2 = (bf16*)(ws + WS_W2); bf16* HB = (bf16*)(ws + WS_HB);
    bf16* QIMG = (bf16*)(ws + WS_QIMG); bf16* KIMG = (bf16*)(ws + WS_KIMG); bf16* VIMG = (bf16*)(ws + WS_VIMG); bf16* UG2 = (bf16*)(ws + WS_UG2); bf16* RET = (bf16*)(ws + WS_RET);
    float* S5S = (float*)(ws + WS_S5S); bf16* YB = (bf16*)(ws + WS_YB); float* RKV = (float*)(ws + WS_RKV); bf16* RST = (bf16*)(ws + WS_RST); bf16* MIX = (bf16*)(ws + WS_MIX);
    float* YPRE = (float*)(ws + WS_YPRE); float* X1 = (float*)(ws + WS_X1); float* XB = (float*)(ws + WS_XB);
    int* LIST = (int*)(ws + WS_LIST); int* TOKI = (int*)(ws + WS_TOKI); float* GATE = (float*)(ws + WS_GATE); bf16* A2 = (bf16*)(ws + WS_A2); bf16* YS = (bf16*)(ws + WS_YS);
    float* COSA = ROT, *SINA = ROT + (size_t)T * 32, *COSR = ROT + (size_t)T * 64, *SINR = ROT + (size_t)T * 96;

    if (PHM(10) && IN(0)) {
        PH_IDS
        for (int rep = 0; rep < NREP(10); ++rep) {
        LAS float* cond = (LAS float*)lds; LAS float* red = (LAS float*)(lds + 16384);
        for (int i = tid; i < 4096; i += NTHR) { const float v = c_in[i]; cond[i] = v * sigmoidf_(v); }
        __syncthreads();
        for (int it = bx; it < 4 * 96; it += G) {
            const int l = it / 96, n0 = (it % 96) * 64;
            float a0 = 0.f, a1 = 0.f, a2 = 0.f, a3 = 0.f;
            const float* wp = ada_w + ((size_t)l * 1024 + wave * 128) * 6144 + n0 + lane;
#pragma unroll 8
            for (int kk = 0; kk < 128; ++kk) { const float wv = wp[(size_t)kk * 6144]; const int k = wave * 128 + kk; a0 += cond[k] * wv; a1 += cond[1024 + k] * wv; a2 += cond[2048 + k] * wv; a3 += cond[3072 + k] * wv; }
            red[(wave * 4 + 0) * 64 + lane] = a0; red[(wave * 4 + 1) * 64 + lane] = a1; red[(wave * 4 + 2) * 64 + lane] = a2; red[(wave * 4 + 3) * 64 + lane] = a3;
            __syncthreads();
            if (tid < 256) { const int b = tid >> 6; float s = ada_b[(size_t)l * 6144 + n0 + lane];
#pragma unroll
                for (int w = 0; w < 8; ++w) s += red[(w * 4 + b) * 64 + lane];
                MOD[((size_t)l * 4 + b) * 6144 + n0 + lane] = s; }
            __syncthreads();
        }
        for (int i = gt; i < T * 32; i += NGT) { const int row = i >> 5, f = i & 31; const double p = (double)pos_in[row];
            float c, s; sincos_rev(p * args.invfA[f], c, s); COSA[i] = c; SINA[i] = s; sincos_rev(p * args.invfR[f], c, s); COSR[i] = c; SINR[i] = s; }
        for (int i = gt; i < DEPTH * 32 * 1024; i += NGT) { const int k = i & 1023, e = (i >> 10) & 31, ll = i >> 15; ((float*)(ws + WS_ROUTW))[i] = router_w[((size_t)ll * 1024 + k) * 32 + e]; }
        for (int i = gt; i < 4 * 2 * 16 * 64; i += NGT) {
            const int g = (i >> 6) & 15, ld = i >> 10;
            const float lr = fminf(s5_lre[i], -1e-4f), li = s5_lim[i]; const float dt = expf(s5_ls[ld * 16 + g]);
            float* pw = PW + (size_t)i * 130;
            for (int tau = 0; tau <= 64; ++tau) { const float mag = expf((float)tau * lr * dt); float c, s; sincos_rev((double)tau * (double)li * (double)dt, c, s); pw[2 * tau] = mag * c; pw[2 * tau + 1] = mag * s; }
            const float ar = pw[2], ai = pw[3], den = lr * lr + li * li;
            const float fre = ((ar - 1.0f) * lr + ai * li) / den, fim = (ai * lr - (ar - 1.0f) * li) / den;
            for (int n = 0; n < 16; ++n) { const float br = s5_bre[(size_t)i * 16 + n], bi = s5_bim[(size_t)i * 16 + n]; BB[((size_t)i * 16 + n) * 2] = fre * br - fim * bi; BB[((size_t)i * 16 + n) * 2 + 1] = fre * bi + fim * br; }
        }
        __syncthreads(); }
        SEAM(0);
    }
    if (PHM(11) && IN(1)) {
        PH_IDS
        for (int rep = 0; rep < NREP(11); ++rep) {
        if (wave >= 4) {
        const int gw2 = bx * 4 + (wave - 4), NGW2 = G * 4, bt = bx * 256 + (tid - 256), NBT = G * 256;
        for (int m0 = gw2; m0 < T; m0 += 4 * NGW2) { f32x4 v[4][4];
#pragma unroll
            for (int r = 0; r < 4; ++r) { const f32x4* xr = (const f32x4*)(x_in + (size_t)(m0 + r * NGW2) * DM) + lane;
#pragma unroll
                for (int j = 0; j < 4; ++j) v[r][j] = xr[64 * j]; }
#pragma unroll
            for (int r = 0; r < 4; ++r) { const int m = m0 + r * NGW2; const float* md = MOD + (size_t)(m >> 13) * 6144; mod_row_store(v[r], md, md + 1024, HB + (size_t)m * DM, lane); } }
        float* KT = S5S;
#pragma unroll 2
        for (int i = bt; i < 4 * 16 * 2 * 64 * 256; i += NBT) {
            const int mm = i & 15, n = (i >> 4) & 15, tau = (i >> 8) & 63, dir = (i >> 14) & 1, g = (i >> 15) & 15, l = i >> 19;
            const size_t pg = ((size_t)(l * 2 + dir) * 16 + g);
            const float* cr = s5_cre + (pg * 16 + n) * 64; const float* ci = s5_cim + (pg * 16 + n) * 64;
            const float* pw = PW + pg * 64 * 130 + 2 * tau; const float* bb = BB + (pg * 64 * 16 + mm) * 2;
            float acc = 0.f;
#pragma unroll 8
            for (int p = 0; p < 64; ++p) { const float pr = pw[(size_t)p * 130], pi = pw[(size_t)p * 130 + 1], br = bb[(size_t)p * 32], bi = bb[(size_t)p * 32 + 1];
                acc += cr[p] * (pr * br - pi * bi) - ci[p] * (pr * bi + pi * br); }
            KT[i] = acc;
        }
#pragma unroll 2
        for (int i = bt; i < 4 * 16 * 1024 * 32; i += NBT) {
            const int c8 = i & 31, rowj = (i >> 5) & 1023, g = (i >> 15) & 15, l = i >> 19;
            const int col = c8 * 8, dir = col >> 7, part = (col >> 6) & 1, p0 = col & 63;
            const size_t pg = ((size_t)(l * 2 + dir) * 16 + g);
            const int j = rowj >> 4, n = rowj & 15; const int tau = dir == 0 ? j + 1 : 64 - j;
            const float* cp = s5_cre + (pg * 16 + n) * 64 + p0; const float* cq = s5_cim + (pg * 16 + n) * 64 + p0;
            const f32x4 cr0 = *(const f32x4*)cp, cr1 = *(const f32x4*)(cp + 4), ci0 = *(const f32x4*)cq, ci1 = *(const f32x4*)(cq + 4);
            float v[8];
#pragma unroll
            for (int e = 0; e < 8; ++e) { const f32x2 a = *(const f32x2*)(PW + (pg * 64 + p0 + e) * 130 + 2 * tau); const float cr = e < 4 ? cr0[e & 3] : cr1[e & 3], ci = e < 4 ? ci0[e & 3] : ci1[e & 3];
                v[e] = part == 0 ? (cr * a[0] - ci * a[1]) : -(cr * a[1] + ci * a[0]); }
            *(u32x4*)(TW + ((size_t)(l * 16 + g) * 1024 + rowj) * 1280 + 1024 + col) = (u32x4){pk2(v[0], v[1]), pk2(v[2], v[3]), pk2(v[4], v[5]), pk2(v[6], v[7])};
        }
#pragma unroll 2
        for (int i = bt; i < 4 * 16 * 256 * 128; i += NBT) {
            const int c8 = i & 127, p2 = (i >> 7) & 255, g = (i >> 15) & 15, l = i >> 19;
            const int dir = p2 >> 7, part = (p2 >> 6) & 1, p = p2 & 63;
            const size_t pg = ((size_t)(l * 2 + dir) * 16 + g);
            const int sidx = c8 >> 1, m0 = (c8 & 1) * 8; const int tau = dir == 0 ? 63 - sidx : sidx;
            const f32x2 pwv = *(const f32x2*)(PW + (pg * 64 + p) * 130 + 2 * tau);
            const float* bp = BB + ((pg * 64 + p) * 16 + m0) * 2;
            const f32x4 b0 = *(const f32x4*)bp, b1 = *(const f32x4*)(bp + 4), b2 = *(const f32x4*)(bp + 8), b3 = *(const f32x4*)(bp + 12);
            const float br[8] = {b0[0], b0[2], b1[0], b1[2], b2[0], b2[2], b3[0], b3[2]}, bi[8] = {b0[1], b0[3], b1[1], b1[3], b2[1], b2[3], b3[1], b3[3]};
            float v[8];
#pragma unroll
            for (int e = 0; e < 8; ++e) v[e] = part == 0 ? (pwv[0] * br[e] - pwv[1] * bi[e]) : (pwv[0] * bi[e] + pwv[1] * br[e]);
            *(u32x4*)(W1S + (size_t)i * 8) = (u32x4){pk2(v[0], v[1]), pk2(v[2], v[3]), pk2(v[4], v[5]), pk2(v[6], v[7])};
        }
        }
        {
            LAS float* scr = (LAS float*)(lds + 32768 + wave * 8704);
            constexpr int I_IN = 16 * 88, I_OUT = 16 * 32, I_GLU = 4 * 16, I_W1 = 16 * 64, I_W2 = 16 * 32;
            constexpr int N_SMALL = DEPTH * (I_IN + I_OUT + I_GLU);
            constexpr int N_ALL = N_SMALL + DEPTH * NE * (I_W1 + I_W2);
            for (;;) {
                int it0 = 0; if (lane == 0) it0 = (int)__hip_atomic_fetch_add(ctl + CW_CONV, 16u, __ATOMIC_RELAXED, __HIP_MEMORY_SCOPE_AGENT);
                it0 = __builtin_amdgcn_readfirstlane(it0);
                if (it0 >= N_ALL) break;
                for (int it = it0; it < it0 + 16 && it < N_ALL; ++it) {
                int r = it;
                if (r < N_SMALL) {
                    const int l = r / (I_IN + I_OUT + I_GLU); r %= (I_IN + I_OUT + I_GLU);
                    if (r < I_IN) transpose_item<1>(w_in + (size_t)l * 1024 * INW, 1024, INW, WIN + (size_t)l * INW * 1024, scr, r, lane);
                    else if (r < I_IN + I_OUT) transpose_item<0>(w_out + (size_t)l * 1024 * 1024, 1024, 1024, WOUT + (size_t)l * 1024 * 1024, scr, r - I_IN, lane);
                    else transpose_item<3>(glu_w + (size_t)l * 256 * 512, 256, 512, GLU + (size_t)l * 512 * 256, scr, r - I_IN - I_OUT, lane);
                } else {
                    r -= N_SMALL; const int le = r / (I_W1 + I_W2); r %= (I_W1 + I_W2);
                    if (r < I_W1) transpose_item<2>(exp_w1 + (size_t)le * 1024 * 2048, 1024, 2048, W1 + (size_t)le * 2048 * 1024, scr, r, lane);
                    else transpose_item<0>(exp_w2 + (size_t)le * 1024 * 1024, 1024, 1024, W2 + (size_t)le * 1024 * 1024, scr, r - I_W1, lane);
                }
                }
            }
        }
        }
        SEAM(1);
    }
    if (PHM(11) && IN(2)) {
        PH_IDS
        const float* KT = S5S;
#pragma unroll 4
        for (int i = gt; i < 4 * 16 * 1024 * 128; i += NGT) {
            const int c8 = i & 127, rowj = (i >> 7) & 1023, lg = i >> 17;
            const int sidx = c8 >> 1, m0 = (c8 & 1) * 8, j = rowj >> 4, n = rowj & 15;
            const int d = j - sidx; const int tau = d >= 0 ? d : -d;
            const float* kf = KT + ((((size_t)lg * 2 + (d >= 0 ? 0 : 1)) * 64 + tau) * 16 + n) * 16 + m0;
            f32x4 a0 = *(const f32x4*)kf, a1 = *(const f32x4*)(kf + 4);
            if (d == 0) { const float* kb = kf + (size_t)64 * 256; a0 += *(const f32x4*)kb; a1 += *(const f32x4*)(kb + 4); }
            *(u32x4*)(TW + ((size_t)lg * 1024 + rowj) * 1280 + sidx * 16 + m0) = pack8u(a0, a1);
        }
        SEAM(2);
    }

    for (int l = 0; l < DEPTH; ++l) {
        const int P = 3 + l * NPH_LAYER;
        const float* xcur = (l == 0) ? x_in : XB;
        float* xnext = (l == DEPTH - 1) ? args.out : XB;
        const float* modl = MOD + (size_t)l * 4 * 6144;
        unsigned* gcnt = ctl + CW_GCNT + 64 * l;
        if (PHM(0) && IN(P + 0)) {
            DenseSched S{T / 256, INW / 256, G, bx, (const char*)HB, (const char*)(WIN + (size_t)l * INW * 1024), (size_t)256 * 1024 * 2, (size_t)256 * 1024 * 2};
            EpiProj E{QIMG, KIMG, VIMG, UG2, RET, COSA, SINA, COSR, SINR};
            for (int rep = 0; rep < NREP(0); ++rep) pg8::gemm_phase<EpiProj, DenseSched, false>(lds, 1024, 1024, 1024, S, E);
            SEAM(P + 0);
        }
        if (PHM(1) && IN(P + 1)) {
            GroupSched S{1, G, bx, (const char*)UG2, (const char*)(W1S + (size_t)l * 16 * 256 * 1024), (size_t)512 * 1280 * 2, (size_t)256 * 1024 * 2, (size_t)256 * 1280 * 2, (size_t)256 * 1024 * 2};
            EpiS5S E{S5S};
            for (int rep = 0; rep < NREP(1); ++rep) {
            if (PHM(12)) pg8::gemm_phase<EpiS5S, GroupSched, false>(lds, 1024, 1280, 1024, S, E);
            __syncthreads();
            if (PHM(13)) for (int pr = bx; pr < 512; pr += G) ret_kv_pair(lds, RET, RKV, 2 * pr, args.lg2f, args.lg2b);
            }
            SEAM(P + 1);
        }
        if (PHM(2) && IN(P + 2)) {
            PH_IDS
            for (int rep = 0; rep < NREP(2); ++rep) {
            if (bx < 128) {
                const int dir = bx & 1, g = (bx >> 1) & 15, b = bx >> 5;
                const size_t pg = ((size_t)(l * 2 + dir) * 16 + g);
                const float aqr = PW[(pg * 64 + lane) * 130 + 128], aqi = PW[(pg * 64 + lane) * 130 + 129];
                const float* sb = S5S + ((size_t)g * 512 + b * 128) * 256 + dir * 128 + lane;
                bf16* ob = UG2 + ((size_t)g * 512 + b * 128) * 1280 + 1024 + dir * 128 + lane;
                float sr[16], si[16];
#pragma unroll
                for (int k = 0; k < 16; ++k) { const int cc = 16 * wave + k; const int c = dir == 0 ? cc : 127 - cc; sr[k] = sb[(size_t)c * 256]; si[k] = sb[(size_t)c * 256 + 64]; }
                float hr = 0.f, hi2 = 0.f;
#pragma unroll
                for (int k = 0; k < 16; ++k) { const float nr = aqr * hr - aqi * hi2 + sr[k], ni = aqr * hi2 + aqi * hr + si[k]; hr = nr; hi2 = ni; }
                LAS float* seg = (LAS float*)lds;
                seg[(wave * 2 + 0) * 64 + lane] = hr; seg[(wave * 2 + 1) * 64 + lane] = hi2;
                float a16r = aqr, a16i = aqi;
#pragma unroll
                for (int q = 0; q < 4; ++q) { const float tr_ = a16r * a16r - a16i * a16i, ti_ = 2.f * a16r * a16i; a16r = tr_; a16i = ti_; }
                __syncthreads();
                hr = 0.f; hi2 = 0.f;
                for (int w2 = 0; w2 < wave; ++w2) { const float er = seg[(w2 * 2 + 0) * 64 + lane], ei = seg[(w2 * 2 + 1) * 64 + lane]; const float nr = a16r * hr - a16i * hi2 + er, ni = a16r * hi2 + a16i * hr + ei; hr = nr; hi2 = ni; }
#pragma unroll
                for (int k = 0; k < 16; ++k) { const int cc = 16 * wave + k; const int c = dir == 0 ? cc : 127 - cc;
                    ob[(size_t)c * 1280] = (bf16)(pk2(hr, 0.f) & 0xffffu); ob[(size_t)c * 1280 + 64] = (bf16)(pk2(hi2, 0.f) & 0xffffu);
                    const float nr = aqr * hr - aqi * hi2 + sr[k], ni = aqr * hi2 + aqi * hr + si[k]; hr = nr; hi2 = ni; }
                __syncthreads();
            }
            for (int i = gt; i < 2 * 16 * 4096; i += NGT) { const int idx = i & 4095, dir = (i >> 12) & 1, bh = i >> 13, h = bh & 3;
                const float dk = fexp2(128.f * (dir == 0 ? args.lg2f[h] : args.lg2b[h]));
                const float* kv = RKV + (size_t)bh * 64 * 2 * 4096 + dir * 4096 + idx; bf16* rs = RST + (size_t)bh * 64 * 2 * 4096 + dir * 4096 + idx;
                float st = 0.f;
#pragma unroll 16
                for (int nn = 0; nn < 64; ++nn) { const int n = dir == 0 ? nn : 63 - nn; const float v = kv[(size_t)n * 8192]; rs[(size_t)n * 8192] = (bf16)(pk2(st, 0.f) & 0xffffu); st = dk * st + v; }
            }
            }
            SEAM(P + 2);
        }
        if (PHM(3) && IN(P + 3)) {
            float lam;
            { float s1 = 0.f, s2 = 0.f; for (int i = 0; i < 64; ++i) { s1 += lq1[l * 64 + i] * lk1[l * 64 + i]; s2 += lq2[l * 64 + i] * lk2[l * 64 + i]; } lam = expf(s1) - expf(s2) + args.lam_init[l]; }
            if (PHM(14)) for (int rep = 0; rep < NREP(14); ++rep) for (int u = bx; u < 1024; u += G) { const int qb = u & 63, bh = u >> 6; attn_unit(lds, QIMG, KIMG, VIMG, MIX, bh >> 2, bh & 3, qb, lam, subln_g + l * 128, 1.0f - args.lam_init[l]); }
            const int half = G >> 1;
            if (PHM(15)) {
                GroupSched S{4, half, bx < half ? bx : -1, (const char*)UG2, (const char*)(TW + (size_t)l * 16 * 1024 * 1280), (size_t)512 * 1280 * 2, (size_t)1024 * 1280 * 2, (size_t)256 * 1280 * 2, (size_t)256 * 1280 * 2};
                EpiS5Y E{YB, UG2, s5_d + l * 256};
                for (int rep = 0; rep < NREP(15); ++rep) pg8::gemm_phase<EpiS5Y, GroupSched, false>(lds, 1280, 1280, 1280, S, E);
            }
            __syncthreads();
            if (PHM(16)) for (int rep = 0; rep < NREP(16); ++rep) {
                if (bx < half) ret_out_pair(lds, RET, RST, MIX, 2 * bx, args.lg2f, args.lg2b);
                else for (int k = 0; k < 3; ++k) ret_out_pair(lds, RET, RST, MIX, 2 * (half + (bx - half) * 3 + k), args.lg2f, args.lg2b);
            }
            SEAM(P + 3);
        }
        if (PHM(4) && IN(P + 4)) {
            DenseSched S{T / 256, 2, G, bx, (const char*)YB, (const char*)(GLU + (size_t)l * 512 * 256), (size_t)256 * 256 * 2, (size_t)256 * 256 * 2};
            EpiGlu E{MIX, glu_b + l * 512};
            for (int rep = 0; rep < NREP(4); ++rep) pg8::gemm_phase<EpiGlu, DenseSched, false>(lds, 256, 256, 256, S, E);
            SEAM(P + 4);
        }
        if (PHM(5) && IN(P + 5)) {
            DenseSched S{T / 256, 4, G, bx, (const char*)MIX, (const char*)(WOUT + (size_t)l * 1024 * 1024), (size_t)256 * 1024 * 2, (size_t)256 * 1024 * 2};
            EpiOut E{(bf16*)YPRE, modl};
            for (int rep = 0; rep < NREP(5); ++rep) pg8::gemm_phase<EpiOut, DenseSched, false>(lds, 1024, 1024, 1024, S, E);
            SEAM(P + 5);
        }
        if (PHM(6) && IN(P + 6)) {
            PH_IDS
            for (int rep = 0; rep < NREP(6); ++rep) { const bool commit = (rep == NREP(6) - 1);
            __syncthreads();
            LAS float* WT = (LAS float*)lds;
            for (int i = tid; i < 8192; i += NTHR) ((LAS f32x4*)WT)[i] = ((const f32x4*)(ws + WS_ROUTW) + (size_t)l * 8192)[i];
            LAS int* lcnt = (LAS int*)(lds + TAB_OFF); LAS int* lbase = lcnt + 32; LAS int* ent = lbase + 32;
            if (tid < 32) lcnt[tid] = 0;
            __syncthreads();
            const float rbv = router_b[l * 32 + (lane >> 1)];
            int it = 0;
            f32x4 xn[2][4]; u32x2 yn[2][4];
#pragma unroll
            for (int r = 0; r < 2; ++r)
#pragma unroll
                for (int j = 0; j < 4; ++j) { yn[r][j] = *(const u32x2*)((const bf16*)YPRE + (size_t)(gw + r * NGW) * DM + 4 * lane + 256 * j); xn[r][j] = *((const f32x4*)(xcur + (size_t)(gw + r * NGW) * DM) + lane + 64 * j); }
            for (int m0 = gw; m0 < T; m0 += 2 * NGW, ++it) {
                f32x4 v[2][4]; float mean[2], rstd[2];
#pragma unroll
                for (int r = 0; r < 2; ++r)
#pragma unroll
                    for (int j = 0; j < 4; ++j) { const u32x2 ym = yn[r][j]; v[r][j] = xn[r][j] * DN_ALPHA + (f32x4){bflo(ym[0]), bfhi(ym[0]), bflo(ym[1]), bfhi(ym[1])}; }
                { const int mn = (m0 + 2 * NGW < T) ? m0 + 2 * NGW : m0;
#pragma unroll
                  for (int r = 0; r < 2; ++r)
#pragma unroll
                    for (int j = 0; j < 4; ++j) { yn[r][j] = *(const u32x2*)((const bf16*)YPRE + (size_t)(mn + r * NGW) * DM + 4 * lane + 256 * j); xn[r][j] = *((const f32x4*)(xcur + (size_t)(mn + r * NGW) * DM) + lane + 64 * j); } }
#pragma unroll
                for (int r = 0; r < 2; ++r) row_stats(v[r], mean[r], rstd[r]);
#pragma unroll
                for (int j = 0; j < 4; ++j) { const int col = 4 * lane + 256 * j; const f32x4 gg = *(const f32x4*)(ln_g + (size_t)(l * 2) * DM + col), bb = *(const f32x4*)(ln_b + (size_t)(l * 2) * DM + col);
#pragma unroll
                    for (int r = 0; r < 2; ++r) { v[r][j] = (v[r][j] - mean[r]) * rstd[r] * gg + bb; *(f32x4*)(X1 + (size_t)(m0 + r * NGW) * DM + col) = v[r][j]; } }
#pragma unroll
                for (int r = 0; r < 2; ++r) row_stats(v[r], mean[r], rstd[r]);
#pragma unroll
                for (int r = 0; r < 2; ++r) { const int m = m0 + r * NGW; const float* sh = modl + (size_t)(m >> 13) * 6144 + 3 * 1024; const float* sc = sh + 1024;
#pragma unroll
                    for (int j = 0; j < 4; ++j) { const int col = 4 * lane + 256 * j; const f32x4 a = *(const f32x4*)(sc + col), bb = *(const f32x4*)(sh + col);
                        v[r][j] = (v[r][j] - mean[r]) * rstd[r] * (a + 1.0f) + bb; *(u32x2*)(HB + (size_t)m * DM + col) = (u32x2){pk2(v[r][j][0], v[r][j][1]), pk2(v[r][j][2], v[r][j][3])}; } }
#pragma unroll
                for (int r = 0; r < 2; ++r) {
                    float pe[32];
#pragma unroll
                    for (int eg = 0; eg < 8; ++eg) {
#pragma unroll
                        for (int e = 4 * eg; e < 4 * eg + 4; ++e) { f32x2 a01 = (f32x2){0.f, 0.f}, a23 = (f32x2){0.f, 0.f};
#pragma unroll
                            for (int j = 0; j < 4; ++j) { const f32x4 w = *(const LAS f32x4*)(WT + e * 1024 + 4 * lane + 256 * j);
                                a01 = __builtin_elementwise_fma(__builtin_shufflevector(v[r][j], v[r][j], 0, 1), __builtin_shufflevector(w, w, 0, 1), a01);
                                a23 = __builtin_elementwise_fma(__builtin_shufflevector(v[r][j], v[r][j], 2, 3), __builtin_shufflevector(w, w, 2, 3), a23); }
                            const f32x2 s2 = a01 + a23; pe[e] = s2[0] + s2[1]; }
                        asm volatile("" ::: "memory");
                    }
#pragma unroll
                    for (int e = 0; e < 16; e += 4) swap32x4(pe[e], pe[e + 16], pe[e + 1], pe[e + 17], pe[e + 2], pe[e + 18], pe[e + 3], pe[e + 19]);
#pragma unroll
                    for (int e = 0; e < 16; ++e) pe[e] += pe[e + 16];
#pragma unroll
                    for (int e = 0; e < 8; e += 4) swap16x4(pe[e], pe[e + 8], pe[e + 1], pe[e + 9], pe[e + 2], pe[e + 10], pe[e + 3], pe[e + 11]);
#pragma unroll
                    for (int e = 0; e < 8; ++e) pe[e] += pe[e + 8];
                    { const bool b3 = (lane & 8) != 0;
#pragma unroll
                      for (int j = 0; j < 4; ++j) { const float snd = b3 ? pe[j] : pe[j + 4], kp = b3 ? pe[j + 4] : pe[j]; pe[j] = kp + dppmov<0x128>(snd); } }
                    { const bool b2 = (lane & 4) != 0;
#pragma unroll
                      for (int j = 0; j < 2; ++j) { const float snd = b2 ? pe[j] : pe[j + 2], kp = b2 ? pe[j + 2] : pe[j]; pe[j] = kp + dppmov<0x1B>(dppmov<0x141>(snd)); } }
                    { const bool b1 = (lane & 2) != 0; const float snd = b1 ? pe[0] : pe[1], kp = b1 ? pe[1] : pe[0]; pe[0] = kp + dppmov<0x4E>(snd); }
                    float lgv = pe[0] + dppmov<0xB1>(pe[0]) + rbv;
                    int te[4]; float tv[4];
#pragma unroll
                    for (int k = 0; k < 4; ++k) { const float mx = wave_max(lgv); const unsigned long long bm = __ballot(lgv == mx); const int fl = __ffsll((long long)bm) - 1;
                        te[k] = fl >> 1; tv[k] = mx; lgv = ((lane >> 1) == (fl >> 1)) ? -INFINITY : lgv; }
                    float gs = 0.f, ge[4];
#pragma unroll
                    for (int k = 0; k < 4; ++k) { ge[k] = fexp2((tv[k] - tv[0]) * LOG2E); gs += ge[k]; }
                    const float ig = 1.0f / gs;
                    if (lane < 4 && commit) { const int e = lane == 0 ? te[0] : lane == 1 ? te[1] : lane == 2 ? te[2] : te[3]; const float gv = (lane == 0 ? ge[0] : lane == 1 ? ge[1] : lane == 2 ? ge[2] : ge[3]) * ig;
                        const int lp = atomicAdd((int*)&lcnt[e], 1);
                        const int sl = (wave * 32 + it * 2 + r) * 4 + lane; ent[sl * 3] = e; ent[sl * 3 + 1] = lp; ent[sl * 3 + 2] = __float_as_int(gv); }
                }
            }
            if (!commit) continue;
            __syncthreads();
            if (tid < 32) lbase[tid] = (int)atomicAdd(gcnt + tid, (unsigned)lcnt[tid]);
            __syncthreads();
            { int nl = 0; for (int m = gw; m < T; m += NGW, ++nl) { if (lane < 4) { const int sl = (wave * 32 + nl) * 4 + lane; const int e = ent[sl * 3], pos = lbase[e] + ent[sl * 3 + 1];
                    LIST[(size_t)e * T + pos] = m; TOKI[((size_t)m * 4 + lane) * 2] = e; TOKI[((size_t)m * 4 + lane) * 2 + 1] = pos; GATE[(size_t)m * 4 + lane] = __int_as_float(ent[sl * 3 + 2]); } } }
            }
            SEAM(P + 6);
        }
        if (PHM(7) && IN(P + 7)) {
            const int ntile = moe_tables(lds, gcnt);
            LAS int* cnt = (LAS int*)(lds + TAB_OFF);
            MoeSched S{ntile, 8, G, bx, (const char*)HB, (const char*)(W1 + (size_t)l * 32 * 2048 * 1024), (size_t)2048 * 1024 * 2, 0, (size_t)256 * 1024 * 2, cnt, cnt + 32, (const LAS unsigned char*)(cnt + 68), LIST};
            EpiMoe1 E{A2, exp_b1 + (size_t)l * 32 * 2048};
            for (int rep = 0; rep < NREP(7); ++rep) pg8::gemm_phase<EpiMoe1, MoeSched, true>(lds, 1024, 1024, 1024, S, E);
            SEAM(P + 7);
        }
        if (PHM(8) && IN(P + 8)) {
            const int ntile = moe_tables(lds, gcnt);
            LAS int* cnt = (LAS int*)(lds + TAB_OFF);
            MoeSched S{ntile, 4, G, bx, (const char*)A2, (const char*)(W2 + (size_t)l * 32 * 1024 * 1024), (size_t)1024 * 1024 * 2, (size_t)256 * 1024 * 2, (size_t)256 * 1024 * 2, cnt, cnt + 32, (const LAS unsigned char*)(cnt + 68), LIST};
            EpiMoe2 E{YS, exp_b2 + (size_t)l * 32 * 1024};
            for (int rep = 0; rep < NREP(8); ++rep) pg8::gemm_phase<EpiMoe2, MoeSched, false>(lds, 1024, 1024, 1024, S, E);
            SEAM(P + 8);
        }
        if (PHM(9) && IN(P + 9)) {
            PH_IDS
            (void)moe_tables(lds, gcnt);
            const LAS int* tstart = (const LAS int*)(lds + TAB_OFF) + 32;
            for (int rep = 0; rep < NREP(9); ++rep)
            for (int m0 = gw; m0 < T; m0 += 2 * NGW) {
                int te[2][4], tp[2][4]; float tg[2][4];
#pragma unroll
                for (int r = 0; r < 2; ++r) { const int m = m0 + r * NGW; const u32x4 q0 = *(const u32x4*)(TOKI + (size_t)m * 8), q1 = *(const u32x4*)(TOKI + (size_t)m * 8 + 4); const f32x4 gq = *(const f32x4*)(GATE + (size_t)m * 4);
                    te[r][0] = q0[0]; tp[r][0] = q0[1]; te[r][1] = q0[2]; tp[r][1] = q0[3]; te[r][2] = q1[0]; tp[r][2] = q1[1]; te[r][3] = q1[2]; tp[r][3] = q1[3];
                    tg[r][0] = gq[0]; tg[r][1] = gq[1]; tg[r][2] = gq[2]; tg[r][3] = gq[3]; }
                u32x2 yw[2][4][4]; f32x4 xx[2][4];
#pragma unroll
                for (int r = 0; r < 2; ++r) {
#pragma unroll
                    for (int k = 0; k < 4; ++k) { const bf16* yr = YS + ((size_t)tstart[te[r][k]] * 256 + tp[r][k]) * 1024;
#pragma unroll
                        for (int j = 0; j < 4; ++j) yw[r][k][j] = *(const u32x2*)(yr + 4 * lane + 256 * j); }
#pragma unroll
                    for (int j = 0; j < 4; ++j) xx[r][j] = *(const f32x4*)(X1 + (size_t)(m0 + r * NGW) * DM + 4 * lane + 256 * j); }
#pragma unroll
                for (int r = 0; r < 2; ++r) {
                    const int m = m0 + r * NGW, b = m >> 13;
                    const float* g2 = modl + (size_t)b * 6144 + 5 * 1024;
                    f32x4 v[4];
#pragma unroll
                    for (int j = 0; j < 4; ++j) { f32x4 ff = (f32x4){0.f, 0.f, 0.f, 0.f};
#pragma unroll
                        for (int k = 0; k < 4; ++k) { const u32x2 w = yw[r][k][j]; ff += (f32x4){bflo(w[0]), bfhi(w[0]), bflo(w[1]), bfhi(w[1])} * tg[r][k]; }
                        const f32x4 gg = *(const f32x4*)(g2 + 4 * lane + 256 * j); v[j] = xx[r][j] * DN_ALPHA + (gg + 1.0f) * ff; }
                    float mean, rstd; row_stats(v, mean, rstd);
#pragma unroll
                    for (int j = 0; j < 4; ++j) { const int col = 4 * lane + 256 * j; const f32x4 gg = *(const f32x4*)(ln_g + (size_t)(l * 2 + 1) * DM + col), bb = *(const f32x4*)(ln_b + (size_t)(l * 2 + 1) * DM + col);
                        v[j] = (v[j] - mean) * rstd * gg + bb; *(f32x4*)(xnext + (size_t)m * DM + col) = v[j]; }
                    if (l + 1 < DEPTH) { const float* md = MOD + ((size_t)(l + 1) * 4 + b) * 6144; mod_row_store(v, md, md + 1024, HB + (size_t)m * DM, lane); }
                }
            }
            SEAM(P + 9);
        }
    }
#if STAMP_SEL >= 0
    __syncthreads();
    if (bx == 0 && threadIdx.x == 0) args.out[0] = __uint_as_float(MISC[18]);
#endif
#undef IN
#undef SEAM
#undef GRID_BAR
}

extern "C" void kernel_launch(void* const* d_in, const int* in_sizes, int n_in, void* d_out, int out_size, void* d_ws, size_t ws_size, hipStream_t stream) {
    static int grid = 0;
    if (grid == 0) {
        if (n_in != 30 || in_sizes[0] != T * DM || out_size != T * DM || ws_size < WS_END) { fprintf(stderr, "kernel_launch: unexpected problem (n_in %d, in0 %d, out %d, ws %zu)\n", n_in, n_in > 0 ? in_sizes[0] : -1, out_size, ws_size); grid = -1; return; }
        int dev = 0, cus = 0, per_cu = 0;
        if (hipGetDevice(&dev) != hipSuccess || hipDeviceGetAttribute(&cus, hipDeviceAttributeMultiprocessorCount, dev) != hipSuccess) { grid = -1; return; }
        if (hipFuncSetAttribute((const void*)hybrid_fwd, hipFuncAttributeMaxDynamicSharedMemorySize, LDS_BYTES) != hipSuccess) { fprintf(stderr, "kernel_launch: hipFuncSetAttribute failed\n"); grid = -1; return; }
        if (hipOccupancyMaxActiveBlocksPerMultiprocessor(&per_cu, (const void*)hybrid_fwd, NTHR, LDS_BYTES) != hipSuccess || per_cu < 1) { fprintf(stderr, "kernel_launch: occupancy query says %d\n", per_cu); (void)hipGetLastError(); if (per_cu < 1) { grid = -1; return; } }
        grid = cus;
        if (grid > 256) grid = 256;
        if (grid < 128) { grid = -1; return; }
    }
    if (grid < 0) return;
    (void)hipMemsetAsync((char*)d_ws + WS_CTL, 0, CTL_BYTES, stream);
    Args a{};
    for (int i = 0; i < 30; ++i) a.in[i] = d_in[i];
    a.out = (float*)d_out; a.ws = (unsigned char*)d_ws;
    for (int i = 0; i < 32; ++i) { a.invfA[i] = std::pow(10000.0, -(double)i / 32.0); a.invfR[i] = std::pow(10000.0, -(double)i / 31.0); }
    for (int l = 0; l < 4; ++l) a.lam_init[l] = (float)(0.8 - 0.6 * std::exp(-0.3 * l));
    for (int h = 0; h < 4; ++h) { a.lg2f[h] = (float)std::log2(1.0 - std::exp2(-5.0 - h)); a.lg2b[h] = (float)std::log2(1.0 - std::exp2(-5.5 - h)); }
#if MK_SPLIT
    for (int p = 0; p < NPH; ++p) { a.ph_lo = p; a.ph_hi = p + 1; hipLaunchKernelGGL(hybrid_fwd, dim3(grid), dim3(NTHR), LDS_BYTES, stream, a); }
#else
    a.ph_lo = 0; a.ph_hi = NPH;
    hipLaunchKernelGGL(hybrid_fwd, dim3(grid), dim3(NTHR), LDS_BYTES, stream, a);
#endif
}
```

```cpp
#include <hip/hip_runtime.h>
#include <cstdio>
#include <cstdint>
#include <cmath>

#define LAS __attribute__((address_space(3)))
#define GAS __attribute__((address_space(1)))
typedef unsigned short bf16;
typedef short bf16x8 __attribute__((ext_vector_type(8)));
typedef short s16x4 __attribute__((ext_vector_type(4)));
typedef float f32x4 __attribute__((ext_vector_type(4)));
typedef float f32x2 __attribute__((ext_vector_type(2)));
typedef float f32x16 __attribute__((ext_vector_type(16)));
typedef unsigned u32x4 __attribute__((ext_vector_type(4)));
typedef unsigned u32x2 __attribute__((ext_vector_type(2)));
typedef __bf16 bf16x2_t __attribute__((ext_vector_type(2)));

#ifndef STAMP_SEL
#define STAMP_SEL -1
#endif
#ifndef MK_SPLIT
#define MK_SPLIT 0
#endif

constexpr int NB = 4, SEQ = 8192, DM = 1024, T = NB * SEQ, DEPTH = 4;
constexpr int INW = 2816, NE = 32;
constexpr int NTILE_MAX = T * 4 / 256 + NE;
constexpr float LN_EPS = 1e-5f;
constexpr float C2 = 0.125f * 1.4426950408889634f;
constexpr float LOG2E = 1.4426950408889634f;
constexpr float DN_ALPHA = 1.681792830507429f;

constexpr size_t MiB = 1u << 20;
constexpr size_t WS_CTL = 0, CTL_BYTES = 65536;
constexpr size_t WS_MOD = 1 * MiB;
constexpr size_t WS_ROUTW = 1 * MiB + 512 * 1024;
constexpr size_t WS_ROT = 2 * MiB;
constexpr size_t WS_PW = 18 * MiB;
constexpr size_t WS_BB = 23 * MiB;
constexpr size_t WS_WIN = 24 * MiB;
constexpr size_t WS_WOUT = 46 * MiB;
constexpr size_t WS_GLU = 54 * MiB;
constexpr size_t WS_W1S = 56 * MiB;
constexpr size_t WS_TW = 88 * MiB;
constexpr size_t WS_W1 = 248 * MiB;
constexpr size_t WS_W2 = 760 * MiB;
constexpr size_t WS_HB = 1016 * MiB;
constexpr size_t WS_QIMG = 1080 * MiB;
constexpr size_t WS_KIMG = 1112 * MiB;
constexpr size_t WS_VIMG = 1144 * MiB;
constexpr size_t WS_UG2 = 1176 * MiB;
constexpr size_t WS_RET = 1196 * MiB;
constexpr size_t WS_S5S = 1260 * MiB;
constexpr size_t WS_YB = 1268 * MiB;
constexpr size_t WS_RKV = 1284 * MiB;
constexpr size_t WS_RST = 1316 * MiB;
constexpr size_t WS_MIX = 1332 * MiB;
constexpr size_t WS_YPRE = 1396 * MiB;
constexpr size_t WS_X1 = 1524 * MiB;
constexpr size_t WS_XB = 1652 * MiB;
constexpr size_t WS_LIST = 1780 * MiB;
constexpr size_t WS_TOKI = 1784 * MiB;
constexpr size_t WS_GATE = 1785 * MiB;
constexpr size_t WS_A2 = 1786 * MiB;
constexpr size_t WS_YS = 2058 * MiB;
constexpr size_t WS_S5S4 = 2330 * MiB;
constexpr size_t WS_END = 2362 * MiB;

constexpr int CW_TMO = 0, CW_BAR = 1024, CW_CONV = 4608, CW_GCNT = 8192;

constexpr int RING_BYTES = 131072;
constexpr int LDSCTL_OFF = RING_BYTES, MISC_OFF = LDSCTL_OFF + 320, TAB_OFF = LDSCTL_OFF + 512;
constexpr int LDS_BYTES = 147456;
constexpr int NWAVES = 8, NTHR = 512;

#define RLX_AGENT __ATOMIC_RELAXED, __HIP_MEMORY_SCOPE_AGENT
__device__ __forceinline__ unsigned pk2(float lo, float hi) { f32x2 v = {lo, hi}; bf16x2_t b = __builtin_convertvector(v, bf16x2_t); return __builtin_bit_cast(unsigned, b); }
__device__ __forceinline__ float bf2f(unsigned short u) { return __uint_as_float(((unsigned)u) << 16); }
__device__ __forceinline__ float bflo(unsigned u) { return __uint_as_float(u << 16); }
__device__ __forceinline__ float bfhi(unsigned u) { return __uint_as_float(u & 0xffff0000u); }
template <int CTRL> __device__ __forceinline__ float dppadd(float v) { return v + __builtin_bit_cast(float, __builtin_amdgcn_update_dpp(0, __builtin_bit_cast(int, v), CTRL, 0xF, 0xF, true)); }
__device__ __forceinline__ float swap16_add(float v) { float w = v; asm volatile("v_nop\n\tv_nop\n\tv_permlane16_swap_b32 %0, %1\n\tv_nop\n\tv_nop" : "+v"(v), "+v"(w)); return v + w; }
__device__ __forceinline__ float swap32_add(float v) { float w = v; asm volatile("v_nop\n\tv_nop\n\tv_permlane32_swap_b32 %0, %1\n\tv_nop\n\tv_nop" : "+v"(v), "+v"(w)); return v + w; }
__device__ __forceinline__ float swap32_max(float v) { float w = v; asm volatile("v_nop\n\tv_nop\n\tv_permlane32_swap_b32 %0, %1\n\tv_nop\n\tv_nop" : "+v"(v), "+v"(w)); return fmaxf(v, w); }
__device__ __forceinline__ float half_sum(float v) {
    v = dppadd<0xB1>(v); v = dppadd<0x4E>(v); v = dppadd<0x141>(v); v = dppadd<0x140>(v); return swap16_add(v);
}
__device__ __forceinline__ float wave_sum(float v) { return swap32_add(half_sum(v)); }
__device__ __forceinline__ float fexp2(float x) { return __builtin_amdgcn_exp2f(x); }
__device__ __forceinline__ float frcp(float x) { return __builtin_amdgcn_rcpf(x); }
__device__ __forceinline__ float sigmoidf_(float x) { return frcp(1.0f + fexp2(-x * LOG2E)); }
__device__ __forceinline__ int otid() { int t = threadIdx.x; asm volatile("" : "+v"(t)); return t; }
__device__ __forceinline__ int crow(int r, int hi) { return (r & 3) + 8 * (r >> 2) + 4 * hi; }
__device__ __forceinline__ s16x4 vtr(const LAS char* p) { return __builtin_bit_cast(s16x4, __builtin_amdgcn_ds_read_tr16_b64_v4i16((LAS s16x4*)p)); }
__device__ __forceinline__ bf16x8 cat8(s16x4 a, s16x4 b) { return (bf16x8){a[0], a[1], a[2], a[3], b[0], b[1], b[2], b[3]}; }
__device__ __forceinline__ bf16x8 pack8(float a0, float a1, float a2, float a3, float a4, float a5, float a6, float a7) {
    u32x4 w = {pk2(a0, a1), pk2(a2, a3), pk2(a4, a5), pk2(a6, a7)}; return __builtin_bit_cast(bf16x8, w);
}
__device__ __forceinline__ u32x4 pack8u(f32x4 a, f32x4 b) { return (u32x4){pk2(a[0], a[1]), pk2(a[2], a[3]), pk2(b[0], b[1]), pk2(b[2], b[3])}; }

#define XB_TMO      128
#define XB_XCNT(j)  (256  + 64 * (j))
#define XB_XSUB(j)  (1280 + 64 * (j))
#define XB_XGEN(j)  (2304 + 64 * (j))
#define XB_TOP      3328
#define XB_TOPGEN   3392
#define XCD_BAR_WORDS 3456
#define XB_SPIN_CAP (1u << 22)
__device__ __forceinline__ unsigned xb_ld(unsigned* p)              { return __hip_atomic_load(p, __ATOMIC_RELAXED, __HIP_MEMORY_SCOPE_AGENT); }
__device__ __forceinline__ unsigned xb_add(unsigned* p, unsigned v) { return __hip_atomic_fetch_add(p, v, __ATOMIC_RELAXED, __HIP_MEMORY_SCOPE_AGENT); }
__device__ __forceinline__ unsigned xb_xcc_id() { return (unsigned)__builtin_amdgcn_s_getreg((3 << 11) | 20) & 0xFu; }
#define XB_SPIN(cond, bar) do { unsigned _sp = 0; while (cond) { __builtin_amdgcn_s_sleep(1); \
    if ((++_sp & 255u) == 0u) { if (xb_ld(&(bar)[XB_TMO])) break; if (_sp > XB_SPIN_CAP) { atomicAdd(&(bar)[XB_TMO], 1u); break; } } } } while (0)
struct XcdBarrier { unsigned* bar; unsigned x; volatile LAS unsigned* st; };
__device__ __forceinline__ XcdBarrier xcd_barrier_post(unsigned* bar, volatile LAS unsigned* st) {
    XcdBarrier b; b.bar = bar; b.x = xb_xcc_id(); b.st = st;
    if (threadIdx.x == 0) (void)xb_add(&bar[XB_XCNT(b.x)], 1u);
    return b;
}
__device__ __forceinline__ void xcd_barrier_complete(unsigned* bar, unsigned x, unsigned& nloc, unsigned& nx) {
    const unsigned G = gridDim.x * gridDim.y * gridDim.z;
    unsigned sum, cnt, mine, sp = 0u;
    for (;;) {
        sum = 0u; cnt = 0u; mine = 0u;
#pragma unroll
        for (unsigned j = 0; j < 16; ++j) { const unsigned c = xb_ld(&bar[XB_XCNT(j)]); sum += c; cnt += (c > 0u) ? 1u : 0u; mine = (j == x) ? c : mine; }
        if (sum == G) break;
        __builtin_amdgcn_s_sleep(1);
        if ((++sp & 255u) == 0u) { if (xb_ld(&bar[XB_TMO])) break; if (sp > XB_SPIN_CAP) { atomicAdd(&bar[XB_TMO], 1u); break; } }
    }
    nloc = mine > 0u ? mine : 1u; nx = cnt > 0u ? cnt : 1u;
}
__device__ __forceinline__ void xcd_barrier(const XcdBarrier& b) {
    asm volatile("s_waitcnt vmcnt(0)" ::: "memory");
    __syncthreads();
    if (threadIdx.x == 0) {
        unsigned* bar = b.bar;
        __builtin_amdgcn_s_waitcnt(0);
        unsigned nloc = b.st[0], nx = b.st[1];
        if (nloc == 0u) { xcd_barrier_complete(bar, b.x, nloc, nx); b.st[0] = nloc; b.st[1] = nx; }
        const unsigned old = xb_add(&bar[XB_XSUB(b.x)], 1u);
        const unsigned gen = old / nloc;
        if (old + 1u == (gen + 1u) * nloc) {
            __builtin_amdgcn_fence(__ATOMIC_RELEASE, "agent");
            asm volatile("s_waitcnt vmcnt(0)" ::: "memory");
            const unsigned og = xb_add(&bar[XB_TOP], 1u);
            const unsigned tg = og / nx;
            if (og + 1u == (tg + 1u) * nx) xb_add(&bar[XB_TOPGEN], 1u);
            else XB_SPIN(xb_ld(&bar[XB_TOPGEN]) == tg, bar);
            __builtin_amdgcn_fence(__ATOMIC_ACQUIRE, "agent");
            xb_add(&bar[XB_XGEN(b.x)], 1u);
            asm volatile("s_waitcnt vmcnt(0)" ::: "memory");
        } else {
            XB_SPIN(xb_ld(&bar[XB_XGEN(b.x)]) == gen, bar);
            __builtin_amdgcn_fence(__ATOMIC_ACQUIRE, "agent");
            asm volatile("s_waitcnt vmcnt(0)" ::: "memory");
        }
    }
    __syncthreads();
}

namespace pg8 {
constexpr int BM = 256, BK = 64, HALF = 128, HTB = HALF * BK * 2, STAGE_BYTES = 8 * HTB, NXCD = 8, WGM = 8;
__device__ __forceinline__ int lds_byte(int r, int c) { const int st = (r >> 4) * 2 + (c >> 5), rr = r & 15, cc = c & 31, ob = rr * 64 + cc * 2; return st * 1024 + (ob ^ (((ob >> 9) & 1) << 5)); }
__device__ __forceinline__ void stage_rc(int b, int& R, int& C) { const int st = b / 1024, sb = b % 1024, swz = sb ^ (((sb >> 9) & 1) << 5); R = (st >> 1) * 16 + swz / 64; C = (st & 1) * 32 + (swz % 64) / 2; }
__device__ __forceinline__ int perm32(int rho) { const int n = rho >> 4, i = rho & 15; return 8 * (i >> 2) + 4 * n + (i & 3); }
struct Unit { int pm, pn, g; };

__device__ __forceinline__ bool static_order(int i, int G, int c, int nM, int nN, int& pm, int& pn) {
    const int nwg = nM * nN; const long L = (long)i * G + c; if (L >= nwg) return false;
    int wgid = (int)L; { const int q = nwg / NXCD, r = nwg % NXCD, xcd = wgid % NXCD, off = wgid / NXCD; wgid = (xcd < r ? xcd * (q + 1) : r * (q + 1) + (xcd - r) * q) + off; }
    const int nig = WGM * nN, gid = wgid / nig, fm = gid * WGM, gsz = (nM - fm) < WGM ? (nM - fm) : WGM;
    pm = fm + ((wgid % nig) % gsz); pn = (wgid % nig) / gsz; return true;
}

template <class Epi, class Sched, bool GATHER>
__device__ __forceinline__ void gemm_phase(LAS unsigned char* lds, const int K, const int lda, const int ldb, const Sched& S, const Epi& E) {
    const int tid = otid(), wid = __builtin_amdgcn_readfirstlane(tid >> 6), lane = tid & 63, wr = wid >> 2, wc = wid & 3, fr = lane & 15, fq = lane >> 4;
    const int nt = K / BK;
    int Rr[2], Cc[2];
    unsigned voffB[2], vAc[2][2];
#pragma unroll
    for (int i = 0; i < 2; ++i) { int R, C; stage_rc(tid * 16 + i * 8192, R, C); Rr[i] = R; Cc[i] = C; const int Rb = (R & ~31) + perm32(R & 31);
        voffB[i] = (unsigned)(Rb * ldb + C) * 2u;
#pragma unroll
        for (int h = 0; h < 2; ++h) vAc[h][i] = (unsigned)((GATHER ? 0 : R) * lda + C) * 2u; }
    const size_t kstep = (size_t)(BK * 2);
    const size_t hstepB = (size_t)HALF * ldb * 2;
    const size_t hstepA = GATHER ? (size_t)0 : (size_t)HALF * lda * 2;
    const unsigned ldsw = (unsigned)wid * 1024u;
    const int aoff = lds_byte(wr * 64 + fr, fq * 8), boff = lds_byte(wc * 32 + fr, fq * 8);
    LAS int* rowtab = (LAS int*)(lds + TAB_OFF + 2048);
#define PG8_SA(b, h) (((b) * 2 + (h)) * HTB)
#define PG8_SB(b, h) ((4 + (b) * 2 + (h)) * HTB)
#define PG8_STAGE(bufoff, gbase, v0, v1) do { \
        __builtin_amdgcn_global_load_lds((const unsigned*)((const char*)(gbase) + (v0)), (LAS unsigned*)(lds + (bufoff) + ldsw), 16, 0, 0); \
        __builtin_amdgcn_global_load_lds((const unsigned*)((const char*)(gbase) + (v1)), (LAS unsigned*)(lds + (bufoff) + ldsw + 8192), 16, 0, 0); } while (0)
#define PG8_STAGEB(bufoff, gbase) PG8_STAGE(bufoff, gbase, voffB[0], voffB[1])
#define PG8_LDA(dst, b, h) do { _Pragma("unroll") for (int m = 0; m < 4; ++m) _Pragma("unroll") for (int k = 0; k < 2; ++k) dst[m][k] = *(const LAS bf16x8*)(lds + PG8_SA(b, h) + aoff + m * 2048 + k * 1024); } while (0)
#define PG8_LDB(dst, b, h) do { _Pragma("unroll") for (int n = 0; n < 2; ++n) _Pragma("unroll") for (int k = 0; k < 2; ++k) dst[n][k] = *(const LAS bf16x8*)(lds + PG8_SB(b, h) + boff + n * 2048 + k * 1024); } while (0)
#define PG8_MMA(ai, bj, At, Bt) do { __builtin_amdgcn_s_setprio(1); _Pragma("unroll") for (int m = 0; m < 4; ++m) _Pragma("unroll") for (int n = 0; n < 2; ++n) _Pragma("unroll") for (int k = 0; k < 2; ++k) \
        acc[ai][bj][m][n] = __builtin_amdgcn_mfma_f32_16x16x32_bf16(Bt[n][k], At[m][k], acc[ai][bj][m][n], 0, 0, 0); __builtin_amdgcn_s_setprio(0); } while (0)
#define PG8_WAIT_V(n) asm volatile("s_waitcnt vmcnt(" #n ")" ::: "memory")
#define PG8_WAIT_L(n) asm volatile("s_waitcnt lgkmcnt(" #n ")" ::: "memory")
#define PG8_BAR __builtin_amdgcn_s_barrier()
#define PG8_SCHED __builtin_amdgcn_sched_barrier(0)
    Unit cur, nxt; int ui = 0;
    if (!S.next(0, cur)) return;
    f32x4 acc[2][2][4][2];
#pragma unroll
    for (int a = 0; a < 2; ++a)
#pragma unroll
        for (int b = 0; b < 2; ++b)
#pragma unroll
            for (int m = 0; m < 4; ++m)
#pragma unroll
                for (int n = 0; n < 2; ++n) acc[a][b][m][n] = (f32x4){0.f, 0.f, 0.f, 0.f};
    bf16x8 At[4][2], B0[2][2], B1[2][2];
    const char* cA = S.a_base(cur); const char* cB = S.b_base(cur);
    if constexpr (GATHER) {
        if (tid < 256) rowtab[tid] = S.a_row(cur, tid);
        PG8_WAIT_V(0); PG8_WAIT_L(0); PG8_BAR;
#pragma unroll
        for (int h = 0; h < 2; ++h)
#pragma unroll
            for (int i = 0; i < 2; ++i) vAc[h][i] = (unsigned)(rowtab[h * HALF + Rr[i]] * lda + Cc[i]) * 2u;
    }
    PG8_STAGEB(PG8_SB(0, 0), cB); PG8_STAGEB(PG8_SB(0, 1), cB + hstepB); PG8_STAGE(PG8_SA(0, 0), cA, vAc[0][0], vAc[0][1]); PG8_STAGE(PG8_SA(0, 1), cA + hstepA, vAc[1][0], vAc[1][1]);
    if (wr == 1) PG8_BAR;
    PG8_WAIT_V(2); PG8_BAR;
    PG8_STAGEB(PG8_SB(1, 0), cB + kstep); PG8_STAGE(PG8_SA(1, 0), cA + kstep, vAc[0][0], vAc[0][1]); PG8_STAGEB(PG8_SB(1, 1), cB + hstepB + kstep);
    PG8_WAIT_V(6); PG8_BAR;
    for (;;) {
        const bool has_next = S.next(ui + 1, nxt);
        const char* nA = has_next ? S.a_base(nxt) : cA; const char* nB = has_next ? S.b_base(nxt) : cB;
        if constexpr (GATHER) {
            if (tid < 256) rowtab[((ui + 1) & 1) * 256 + tid] = has_next ? S.a_row(nxt, tid) : 0;
            PG8_WAIT_V(0);
        }
#pragma unroll 1
        for (int t = 0; t < nt; t += 2) {
            const bool last = (t == nt - 2);
            const char* a1 = cA + (size_t)(t + 1) * kstep;
            const char* a2 = last ? nA : cA + (size_t)(t + 2) * kstep; const char* b2 = last ? nB : cB + (size_t)(t + 2) * kstep;
            const char* a3 = a2 + kstep; const char* b3 = b2 + kstep;
            unsigned v2[2][2];
#pragma unroll
            for (int h = 0; h < 2; ++h)
#pragma unroll
                for (int i = 0; i < 2; ++i) v2[h][i] = vAc[h][i];
            if constexpr (GATHER) { if (last && has_next) {
#pragma unroll
                for (int h = 0; h < 2; ++h)
#pragma unroll
                    for (int i = 0; i < 2; ++i) v2[h][i] = (unsigned)(rowtab[((ui + 1) & 1) * 256 + h * HALF + Rr[i]] * lda + Cc[i]) * 2u; } }
            PG8_LDB(B0, 0, 0); PG8_LDB(B1, 0, 1); PG8_SCHED; PG8_LDA(At, 0, 0); PG8_STAGE(PG8_SA(1, 1), a1 + hstepA, vAc[1][0], vAc[1][1]);
            PG8_WAIT_V(8); PG8_WAIT_L(0); PG8_BAR; PG8_MMA(0, 0, At, B0); PG8_MMA(0, 1, At, B1); PG8_BAR; PG8_SCHED;
            PG8_LDA(At, 0, 1); PG8_STAGEB(PG8_SB(0, 0), b2); PG8_STAGEB(PG8_SB(0, 1), b2 + hstepB); PG8_STAGE(PG8_SA(0, 0), a2, v2[0][0], v2[0][1]);
            PG8_WAIT_V(8); PG8_WAIT_L(0); PG8_BAR; PG8_MMA(1, 0, At, B0); PG8_MMA(1, 1, At, B1); PG8_BAR; PG8_SCHED;
            PG8_LDB(B0, 1, 0); PG8_LDB(B1, 1, 1); PG8_SCHED; PG8_LDA(At, 1, 0); PG8_STAGE(PG8_SA(0, 1), a2 + hstepA, v2[1][0], v2[1][1]);
            PG8_WAIT_V(8); PG8_WAIT_L(0); PG8_BAR; PG8_MMA(0, 0, At, B0); PG8_MMA(0, 1, At, B1); PG8_BAR; PG8_SCHED;
            PG8_LDA(At, 1, 1); PG8_STAGEB(PG8_SB(1, 0), b3); PG8_STAGEB(PG8_SB(1, 1), b3 + hstepB); PG8_STAGE(PG8_SA(1, 0), a3, v2[0][0], v2[0][1]);
            PG8_WAIT_V(8); PG8_WAIT_L(0); PG8_BAR; PG8_MMA(1, 0, At, B0); PG8_MMA(1, 1, At, B1); PG8_BAR; PG8_SCHED;
        }
        if (wr == 0) PG8_BAR;
        { int efr = fr, efq = fq; asm volatile("" : "+v"(efr), "+v"(efq)); E(acc, cur, wr, wc, efr, efq); }
        if (!has_next) break;
#pragma unroll
        for (int a = 0; a < 2; ++a)
#pragma unroll
            for (int b = 0; b < 2; ++b)
#pragma unroll
                for (int m = 0; m < 4; ++m)
#pragma unroll
                    for (int n = 0; n < 2; ++n) acc[a][b][m][n] = (f32x4){0.f, 0.f, 0.f, 0.f};
        cur = nxt; cA = nA; cB = nB; ++ui;
        if constexpr (GATHER) {
#pragma unroll
            for (int h = 0; h < 2; ++h)
#pragma unroll
                for (int i = 0; i < 2; ++i) vAc[h][i] = (unsigned)(rowtab[(ui & 1) * 256 + h * HALF + Rr[i]] * lda + Cc[i]) * 2u;
        }
        if (wr == 1) PG8_BAR;
    }
    PG8_WAIT_V(0);
    PG8_BAR;
#undef PG8_SA
#undef PG8_SB
#undef PG8_STAGE
#undef PG8_STAGEB
#undef PG8_LDA
#undef PG8_LDB
#undef PG8_MMA
#undef PG8_WAIT_V
#undef PG8_WAIT_L
#undef PG8_BAR
#undef PG8_SCHED
}
}
using pg8::Unit;

struct DenseSched {
    int nM, nN, G, c; const char* A; const char* Bt; size_t atile, btile;
    __device__ __forceinline__ bool next(int i, Unit& u) const { u.g = 0; return pg8::static_order(i, G, c, nM, nN, u.pm, u.pn); }
    __device__ __forceinline__ const char* a_base(const Unit& u) const { return A + (size_t)u.pm * atile; }
    __device__ __forceinline__ const char* b_base(const Unit& u) const { return Bt + (size_t)u.pn * btile; }
    __device__ __forceinline__ int a_row(const Unit&, int) const { return 0; }
};
struct GroupSched {
    int nN, G, c; const char* A; const char* Bt; size_t agroup, bgroup, atile, btile;
    __device__ __forceinline__ bool next(int i, Unit& u) const { const long L = (long)i * G + c; if (c < 0 || L >= 16 * 2 * nN) return false; const int per = 2 * nN; u.g = (int)L / per; const int r = (int)L % per; u.pm = r % 2; u.pn = r / 2; return true; }
    __device__ __forceinline__ const char* a_base(const Unit& u) const { return A + (size_t)u.g * agroup + (size_t)u.pm * atile; }
    __device__ __forceinline__ const char* b_base(const Unit& u) const { return Bt + (size_t)u.g * bgroup + (size_t)u.pn * btile; }
    __device__ __forceinline__ int a_row(const Unit&, int) const { return 0; }
};
struct S5G1Sched {
    int G, c; const char* A; const char* Bt;
    __device__ __forceinline__ bool next(int i, Unit& u) const { const long L = (long)i * G + c; if (L >= 128) return false; u.g = (int)L >> 3; u.pm = (int)L & 1; u.pn = ((int)L >> 1) & 3; return true; }
    __device__ __forceinline__ const char* a_base(const Unit& u) const { return A + ((size_t)u.g * 512 + u.pm * 256) * 1280 * 2 + (size_t)u.pn * 512; }
    __device__ __forceinline__ const char* b_base(const Unit& u) const { return Bt + (size_t)u.g * 256 * 1024 * 2 + (size_t)u.pn * 512; }
    __device__ __forceinline__ int a_row(const Unit&, int) const { return 0; }
};
struct MoeSched {
    int nM, nN, G, c; const char* A; const char* W; size_t wexp, atile, btile;
    const LAS int* cnt; const LAS int* tstart; const LAS unsigned char* tile_e; const int* list;
    __device__ __forceinline__ bool next(int i, Unit& u) const { const bool ok = pg8::static_order(i, G, c, nM, nN, u.pm, u.pn); u.g = ok ? (int)tile_e[u.pm] : 0; return ok; }
    __device__ __forceinline__ const char* a_base(const Unit& u) const { return A + (size_t)u.pm * atile; }
    __device__ __forceinline__ const char* b_base(const Unit& u) const { return W + (size_t)u.g * wexp + (size_t)u.pn * btile; }
    __device__ __forceinline__ int a_row(const Unit& u, int r) const { const int slot = (u.pm - tstart[u.g]) * 256 + r; return slot < cnt[u.g] ? list[(size_t)u.g * T + slot] : 0; }
};

typedef f32x4 Acc[2][2][4][2];
struct EpiProj {
    bf16 *Qimg, *Kimg, *Vimg, *Ug2, *RET; const float *cosA, *sinA, *cosR, *sinR;
    __device__ __forceinline__ void operator()(const Acc& acc, const Unit& u, int wr, int wc, int fr, int fq) const {
        const int pn = u.pn;
#pragma unroll
        for (int ai = 0; ai < 2; ++ai)
#pragma unroll
            for (int m = 0; m < 4; ++m) {
                const int row = u.pm * 256 + ai * 128 + wr * 64 + m * 16 + fr; const int b = row >> 13, t = row & 8191;
                if (pn < 4 || pn == 7 || pn == 8) {
                    const size_t to = (size_t)row * 32 + 8 * fq;
                    const float* ct = (pn < 4 ? cosA : cosR) + to; const float* st = (pn < 4 ? sinA : sinR) + to;
                    const f32x4 c0 = *(const f32x4*)ct, c1 = *(const f32x4*)(ct + 4), s0 = *(const f32x4*)st, s1 = *(const f32x4*)(st + 4);
                    const f32x4 xa0 = acc[ai][0][m][0], xa1 = acc[ai][0][m][1], xb0 = acc[ai][1][m][0], xb1 = acc[ai][1][m][1];
                    const float sc = (pn < 2) ? C2 : (pn == 8 ? 0.125f : 1.0f);
                    const f32x4 o10 = (xa0 * c0 - xb0 * s0) * sc, o11 = (xa1 * c1 - xb1 * s1) * sc, o20 = (xb0 * c0 + xa0 * s0) * sc, o21 = (xb1 * c1 + xa1 * s1) * sc;
                    const u32x4 w1 = pack8u(o10, o11), w2 = pack8u(o20, o21);
                    if (pn < 2) { const int hc = 4 * pn + wc; bf16* p = Qimg + ((size_t)(b * 8 + hc) * 8192 + t) * 64 + 8 * fq; *(u32x4*)p = w1; *(u32x4*)(p + 32) = w2; }
                    else if (pn < 4) { const int hc = 4 * (pn - 2) + wc; bf16* p = Kimg + ((size_t)((b * 8 + hc) * 128 + (t >> 6)) * 8 + fq) * 512 + (t & 63) * 8; *(u32x4*)p = w1; *(u32x4*)(p + 4 * 512) = w2; }
                    else { bf16* p = RET + (size_t)row * 1024 + (pn - 7) * 256 + 64 * wc + 8 * fq; *(u32x4*)p = w1; *(u32x4*)(p + 32) = w2; }
                } else {
#pragma unroll
                    for (int bj = 0; bj < 2; ++bj) {
                        const u32x4 w = pack8u(acc[ai][bj][m][0], acc[ai][bj][m][1]);
                        bf16* p;
                        if (pn < 6) { const int h = 2 * (pn - 4) + bj; p = Vimg + ((size_t)((b * 4 + h) * 128 + (t >> 6)) * 4 + wc) * 2048 + (t & 63) * 32 + 8 * fq; }
                        else if (pn == 6) { const int g = 8 * bj + 2 * wc + (fq >> 1); p = Ug2 + ((size_t)(g * 512 + b * 128 + (t >> 6))) * 1280 + (t & 63) * 16 + 8 * (fq & 1); }
                        else { p = RET + (size_t)row * 1024 + 512 + (pn - 9) * 256 + 128 * bj + 32 * wc + 8 * fq; }
                        *(u32x4*)p = w;
                    }
                }
                asm volatile("" ::: "memory");
            }
    }
};
struct EpiS5S {
    float* S;
    __device__ __forceinline__ void operator()(const Acc& acc, const Unit& u, int wr, int wc, int fr, int fq) const {
#pragma unroll
        for (int ai = 0; ai < 2; ++ai)
#pragma unroll
            for (int m = 0; m < 4; ++m) { float* rowp = S + (size_t)u.pn * (16 * 512 * 256) + ((size_t)u.g * 512 + u.pm * 256 + ai * 128 + wr * 64 + m * 16 + fr) * 256 + wc * 32 + 8 * fq;
#pragma unroll
                for (int bj = 0; bj < 2; ++bj) { *(f32x4*)(rowp + bj * 128) = acc[ai][bj][m][0]; *(f32x4*)(rowp + bj * 128 + 4) = acc[ai][bj][m][1]; } }
    }
};
struct EpiS5Y {
    bf16* Yb; const bf16* Ug2; const float* dskip;
    __device__ __forceinline__ void operator()(const Acc& acc, const Unit& u, int wr, int wc, int fr, int fq) const {
#pragma unroll
        for (int ai = 0; ai < 2; ++ai)
#pragma unroll
            for (int m = 0; m < 4; ++m) { const int bc = u.pm * 256 + ai * 128 + wr * 64 + m * 16 + fr;
#pragma unroll
                for (int bj = 0; bj < 2; ++bj) { const int col = u.pn * 256 + bj * 128 + wc * 32 + 8 * fq; const int j = col >> 4, n0 = col & 15;
                    const int tok = bc * 64 + j; const int ch = u.g * 16 + n0;
                    const u32x4 uu = *(const u32x4*)(Ug2 + ((size_t)u.g * 512 + bc) * 1280 + col);
                    const f32x4 d0 = *(const f32x4*)(dskip + ch), d1 = *(const f32x4*)(dskip + ch + 4);
                    float y[8] = {acc[ai][bj][m][0][0] + d0[0] * bflo(uu[0]), acc[ai][bj][m][0][1] + d0[1] * bfhi(uu[0]), acc[ai][bj][m][0][2] + d0[2] * bflo(uu[1]), acc[ai][bj][m][0][3] + d0[3] * bfhi(uu[1]),
                                  acc[ai][bj][m][1][0] + d1[0] * bflo(uu[2]), acc[ai][bj][m][1][1] + d1[1] * bfhi(uu[2]), acc[ai][bj][m][1][2] + d1[2] * bflo(uu[3]), acc[ai][bj][m][1][3] + d1[3] * bfhi(uu[3])};
#pragma unroll
                    for (int e = 0; e < 8; ++e) { const float v = y[e]; const float uarg = 1.5957691216057308f * (v + 0.044715f * v * v * v); y[e] = v * sigmoidf_(uarg); }
                    *(u32x4*)(Yb + (size_t)tok * 256 + ch) = (u32x4){pk2(y[0], y[1]), pk2(y[2], y[3]), pk2(y[4], y[5]), pk2(y[6], y[7])};
                    asm volatile("" ::: "memory");
                } }
    }
};
struct EpiGlu {
    bf16* MIX; const float* bias;
    __device__ __forceinline__ void operator()(const Acc& acc, const Unit& u, int wr, int wc, int fr, int fq) const {
        const int col = u.pn * 128 + wc * 32 + 8 * fq;
#pragma unroll
        for (int ai = 0; ai < 2; ++ai)
#pragma unroll
            for (int m = 0; m < 4; ++m) { const int row = u.pm * 256 + ai * 128 + wr * 64 + m * 16 + fr;
                const f32x4 ba0 = *(const f32x4*)(bias + col), ba1 = *(const f32x4*)(bias + col + 4), bb0 = *(const f32x4*)(bias + 256 + col), bb1 = *(const f32x4*)(bias + 256 + col + 4);
                const f32x4 a0 = acc[ai][0][m][0] + ba0, a1 = acc[ai][0][m][1] + ba1, g0 = acc[ai][1][m][0] + bb0, g1 = acc[ai][1][m][1] + bb1;
                f32x4 o0, o1;
#pragma unroll
                for (int e = 0; e < 4; ++e) { o0[e] = a0[e] * sigmoidf_(g0[e]); o1[e] = a1[e] * sigmoidf_(g1[e]); }
                *(u32x4*)(MIX + (size_t)row * 1024 + 512 + col) = pack8u(o0, o1); asm volatile("" ::: "memory"); }
    }
};
struct EpiOut {
    bf16* YM; const float* mod;
    __device__ __forceinline__ void operator()(const Acc& acc, const Unit& u, int wr, int wc, int fr, int fq) const {
        const int b = (u.pm * 256) >> 13;
#pragma unroll
        for (int bj = 0; bj < 2; ++bj) { const int col = u.pn * 256 + bj * 128 + wc * 32 + 8 * fq; const float* gp = mod + (size_t)b * 6144 + 2048 + col;
            const f32x4 g0 = *(const f32x4*)gp + 1.0f, g1 = *(const f32x4*)(gp + 4) + 1.0f;
#pragma unroll
            for (int ai = 0; ai < 2; ++ai)
#pragma unroll
                for (int m = 0; m < 4; ++m) { const int row = u.pm * 256 + ai * 128 + wr * 64 + m * 16 + fr;
                    *(u32x4*)(YM + (size_t)row * 1024 + col) = pack8u(g0 * acc[ai][bj][m][0], g1 * acc[ai][bj][m][1]); } }
    }
};
struct EpiMoe1 {
    bf16* A2; const float* b1;
    __device__ __forceinline__ void operator()(const Acc& acc, const Unit& u, int wr, int wc, int fr, int fq) const {
        const int j0 = u.pn * 128 + wc * 32 + 8 * fq;
        const float* bp = b1 + (size_t)u.g * 2048 + 2 * j0;
#pragma unroll
        for (int ai = 0; ai < 2; ++ai)
#pragma unroll
            for (int m = 0; m < 4; ++m) { const size_t slot = (size_t)u.pm * 256 + ai * 128 + wr * 64 + m * 16 + fr;
                const f32x4 q0 = *(const f32x4*)bp, q1 = *(const f32x4*)(bp + 4), q2 = *(const f32x4*)(bp + 8), q3 = *(const f32x4*)(bp + 12);
                const float bg[8] = {q0[0], q0[2], q1[0], q1[2], q2[0], q2[2], q3[0], q3[2]}, bl[8] = {q0[1], q0[3], q1[1], q1[3], q2[1], q2[3], q3[1], q3[3]};
                float o[8];
#pragma unroll
                for (int e = 0; e < 8; ++e) { float zg = acc[ai][0][m][e >> 2][e & 3] + bg[e], zl = acc[ai][1][m][e >> 2][e & 3] + bl[e];
                    zg = fminf(zg, 7.0f); zl = fminf(fmaxf(zl, -7.0f), 7.0f); o[e] = zg * sigmoidf_(1.702f * zg) * (zl + 1.0f); }
                *(u32x4*)(A2 + slot * 1024 + j0) = (u32x4){pk2(o[0], o[1]), pk2(o[2], o[3]), pk2(o[4], o[5]), pk2(o[6], o[7])}; asm volatile("" ::: "memory"); }
    }
};
struct EpiMoe2 {
    bf16* YS; const float* b2;
    __device__ __forceinline__ void operator()(const Acc& acc, const Unit& u, int wr, int wc, int fr, int fq) const {
#pragma unroll
        for (int bj = 0; bj < 2; ++bj) { const int col = u.pn * 256 + bj * 128 + wc * 32 + 8 * fq; const float* bp = b2 + (size_t)u.g * 1024 + col;
            const f32x4 c0 = *(const f32x4*)bp, c1 = *(const f32x4*)(bp + 4);
#pragma unroll
            for (int ai = 0; ai < 2; ++ai)
#pragma unroll
                for (int m = 0; m < 4; ++m) { const size_t slot = (size_t)u.pm * 256 + ai * 128 + wr * 64 + m * 16 + fr;
                    *(u32x4*)(YS + slot * 1024 + col) = pack8u(acc[ai][bj][m][0] + c0, acc[ai][bj][m][1] + c1); } asm volatile("" ::: "memory"); }
    }
};

struct Args {
    const void* in[30]; float* out; unsigned char* ws;
    double invfA[32], invfR[32];
    float lam_init[4];
    float lg2f[4], lg2b[4];
    int ph_lo, ph_hi;
};

template <int PERM>
__device__ __forceinline__ int perm_row(int o) {
    if (PERM == 1) { const int pn = o >> 8; if (pn < 4 || pn == 7 || pn == 8) { const int x = o & 255; return (o & ~255) + 128 * ((x >> 5) & 1) + 32 * (x >> 6) + (x & 31); } return o; }
    if (PERM == 2) return (o >> 8) * 256 + 128 * (o & 1) + ((o >> 1) & 127);
    if (PERM == 3) return 256 * ((o >> 7) & 1) + 128 * (o >> 8) + (o & 127);
    return o;
}
template <int PERM>
__device__ __forceinline__ void transpose_item(const float* W, int K, int N, bf16* WT, LAS float* scr, int item, int lane) {
    const int nblk = N / 32, kb = item / nblk, nb = item % nblk, k0 = 64 * kb, n0 = 32 * nb;
#pragma unroll 8
    for (int i = 0; i < 32; ++i) { const int kk = 2 * i + (lane >> 5); scr[kk * 33 + (lane & 31)] = W[(size_t)(k0 + kk) * N + n0 + (lane & 31)]; }
    asm volatile("s_waitcnt lgkmcnt(0)" ::: "memory");
    const int c = lane & 7;
#pragma unroll
    for (int j = 0; j < 4; ++j) { const int n = (lane >> 3) + 8 * j; const LAS float* s = scr + (8 * c) * 33 + n;
        u32x4 o; o.x = pk2(s[0 * 33], s[1 * 33]); o.y = pk2(s[2 * 33], s[3 * 33]); o.z = pk2(s[4 * 33], s[5 * 33]); o.w = pk2(s[6 * 33], s[7 * 33]);
        *(u32x4*)(WT + (size_t)perm_row<PERM>(n0 + n) * K + k0 + 8 * c) = o; }
    asm volatile("s_waitcnt lgkmcnt(0)" ::: "memory");
}
__device__ __forceinline__ void sincos_rev(double ang, float& c, float& s) {
    double rev = ang * 0.15915494309189535; rev -= __builtin_rint(rev); const float r = (float)rev;
    c = __builtin_amdgcn_cosf(r); s = __builtin_amdgcn_sinf(r);
}

__device__ __forceinline__ void row_stats(const f32x4 (&v)[4], float& mean, float& rstd) {
    float s = 0.f;
#pragma unroll
    for (int j = 0; j < 4; ++j) s += (v[j][0] + v[j][1]) + (v[j][2] + v[j][3]);
    mean = wave_sum(s) * (1.f / DM); float q = 0.f;
#pragma unroll
    for (int j = 0; j < 4; ++j) { const f32x4 d = v[j] - mean; q += (d[0] * d[0] + d[1] * d[1]) + (d[2] * d[2] + d[3] * d[3]); }
    rstd = 1.0f / sqrtf(wave_sum(q) * (1.f / DM) + LN_EPS);
}
__device__ __forceinline__ void mod_row_store(const f32x4 (&v)[4], const float* sh, const float* sc, bf16* orow, int lane) {
    float mean, rstd; row_stats(v, mean, rstd);
#pragma unroll
    for (int j = 0; j < 4; ++j) { const int col = 4 * lane + 256 * j; const f32x4 a = *(const f32x4*)(sc + col), b = *(const f32x4*)(sh + col);
        const f32x4 h = (v[j] - mean) * rstd * (a + 1.0f) + b; *(u32x2*)(orow + col) = (u32x2){pk2(h[0], h[1]), pk2(h[2], h[3])}; }
}

__device__ __forceinline__ void swap32x4(float& a0, float& b0, float& a1, float& b1, float& a2, float& b2, float& a3, float& b3) {
    asm volatile("v_nop\n\tv_nop\n\tv_permlane32_swap_b32 %0, %1\n\tv_permlane32_swap_b32 %2, %3\n\tv_permlane32_swap_b32 %4, %5\n\tv_permlane32_swap_b32 %6, %7\n\tv_nop\n\tv_nop"
                 : "+v"(a0), "+v"(b0), "+v"(a1), "+v"(b1), "+v"(a2), "+v"(b2), "+v"(a3), "+v"(b3)); }
__device__ __forceinline__ void swap16x4(float& a0, float& b0, float& a1, float& b1, float& a2, float& b2, float& a3, float& b3) {
    asm volatile("v_nop\n\tv_nop\n\tv_permlane16_swap_b32 %0, %1\n\tv_permlane16_swap_b32 %2, %3\n\tv_permlane16_swap_b32 %4, %5\n\tv_permlane16_swap_b32 %6, %7\n\tv_nop\n\tv_nop"
                 : "+v"(a0), "+v"(b0), "+v"(a1), "+v"(b1), "+v"(a2), "+v"(b2), "+v"(a3), "+v"(b3)); }
template <int CTRL> __device__ __forceinline__ float dppmov(float v) { return __builtin_bit_cast(float, __builtin_amdgcn_update_dpp(0, __builtin_bit_cast(int, v), CTRL, 0xF, 0xF, true)); }
__device__ __forceinline__ float wave_max(float v) {
    v = fmaxf(v, dppmov<0xB1>(v)); v = fmaxf(v, dppmov<0x4E>(v)); v = fmaxf(v, dppmov<0x141>(v)); v = fmaxf(v, dppmov<0x140>(v));
    { float w = v; asm volatile("v_nop\n\tv_nop\n\tv_permlane16_swap_b32 %0, %1\n\tv_nop\n\tv_nop" : "+v"(v), "+v"(w)); v = fmaxf(v, w); }
    return swap32_max(v);
}
struct Top4 { float t0, t1, t2, t3; int i0, i1, i2, i3; };
__device__ __forceinline__ void top4_init(Top4& q) { q.t0 = q.t1 = q.t2 = q.t3 = -INFINITY; q.i0 = q.i1 = q.i2 = q.i3 = 0; }
__device__ __forceinline__ void top4_insert(Top4& q, float x, int e) {
    const bool c3 = x > q.t3; q.t3 = c3 ? x : q.t3; q.i3 = c3 ? e : q.i3;
    const bool c2 = q.t3 > q.t2; { const float a = q.t2, b = q.t3; const int ia = q.i2, ib = q.i3; q.t2 = c2 ? b : a; q.t3 = c2 ? a : b; q.i2 = c2 ? ib : ia; q.i3 = c2 ? ia : ib; }
    const bool c1 = q.t2 > q.t1; { const float a = q.t1, b = q.t2; const int ia = q.i1, ib = q.i2; q.t1 = c1 ? b : a; q.t2 = c1 ? a : b; q.i1 = c1 ? ib : ia; q.i2 = c1 ? ia : ib; }
    const bool c0 = q.t1 > q.t0; { const float a = q.t0, b = q.t1; const int ia = q.i0, ib = q.i1; q.t0 = c0 ? b : a; q.t1 = c0 ? a : b; q.i0 = c0 ? ib : ia; q.i1 = c0 ? ia : ib; }
}

__device__ __forceinline__ void attn_unit(LAS unsigned char* lds, const bf16* Qimg, const bf16* Kimg, const bf16* Vimg, bf16* MIX, const int b, const int h, const int qb,
                                          const float lam, const float* subg, const float outscale) {
    const int tid = otid(), lane = tid & 63, r32 = lane & 31, hi = lane >> 5; const int wid = __builtin_amdgcn_readfirstlane(tid >> 6);
    const int comp = wid & 1, qsub = (wid >> 1) & 3, grp = wid >> 2, hc = 2 * h + comp;
    const bf16* Qw = Qimg + ((size_t)(b * 8 + hc) * 8192 + qb * 128 + qsub * 32 + r32) * 64;
    bf16x8 qr[4];
#pragma unroll
    for (int d0 = 0; d0 < 4; ++d0) qr[d0] = *(const bf16x8*)(Qw + d0 * 16 + hi * 8);
    asm volatile("s_waitcnt vmcnt(0)" ::: "memory");
    const bf16* K1 = Kimg + (size_t)((b * 8 + 2 * h) * 128) * 4096 + tid * 8;
    const bf16* K2 = Kimg + (size_t)((b * 8 + 2 * h + 1) * 128) * 4096 + tid * 8;
    const bf16* Vg = Vimg + (size_t)((b * 4 + h) * 128) * 8192 + tid * 8;
    LAS float* wsf = (LAS float*)(lds + TAB_OFF) + wid * 64;
    f32x16 o[4];
#pragma unroll
    for (int d = 0; d < 4; ++d) o[d] = (f32x16){};
    float mrow = 0.f, lrow = 0.f;
    const unsigned ldsw = (unsigned)wid * 1024u;
#define ATT_DMA(tt) do { const size_t tt_ = (size_t)(tt); LAS unsigned char* sb_ = lds + ((tt) & 3) * 32768 + ldsw; \
        __builtin_amdgcn_global_load_lds((const unsigned*)(K1 + tt_ * 4096), (LAS unsigned*)(sb_), 16, 0, 0); \
        __builtin_amdgcn_global_load_lds((const unsigned*)(K2 + tt_ * 4096), (LAS unsigned*)(sb_ + 8192), 16, 0, 0); \
        __builtin_amdgcn_global_load_lds((const unsigned*)(Vg + tt_ * 8192), (LAS unsigned*)(sb_ + 16384), 16, 0, 0); \
        __builtin_amdgcn_global_load_lds((const unsigned*)(Vg + tt_ * 8192 + 4096), (LAS unsigned*)(sb_ + 24576), 16, 0, 0); } while (0)
#define ATT_QK(P0, P1, tt) do { const LAS unsigned char* Ks_ = lds + ((tt) & 3) * 32768 + comp * 8192 + hi * 1024 + r32 * 16; \
        { const bf16x8 a0_ = *(const LAS bf16x8*)(Ks_), a1_ = *(const LAS bf16x8*)(Ks_ + 512); \
          P0 = __builtin_amdgcn_mfma_f32_32x32x16_bf16(a0_, qr[0], negm, 0, 0, 0); P1 = __builtin_amdgcn_mfma_f32_32x32x16_bf16(a1_, qr[0], negm, 0, 0, 0); } \
        _Pragma("unroll") for (int d0_ = 1; d0_ < 4; ++d0_) { const bf16x8 a0_ = *(const LAS bf16x8*)(Ks_ + d0_ * 2048), a1_ = *(const LAS bf16x8*)(Ks_ + d0_ * 2048 + 512); \
          P0 = __builtin_amdgcn_mfma_f32_32x32x16_bf16(a0_, qr[d0_], P0, 0, 0, 0); P1 = __builtin_amdgcn_mfma_f32_32x32x16_bf16(a1_, qr[d0_], P1, 0, 0, 0); } } while (0)
    ATT_DMA(0); ATT_DMA(1); ATT_DMA(2);
    asm volatile("s_waitcnt vmcnt(8)" ::: "memory");
    __builtin_amdgcn_s_barrier();
    const int vlane = ((lane & 15) >> 2) * 64 + ((lane >> 4) & 1) * 32 + (lane & 3) * 8 + hi * 256;
    f32x16 p0, p1;
    { const f32x16 negm = (f32x16){}; ATT_QK(p0, p1, 0); }
    asm volatile("s_waitcnt vmcnt(4) lgkmcnt(0)" ::: "memory");
    __builtin_amdgcn_s_barrier();
    if (grp == 1) { __builtin_amdgcn_s_setprio(1); __builtin_amdgcn_s_barrier(); }
    for (int i = 0; i < 128; ++i) {
        float rm, rm2;
        asm("v_max3_f32 %0, %1, %2, %3" : "=v"(rm) : "v"(p0[0]), "v"(p0[1]), "v"(p0[2]));
        asm("v_max3_f32 %0, %1, %2, %3" : "=v"(rm2) : "v"(p1[0]), "v"(p1[1]), "v"(p1[2]));
#pragma unroll
        for (int r = 3; r < 15; r += 2) { asm("v_max3_f32 %0, %1, %2, %3" : "=v"(rm) : "v"(rm), "v"(p0[r]), "v"(p0[r + 1])); asm("v_max3_f32 %0, %1, %2, %3" : "=v"(rm2) : "v"(rm2), "v"(p1[r]), "v"(p1[r + 1])); }
        asm("v_max3_f32 %0, %1, %2, %3" : "=v"(rm) : "v"(rm), "v"(p0[15]), "v"(p1[15]));
        rm = swap32_max(fmaxf(rm, rm2));
        const bool need = (i == 0) || (rm > 6.0f);
        if (__any(need)) {
            const float dl = need ? rm : 0.f;
            mrow += dl;
#pragma unroll
            for (int r = 0; r < 16; ++r) { p0[r] -= dl; p1[r] -= dl; }
            if (i > 0) {
                const float f = fexp2(-dl); lrow *= f;
                if (hi == 0) wsf[r32] = f;
                asm volatile("s_waitcnt lgkmcnt(0)" ::: "memory");
#pragma unroll
                for (int r = 0; r < 16; ++r) { const float fr_ = wsf[crow(r, hi)];
#pragma unroll
                    for (int d = 0; d < 4; ++d) o[d][r] *= fr_; }
            }
        }
        float ls0 = 0.f, ls1 = 0.f;
#pragma unroll
        for (int r = 0; r < 16; ++r) { p0[r] = fexp2(p0[r]); p1[r] = fexp2(p1[r]); ls0 += p0[r]; ls1 += p1[r]; }
        lrow += ls0 + ls1;
        const bf16x8 pa0 = pack8(p0[0], p0[1], p0[2], p0[3], p0[4], p0[5], p0[6], p0[7]), pa1 = pack8(p0[8], p0[9], p0[10], p0[11], p0[12], p0[13], p0[14], p0[15]);
        const bf16x8 pa2 = pack8(p1[0], p1[1], p1[2], p1[3], p1[4], p1[5], p1[6], p1[7]), pa3 = pack8(p1[8], p1[9], p1[10], p1[11], p1[12], p1[13], p1[14], p1[15]);
        bf16x8 kf[4], kg[4];
        const LAS unsigned char* Ks_ = lds + ((i + 1) & 3) * 32768 + comp * 8192 + hi * 1024 + r32 * 16;
        kf[0] = *(const LAS bf16x8*)(Ks_); kf[1] = *(const LAS bf16x8*)(Ks_ + 512); kf[2] = *(const LAS bf16x8*)(Ks_ + 2048); kf[3] = *(const LAS bf16x8*)(Ks_ + 2560);
        asm volatile("s_waitcnt vmcnt(0) lgkmcnt(0)" ::: "memory");
        __builtin_amdgcn_s_barrier();
        __builtin_amdgcn_sched_barrier(0);
        const LAS char* Vs = (const LAS char*)lds + (i & 3) * 32768 + 16384 + vlane;
#define ATT_LDV(dst, d) do { dst[0] = cat8(vtr(Vs + (d) * 4096), vtr(Vs + (d) * 4096 + 512)); dst[1] = cat8(vtr(Vs + (d) * 4096 + 1024), vtr(Vs + (d) * 4096 + 1536)); \
        dst[2] = cat8(vtr(Vs + (d) * 4096 + 2048), vtr(Vs + (d) * 4096 + 2560)); dst[3] = cat8(vtr(Vs + (d) * 4096 + 3072), vtr(Vs + (d) * 4096 + 3584)); } while (0)
#define ATT_PV(d, vv) do { asm volatile("" : "+v"(o[d])); o[d] = __builtin_amdgcn_mfma_f32_32x32x16_bf16(pa0, vv[0], o[d], 0, 0, 0); o[d] = __builtin_amdgcn_mfma_f32_32x32x16_bf16(pa1, vv[1], o[d], 0, 0, 0); \
        o[d] = __builtin_amdgcn_mfma_f32_32x32x16_bf16(pa2, vv[2], o[d], 0, 0, 0); o[d] = __builtin_amdgcn_mfma_f32_32x32x16_bf16(pa3, vv[3], o[d], 0, 0, 0); } while (0)
        bf16x8 va[4], vb[4];
        kg[0] = *(const LAS bf16x8*)(Ks_ + 4096); kg[1] = *(const LAS bf16x8*)(Ks_ + 4608); kg[2] = *(const LAS bf16x8*)(Ks_ + 6144); kg[3] = *(const LAS bf16x8*)(Ks_ + 6656);
        ATT_LDV(va, 0);
        __builtin_amdgcn_sched_barrier(0);
        if (i + 1 < 128) {
            f32x16 negm; { const float nm_ = -mrow;
#pragma unroll
                for (int r = 0; r < 16; ++r) negm[r] = nm_; }
            p0 = __builtin_amdgcn_mfma_f32_32x32x16_bf16(kf[0], qr[0], negm, 0, 0, 0); p1 = __builtin_amdgcn_mfma_f32_32x32x16_bf16(kf[1], qr[0], negm, 0, 0, 0);
            p0 = __builtin_amdgcn_mfma_f32_32x32x16_bf16(kf[2], qr[1], p0, 0, 0, 0); p1 = __builtin_amdgcn_mfma_f32_32x32x16_bf16(kf[3], qr[1], p1, 0, 0, 0);
            asm volatile("s_waitcnt lgkmcnt(8)" ::: "memory"); __builtin_amdgcn_sched_barrier(0);
            p0 = __builtin_amdgcn_mfma_f32_32x32x16_bf16(kg[0], qr[2], p0, 0, 0, 0); p1 = __builtin_amdgcn_mfma_f32_32x32x16_bf16(kg[1], qr[2], p1, 0, 0, 0);
            p0 = __builtin_amdgcn_mfma_f32_32x32x16_bf16(kg[2], qr[3], p0, 0, 0, 0); p1 = __builtin_amdgcn_mfma_f32_32x32x16_bf16(kg[3], qr[3], p1, 0, 0, 0);
        }
        __builtin_amdgcn_sched_barrier(0);
        ATT_LDV(vb, 1);
        asm volatile("s_waitcnt lgkmcnt(8)" ::: "memory"); __builtin_amdgcn_sched_barrier(0);
        ATT_PV(0, va);
        __builtin_amdgcn_sched_barrier(0);
        ATT_LDV(va, 2);
        asm volatile("s_waitcnt lgkmcnt(8)" ::: "memory"); __builtin_amdgcn_sched_barrier(0);
        ATT_PV(1, vb);
        __builtin_amdgcn_sched_barrier(0);
        ATT_LDV(vb, 3);
        asm volatile("s_waitcnt lgkmcnt(8)" ::: "memory"); __builtin_amdgcn_sched_barrier(0);
        ATT_PV(2, va);
        asm volatile("s_waitcnt lgkmcnt(0)" ::: "memory"); __builtin_amdgcn_sched_barrier(0);
        ATT_PV(3, vb);
        __builtin_amdgcn_sched_barrier(0);
#undef ATT_LDV
#undef ATT_PV
        if (i + 3 < 128) { ATT_DMA(i + 3); asm volatile("s_waitcnt vmcnt(4) lgkmcnt(0)" ::: "memory"); }
        else asm volatile("s_waitcnt vmcnt(0) lgkmcnt(0)" ::: "memory");
        __builtin_amdgcn_s_barrier();
        __builtin_amdgcn_sched_barrier(0);
    }
    if (grp == 0) __builtin_amdgcn_s_barrier(); else __builtin_amdgcn_s_setprio(0);
#undef ATT_DMA
#undef ATT_QK
    lrow = swap32_add(lrow);
    if (hi == 0) wsf[r32] = frcp(lrow);
    asm volatile("s_waitcnt lgkmcnt(0)" ::: "memory");
#pragma unroll
    for (int r = 0; r < 16; ++r) { const float il = wsf[crow(r, hi)];
#pragma unroll
        for (int d = 0; d < 4; ++d) o[d][r] *= il; }
    LAS float* xb = (LAS float*)lds + (size_t)qsub * 4096 + lane;
    if (comp == 1) {
#pragma unroll
        for (int d = 0; d < 4; ++d)
#pragma unroll
            for (int r = 0; r < 16; ++r) xb[(d * 16 + r) * 64] = o[d][r];
    }
    __syncthreads();
    if (comp == 0) {
        float ss[16];
#pragma unroll
        for (int r = 0; r < 16; ++r) { ss[r] = 0.f;
#pragma unroll
            for (int d = 0; d < 4; ++d) { const float v = o[d][r] - lam * xb[(d * 16 + r) * 64]; o[d][r] = v; ss[r] += v * v; } }
        float gcol[4];
#pragma unroll
        for (int d = 0; d < 4; ++d) gcol[d] = subg[d * 32 + r32] * outscale;
#pragma unroll
        for (int r = 0; r < 16; ++r) { const float tot = half_sum(ss[r]); const float rs = 1.0f / sqrtf(tot * (1.f / 128.f) + LN_EPS);
            bf16* orow = MIX + ((size_t)b * 8192 + qb * 128 + qsub * 32 + crow(r, hi)) * 1024 + h * 128 + r32;
#pragma unroll
            for (int d = 0; d < 4; ++d) orow[d * 32] = (bf16)(pk2(o[d][r] * rs * gcol[d], 0.f) & 0xffffu); }
    }
    __syncthreads();
}

__device__ __forceinline__ void ret_kv_pair(LAS unsigned char* lds, const bf16* RET, float* RKV, const int unit0, const float* lg2f, const float* lg2b) {
    const int tid = otid(), lane = tid & 63, r32 = lane & 31, hi = lane >> 5; const int wid = __builtin_amdgcn_readfirstlane(tid >> 6);
    const int wg = wid >> 2, w4 = wid & 3, t4 = tid & 255;
    const int unit = unit0 + wg; const int bh = unit >> 6, n = unit & 63, b = bh >> 2, h = bh & 3;
    LAS unsigned char* base = lds + wg * 49152;
    const float l2f = lg2f[h], l2b = lg2b[h];
    const bf16* src = RET + ((size_t)b * 8192 + n * 128) * 1024 + 64 * h;
#pragma unroll
    for (int i = 0; i < 4; ++i) { const int idx = t4 + 256 * i; const int j = idx >> 3, c = idx & 7;
        const u32x4 kk = *(const u32x4*)(src + (size_t)j * 1024 + 256 + c * 8); const u32x4 vv = *(const u32x4*)(src + (size_t)j * 1024 + 512 + c * 8);
        const float wf = fexp2((float)(127 - j) * l2f), wb = fexp2((float)j * l2b);
        u32x4 vf, vb;
#pragma unroll
        for (int e = 0; e < 4; ++e) { const float lo = bflo(vv[e]), hh = bfhi(vv[e]); vf[e] = pk2(lo * wf, hh * wf); vb[e] = pk2(lo * wb, hh * wb); }
        *(LAS u32x4*)(base + j * 128 + c * 16) = kk; *(LAS u32x4*)(base + 16384 + j * 128 + c * 16) = vf; *(LAS u32x4*)(base + 32768 + j * 128 + c * 16) = vb; }
    __syncthreads();
    const int da = w4 >> 1, eb = w4 & 1;
    const int rowoff = (8 * hi + ((lane & 15) >> 2)) * 128 + (16 * ((lane >> 4) & 1) + 4 * (lane & 3)) * 2;
    f32x16 af = (f32x16){}, ab = (f32x16){};
#pragma unroll
    for (int s = 0; s < 8; ++s) {
        const LAS char* kp = (const LAS char*)base + s * 2048 + rowoff + da * 64;
        const LAS char* vp = (const LAS char*)base + 16384 + s * 2048 + rowoff + eb * 64;
        const bf16x8 ka = cat8(vtr(kp), vtr(kp + 512));
        const bf16x8 vf = cat8(vtr(vp), vtr(vp + 512)), vb = cat8(vtr(vp + 16384), vtr(vp + 16384 + 512));
        af = __builtin_amdgcn_mfma_f32_32x32x16_bf16(ka, vf, af, 0, 0, 0);
        ab = __builtin_amdgcn_mfma_f32_32x32x16_bf16(ka, vb, ab, 0, 0, 0);
    }
    float* of = RKV + ((size_t)(bh * 64 + n) * 2) * 4096 + eb * 32 + r32;
#pragma unroll
    for (int r = 0; r < 16; ++r) { const int d = da * 32 + crow(r, hi); of[d * 64] = af[r]; of[4096 + d * 64] = ab[r]; }
    __syncthreads();
}
__device__ __forceinline__ void ret_out_pair(LAS unsigned char* lds, const bf16* RET, const bf16* RST, bf16* MIX, const int unit0, const float* lg2f, const float* lg2b) {
    const int tid = otid(), lane = tid & 63, r32 = lane & 31, hi = lane >> 5; const int wid = __builtin_amdgcn_readfirstlane(tid >> 6);
    const int wg = wid >> 2, w4 = wid & 3, t4 = tid & 255;
    const int unit = unit0 + wg; const int bh = unit >> 6, n = unit & 63, b = bh >> 2, h = bh & 3;
    LAS unsigned char* base = lds + wg * 49152;
    const float l2f = lg2f[h], l2b = lg2b[h];
    const size_t row0 = (size_t)b * 8192 + n * 128;
    const bf16* src = RET + row0 * 1024 + 64 * h;
#pragma unroll
    for (int i = 0; i < 4; ++i) { const int idx = t4 + 256 * i; const int j = idx >> 3, c = idx & 7;
        *(LAS u32x4*)(base + j * 128 + c * 16) = *(const u32x4*)(src + (size_t)j * 1024 + 256 + c * 8);
        *(LAS u32x4*)(base + 16384 + j * 128 + c * 16) = *(const u32x4*)(src + (size_t)j * 1024 + 512 + c * 8); }
    const bf16* rs = RST + ((size_t)(bh * 64 + n) * 2) * 4096;
#pragma unroll
    for (int i = 0; i < 4; ++i) { const int idx = t4 + 256 * i;
        *(LAS u32x4*)(base + 32768 + idx * 16) = *(const u32x4*)(rs + (size_t)idx * 8); }
    bf16x8 qr[4];
    const bf16* qp = src + (size_t)(32 * w4 + r32) * 1024;
#pragma unroll
    for (int d0 = 0; d0 < 4; ++d0) qr[d0] = *(const bf16x8*)(qp + d0 * 16 + hi * 8);
    __syncthreads();
    const int cq = 32 * w4 + r32;
    f32x16 yi[2] = {(f32x16){}, (f32x16){}}, yf[2] = {(f32x16){}, (f32x16){}}, yb[2] = {(f32x16){}, (f32x16){}};
    const int trl = ((lane & 15) >> 2) * 128 + (16 * ((lane >> 4) & 1) + 4 * (lane & 3)) * 2;
#pragma unroll
    for (int kb = 0; kb < 4; ++kb) {
        f32x16 p = (f32x16){};
#pragma unroll
        for (int d0 = 0; d0 < 4; ++d0) { const bf16x8 a = *(const LAS bf16x8*)(base + (32 * kb + r32) * 128 + (16 * d0 + 8 * hi) * 2); p = __builtin_amdgcn_mfma_f32_32x32x16_bf16(a, qr[d0], p, 0, 0, 0); }
#pragma unroll
        for (int r = 0; r < 16; ++r) { const int j = 32 * kb + crow(r, hi); const int rel = cq - j; p[r] *= fexp2(rel >= 0 ? (float)rel * l2f : (float)(-rel) * l2b); }
        const bf16x8 pa0 = pack8(p[0], p[1], p[2], p[3], p[4], p[5], p[6], p[7]), pa1 = pack8(p[8], p[9], p[10], p[11], p[12], p[13], p[14], p[15]);
#pragma unroll
        for (int eb = 0; eb < 2; ++eb) {
            const LAS char* vp = (const LAS char*)base + 16384 + (32 * kb + 4 * hi) * 128 + trl + eb * 64;
            const bf16x8 v0 = cat8(vtr(vp), vtr(vp + 8 * 128)), v1 = cat8(vtr(vp + 16 * 128), vtr(vp + 24 * 128));
            yi[eb] = __builtin_amdgcn_mfma_f32_32x32x16_bf16(pa0, v0, yi[eb], 0, 0, 0);
            yi[eb] = __builtin_amdgcn_mfma_f32_32x32x16_bf16(pa1, v1, yi[eb], 0, 0, 0);
        }
    }
#pragma unroll
    for (int d0 = 0; d0 < 4; ++d0)
#pragma unroll
        for (int eb = 0; eb < 2; ++eb) {
            const LAS char* rp = (const LAS char*)base + 32768 + (16 * d0 + 8 * hi) * 128 + trl + eb * 64;
            const bf16x8 rf = cat8(vtr(rp), vtr(rp + 4 * 128)), rb = cat8(vtr(rp + 8192), vtr(rp + 8192 + 4 * 128));
            yf[eb] = __builtin_amdgcn_mfma_f32_32x32x16_bf16(qr[d0], rf, yf[eb], 0, 0, 0);
            yb[eb] = __builtin_amdgcn_mfma_f32_32x32x16_bf16(qr[d0], rb, yb[eb], 0, 0, 0);
        }
#pragma unroll
    for (int r = 0; r < 16; ++r) {
        const int c = 32 * w4 + crow(r, hi);
        const float sf = fexp2((float)(c + 1) * l2f), sb = fexp2((float)(128 - c) * l2b);
        const float y0 = yi[0][r] + sf * yf[0][r] + sb * yb[0][r], y1 = yi[1][r] + sf * yf[1][r] + sb * yb[1][r];
        const float mean = half_sum(y0 + y1) * (1.f / 64.f); const float d0_ = y0 - mean, d1_ = y1 - mean;
        const float var = half_sum(d0_ * d0_ + d1_ * d1_) * (1.f / 64.f); const float rstd = 1.0f / sqrtf(var + LN_EPS);
        const bf16* gp = RET + (row0 + c) * 1024 + 768 + 64 * h + r32; bf16* op = MIX + (row0 + c) * 1024 + 768 + 64 * h + r32;
        const float g0 = bf2f(gp[0]), g1 = bf2f(gp[32]);
        op[0] = (bf16)(pk2(g0 * sigmoidf_(g0) * d0_ * rstd, 0.f) & 0xffffu); op[32] = (bf16)(pk2(g1 * sigmoidf_(g1) * d1_ * rstd, 0.f) & 0xffffu);
    }
    __syncthreads();
}

__device__ __forceinline__ int moe_tables(LAS unsigned char* lds, const unsigned* gcnt) {
    LAS int* cnt = (LAS int*)(lds + TAB_OFF); LAS int* tstart = cnt + 32; LAS unsigned char* tile_e = (LAS unsigned char*)(tstart + 36);
    const int tid = otid();
    if (tid < 32) cnt[tid] = (int)gcnt[tid];
    __syncthreads();
    if (tid == 0) { int s = 0; for (int e = 0; e < 32; ++e) { tstart[e] = s; s += (cnt[e] + 255) >> 8; } tstart[32] = s; }
    __syncthreads();
    const int ntile = tstart[32];
    for (int p = tid; p < ntile; p += NTHR) { int e = 0;
#pragma unroll
        for (int k = 1; k < 32; ++k) e += (tstart[k] <= p) ? 1 : 0;
        tile_e[p] = (unsigned char)e; }
    __syncthreads();
    return ntile;
}

constexpr int NPH_LAYER = 10, NPH = 3 + DEPTH * NPH_LAYER;
#ifndef PH_MASK
#define PH_MASK 0x1FFFF
#endif
#define PHM(j) (((PH_MASK) >> (j)) & 1)
#ifndef DUP_MASK
#define DUP_MASK 0x0
#endif
#define NREP(j) (1 + (((DUP_MASK) >> (j)) & 1))
__global__ void __launch_bounds__(NTHR, 2) hybrid_fwd(Args args) {
    extern __shared__ __attribute__((aligned(16))) unsigned char lds_raw[];
    LAS unsigned char* lds = (LAS unsigned char*)lds_raw;
    volatile LAS unsigned* MISC = (volatile LAS unsigned*)(lds + MISC_OFF);
    const int G = gridDim.x, bx = blockIdx.x;
    const int NGW = G * NWAVES, NGT = G * NTHR;
#define PH_IDS const int tid = otid(); const int lane = tid & 63; const int wave = __builtin_amdgcn_readfirstlane(tid >> 6); const int gw = bx * NWAVES + wave; const int gt = bx * NTHR + tid; (void)lane; (void)gw; (void)gt; (void)wave;
    unsigned char* ws = args.ws;
    unsigned* ctl = (unsigned*)(ws + WS_CTL);
    for (int u = threadIdx.x; u < (LDS_BYTES - LDSCTL_OFF) / 4; u += NTHR) ((LAS unsigned*)(lds + LDSCTL_OFF))[u] = 0u;
    __syncthreads();
#if MK_SPLIT
    XcdBarrier bar; bar.bar = ctl + CW_BAR; bar.x = 0; bar.st = nullptr;
#define GRID_BAR() do { } while (0)
#else
    XcdBarrier bar = xcd_barrier_post(ctl + CW_BAR, MISC + 8);
#define GRID_BAR() xcd_barrier(bar)
#endif
    const int lo = args.ph_lo, hi_ph = args.ph_hi;
#define IN(k) (lo <= (k) && (k) < hi_ph)
#ifndef BAR_REP
#define BAR_REP 1
#endif
#define SEAM(k) do { if (IN((k) + 1)) { for (int br_ = 0; br_ < BAR_REP; ++br_) GRID_BAR(); } STAMP(k); } while (0)
#if STAMP_SEL >= 0
    if (threadIdx.x == 0) { const unsigned long long t0_ = __builtin_amdgcn_s_memrealtime(); MISC[16] = (unsigned)t0_; MISC[17] = (unsigned)(t0_ >> 32); MISC[18] = 0u; }
#define STAMP(k) do { if (threadIdx.x == 0) { const unsigned long long now_ = __builtin_amdgcn_s_memrealtime(); const unsigned long long last_ = (unsigned long long)MISC[16] | ((unsigned long long)MISC[17] << 32); \
        if ((k) == STAMP_SEL) MISC[18] = __float_as_uint((float)(now_ - last_) * 0.0002f); MISC[16] = (unsigned)now_; MISC[17] = (unsigned)(now_ >> 32); } } while (0)
#else
#define STAMP(k) do { } while (0)
#endif

    const float* x_in = (const float*)args.in[0]; const float* c_in = (const float*)args.in[1]; const int* pos_in = (const int*)args.in[2];
    const float* ada_w = (const float*)args.in[3]; const float* ada_b = (const float*)args.in[4];
    const float* w_in = (const float*)args.in[5]; const float* w_out = (const float*)args.in[6];
    const float* lq1 = (const float*)args.in[7]; const float* lk1 = (const float*)args.in[8]; const float* lq2 = (const float*)args.in[9]; const float* lk2 = (const float*)args.in[10];
    const float* subln_g = (const float*)args.in[11];
    const float* s5_lre = (const float*)args.in[12]; const float* s5_lim = (const float*)args.in[13]; const float* s5_ls = (const float*)args.in[14];
    const float* s5_bre = (const float*)args.in[15]; const float* s5_bim = (const float*)args.in[16]; const float* s5_cre = (const float*)args.in[17]; const float* s5_cim = (const float*)args.in[18];
    const float* s5_d = (const float*)args.in[19]; const float* glu_w = (const float*)args.in[20]; const float* glu_b = (const float*)args.in[21];
    const float* ln_g = (const float*)args.in[22]; const float* ln_b = (const float*)args.in[23];
    const float* router_w = (const float*)args.in[24]; const float* router_b = (const float*)args.in[25];
    const float* exp_w1 = (const float*)args.in[26]; const float* exp_b1 = (const float*)args.in[27]; const float* exp_w2 = (const float*)args.in[28]; const float* exp_b2 = (const float*)args.in[29];
    float* MOD = (float*)(ws + WS_MOD); float* ROT = (float*)(ws + WS_ROT); float* PW = (float*)(ws + WS_PW); float* BB = (float*)(ws + WS_BB);
    bf16* WIN = (bf16*)(ws + WS_WIN); bf16* WOUT = (bf16*)(ws + WS_WOUT); bf16* GLU = (bf16*)(ws + WS_GLU); bf16* W1S = (bf16*)(ws + WS_W1S); bf16* TW = (bf16*)(ws + WS_TW);
    bf16* W1 = (bf16*)(ws + WS_W1); bf16* W2 = (bf16*)(ws + WS_W2); bf16* HB = (bf16*)(ws + WS_HB);
    bf16* QIMG = (bf16*)(ws + WS_QIMG); bf16* KIMG = (bf16*)(ws + WS_KIMG); bf16* VIMG = (bf16*)(ws + WS_VIMG); bf16* UG2 = (bf16*)(ws + WS_UG2); bf16* RET = (bf16*)(ws + WS_RET);
    float* S5S = (float*)(ws + WS_S5S); bf16* YB = (bf16*)(ws + WS_YB); float* RKV = (float*)(ws + WS_RKV); bf16* RST = (bf16*)(ws + WS_RST); bf16* MIX = (bf16*)(ws + WS_MIX);
    float* YPRE = (float*)(ws + WS_YPRE); float* X1 = (float*)(ws + WS_X1); float* XB = (float*)(ws + WS_XB);
    int* LIST = (int*)(ws + WS_LIST); int* TOKI = (int*)(ws + WS_TOKI); float* GATE = (float*)(ws + WS_GATE); bf16* A2 = (bf16*)(ws + WS_A2); bf16* YS = (bf16*)(ws + WS_YS);
    float* COSA = ROT, *SINA = ROT + (size_t)T * 32, *COSR = ROT + (size_t)T * 64, *SINR = ROT + (size_t)T * 96;

    if (PHM(10) && IN(0)) {
        PH_IDS
        for (int rep = 0; rep < NREP(10); ++rep) {
        LAS float* cond = (LAS float*)lds; LAS float* red = (LAS float*)(lds + 16384);
        for (int i = tid; i < 4096; i += NTHR) { const float v = c_in[i]; cond[i] = v * sigmoidf_(v); }
        __syncthreads();
        for (int it = bx; it < 4 * 96; it += G) {
            const int l = it / 96, n0 = (it % 96) * 64;
            float a0 = 0.f, a1 = 0.f, a2 = 0.f, a3 = 0.f;
            const float* wp = ada_w + ((size_t)l * 1024 + wave * 128) * 6144 + n0 + lane;
#pragma unroll 32
            for (int kk = 0; kk < 128; ++kk) { const float wv = wp[(size_t)kk * 6144]; const int k = wave * 128 + kk; a0 += cond[k] * wv; a1 += cond[1024 + k] * wv; a2 += cond[2048 + k] * wv; a3 += cond[3072 + k] * wv; }
            red[(wave * 4 + 0) * 64 + lane] = a0; red[(wave * 4 + 1) * 64 + lane] = a1; red[(wave * 4 + 2) * 64 + lane] = a2; red[(wave * 4 + 3) * 64 + lane] = a3;
            __syncthreads();
            if (tid < 256) { const int b = tid >> 6; float s = ada_b[(size_t)l * 6144 + n0 + lane];
#pragma unroll
                for (int w = 0; w < 8; ++w) s += red[(w * 4 + b) * 64 + lane];
                MOD[((size_t)l * 4 + b) * 6144 + n0 + lane] = s; }
            __syncthreads();
        }
        for (int i = gt; i < T * 32; i += NGT) { const int row = i >> 5, f = i & 31; const double p = (double)pos_in[row];
            float c, s; sincos_rev(p * args.invfA[f], c, s); COSA[i] = c; SINA[i] = s; sincos_rev(p * args.invfR[f], c, s); COSR[i] = c; SINR[i] = s; }
        for (int i = gt; i < DEPTH * 32 * 1024; i += NGT) { const int k = i & 1023, e = (i >> 10) & 31, ll = i >> 15; ((float*)(ws + WS_ROUTW))[i] = router_w[((size_t)ll * 1024 + k) * 32 + e]; }
        for (int q = gt; q < 4 * 2 * 16 * 64 * 65; q += NGT) {
            const int i = q / 65, tau = q - i * 65; const int g = (i >> 6) & 15, ld = i >> 10;
            const float lr = fminf(s5_lre[i], -1e-4f), li = s5_lim[i]; const float dt = expf(s5_ls[ld * 16 + g]);
            const float mag = expf((float)tau * lr * dt); float c, sn; sincos_rev((double)tau * (double)li * (double)dt, c, sn);
            PW[(size_t)i * 130 + 2 * tau] = mag * c; PW[(size_t)i * 130 + 2 * tau + 1] = mag * sn;
        }
        for (int q = gt; q < 4 * 2 * 16 * 64 * 16; q += NGT) {
            const int i = q >> 4, n = q & 15; const int g = (i >> 6) & 15, ld = i >> 10;
            const float lr = fminf(s5_lre[i], -1e-4f), li = s5_lim[i]; const float dt = expf(s5_ls[ld * 16 + g]);
            const float mag = expf(lr * dt); float c, sn; sincos_rev((double)li * (double)dt, c, sn);
            const float ar = mag * c, ai = mag * sn, den = lr * lr + li * li;
            const float fre = ((ar - 1.0f) * lr + ai * li) / den, fim = (ai * lr - (ar - 1.0f) * li) / den;
            const float br = s5_bre[q], bi = s5_bim[q]; BB[(size_t)q * 2] = fre * br - fim * bi; BB[(size_t)q * 2 + 1] = fre * bi + fim * br;
        }
        __syncthreads(); }
        SEAM(0);
    }
    if (PHM(11) && IN(1)) {
        PH_IDS
        for (int rep = 0; rep < NREP(11); ++rep) {
        if (wave >= 4) {
        const int gw2 = bx * 4 + (wave - 4), NGW2 = G * 4, bt = bx * 256 + (tid - 256), NBT = G * 256;
        for (int m0 = gw2; m0 < T; m0 += 4 * NGW2) { f32x4 v[4][4];
#pragma unroll
            for (int r = 0; r < 4; ++r) { const f32x4* xr = (const f32x4*)(x_in + (size_t)(m0 + r * NGW2) * DM) + lane;
#pragma unroll
                for (int j = 0; j < 4; ++j) v[r][j] = xr[64 * j]; }
#pragma unroll
            for (int r = 0; r < 4; ++r) { const int m = m0 + r * NGW2; const float* md = MOD + (size_t)(m >> 13) * 6144; mod_row_store(v[r], md, md + 1024, HB + (size_t)m * DM, lane); } }
        float* KT = S5S;
#pragma unroll 2
        for (int i = bt; i < 4 * 16 * 2 * 64 * 256; i += NBT) {
            const int mm = i & 15, n = (i >> 4) & 15, tau = (i >> 8) & 63, dir = (i >> 14) & 1, g = (i >> 15) & 15, l = i >> 19;
            const size_t pg = ((size_t)(l * 2 + dir) * 16 + g);
            const float* cr = s5_cre + (pg * 16 + n) * 64; const float* ci = s5_cim + (pg * 16 + n) * 64;
            const float* pw = PW + pg * 64 * 130 + 2 * tau; const float* bb = BB + (pg * 64 * 16 + mm) * 2;
            float acc = 0.f;
#pragma unroll 8
            for (int p = 0; p < 64; ++p) { const float pr = pw[(size_t)p * 130], pi = pw[(size_t)p * 130 + 1], br = bb[(size_t)p * 32], bi = bb[(size_t)p * 32 + 1];
                acc += cr[p] * (pr * br - pi * bi) - ci[p] * (pr * bi + pi * br); }
            KT[i] = acc;
        }
#pragma unroll 2
        for (int i = bt; i < 4 * 16 * 1024 * 32; i += NBT) {
            const int c8 = i & 31, rowj = (i >> 5) & 1023, g = (i >> 15) & 15, l = i >> 19;
            const int col = c8 * 8, dir = col >> 7, part = (col >> 6) & 1, p0 = col & 63;
            const size_t pg = ((size_t)(l * 2 + dir) * 16 + g);
            const int j = rowj >> 4, n = rowj & 15; const int tau = dir == 0 ? j + 1 : 64 - j;
            const float* cp = s5_cre + (pg * 16 + n) * 64 + p0; const float* cq = s5_cim + (pg * 16 + n) * 64 + p0;
            const f32x4 cr0 = *(const f32x4*)cp, cr1 = *(const f32x4*)(cp + 4), ci0 = *(const f32x4*)cq, ci1 = *(const f32x4*)(cq + 4);
            float v[8];
#pragma unroll
            for (int e = 0; e < 8; ++e) { const f32x2 a = *(const f32x2*)(PW + (pg * 64 + p0 + e) * 130 + 2 * tau); const float cr = e < 4 ? cr0[e & 3] : cr1[e & 3], ci = e < 4 ? ci0[e & 3] : ci1[e & 3];
                v[e] = part == 0 ? (cr * a[0] - ci * a[1]) : -(cr * a[1] + ci * a[0]); }
            *(u32x4*)(TW + ((size_t)(l * 16 + g) * 1024 + rowj) * 1280 + 1024 + col) = (u32x4){pk2(v[0], v[1]), pk2(v[2], v[3]), pk2(v[4], v[5]), pk2(v[6], v[7])};
        }
#pragma unroll 2
        for (int i = bt; i < 4 * 16 * 256 * 128; i += NBT) {
            const int c8 = i & 127, p2 = (i >> 7) & 255, g = (i >> 15) & 15, l = i >> 19;
            const int dir = p2 >> 7, part = (p2 >> 6) & 1, p = p2 & 63;
            const size_t pg = ((size_t)(l * 2 + dir) * 16 + g);
            const int sidx = c8 >> 1, m0 = (c8 & 1) * 8; const int tau = dir == 0 ? 63 - sidx : sidx;
            const f32x2 pwv = *(const f32x2*)(PW + (pg * 64 + p) * 130 + 2 * tau);
            const float* bp = BB + ((pg * 64 + p) * 16 + m0) * 2;
            const f32x4 b0 = *(const f32x4*)bp, b1 = *(const f32x4*)(bp + 4), b2 = *(const f32x4*)(bp + 8), b3 = *(const f32x4*)(bp + 12);
            const float br[8] = {b0[0], b0[2], b1[0], b1[2], b2[0], b2[2], b3[0], b3[2]}, bi[8] = {b0[1], b0[3], b1[1], b1[3], b2[1], b2[3], b3[1], b3[3]};
            float v[8];
#pragma unroll
            for (int e = 0; e < 8; ++e) v[e] = part == 0 ? (pwv[0] * br[e] - pwv[1] * bi[e]) : (pwv[0] * bi[e] + pwv[1] * br[e]);
            *(u32x4*)(W1S + (size_t)i * 8) = (u32x4){pk2(v[0], v[1]), pk2(v[2], v[3]), pk2(v[4], v[5]), pk2(v[6], v[7])};
        }
        }
        {
            LAS float* scr = (LAS float*)(lds + 32768 + wave * 8704);
            constexpr int I_IN = 16 * 88, I_OUT = 16 * 32, I_GLU = 4 * 16, I_W1 = 16 * 64, I_W2 = 16 * 32;
            constexpr int N_SMALL = DEPTH * (I_IN + I_OUT + I_GLU);
            constexpr int N_ALL = N_SMALL + DEPTH * NE * (I_W1 + I_W2);
            for (;;) {
                int it0 = 0; if (lane == 0) it0 = (int)__hip_atomic_fetch_add(ctl + CW_CONV, 16u, __ATOMIC_RELAXED, __HIP_MEMORY_SCOPE_AGENT);
                it0 = __builtin_amdgcn_readfirstlane(it0);
                if (it0 >= N_ALL) break;
                for (int it = it0; it < it0 + 16 && it < N_ALL; ++it) {
                int r = it;
                if (r < N_SMALL) {
                    const int l = r / (I_IN + I_OUT + I_GLU); r %= (I_IN + I_OUT + I_GLU);
                    if (r < I_IN) transpose_item<1>(w_in + (size_t)l * 1024 * INW, 1024, INW, WIN + (size_t)l * INW * 1024, scr, r, lane);
                    else if (r < I_IN + I_OUT) transpose_item<0>(w_out + (size_t)l * 1024 * 1024, 1024, 1024, WOUT + (size_t)l * 1024 * 1024, scr, r - I_IN, lane);
                    else transpose_item<3>(glu_w + (size_t)l * 256 * 512, 256, 512, GLU + (size_t)l * 512 * 256, scr, r - I_IN - I_OUT, lane);
                } else {
                    r -= N_SMALL; const int le = r / (I_W1 + I_W2); r %= (I_W1 + I_W2);
                    if (r < I_W1) transpose_item<2>(exp_w1 + (size_t)le * 1024 * 2048, 1024, 2048, W1 + (size_t)le * 2048 * 1024, scr, r, lane);
                    else transpose_item<0>(exp_w2 + (size_t)le * 1024 * 1024, 1024, 1024, W2 + (size_t)le * 1024 * 1024, scr, r - I_W1, lane);
                }
                }
            }
        }
        }
        SEAM(1);
    }
    if (PHM(11) && IN(2)) {
        PH_IDS
        const float* KT = S5S;
        LAS float* slab = (LAS float*)lds;
        for (int it = bx; it < 4 * 16 * 16; it += G) {
            const int n = it & 15, lg = it >> 4;
            for (int q = tid; q < 512; q += NTHR) { const int dt = q >> 2, c4 = q & 3;
                *(LAS f32x4*)(slab + dt * 16 + c4 * 4) = *(const f32x4*)(KT + (((size_t)lg * 128 + dt) * 16 + n) * 16 + c4 * 4); }
            __syncthreads();
#pragma unroll 4
            for (int q = tid; q < 64 * 128; q += NTHR) { const int c8 = q & 127, j = q >> 7; const int sidx = c8 >> 1, m0 = (c8 & 1) * 8;
                const int d = j - sidx; const int tau = d >= 0 ? d : -d; const LAS float* kf = slab + ((d >= 0 ? 0 : 64) + tau) * 16 + m0;
                f32x4 a0 = *(const LAS f32x4*)kf, a1 = *(const LAS f32x4*)(kf + 4);
                if (d == 0) { a0 += *(const LAS f32x4*)(kf + 1024); a1 += *(const LAS f32x4*)(kf + 1028); }
                *(u32x4*)(TW + ((size_t)lg * 1024 + j * 16 + n) * 1280 + sidx * 16 + m0) = pack8u(a0, a1); }
            __syncthreads();
        }
        SEAM(2);
    }

    for (int l = 0; l < DEPTH; ++l) {
        const int P = 3 + l * NPH_LAYER;
        const float* xcur = (l == 0) ? x_in : XB;
        float* xnext = (l == DEPTH - 1) ? args.out : XB;
        const float* modl = MOD + (size_t)l * 4 * 6144;
        unsigned* gcnt = ctl + CW_GCNT + 64 * l;
        if (PHM(0) && IN(P + 0)) {
            DenseSched S{T / 256, INW / 256, G, bx, (const char*)HB, (const char*)(WIN + (size_t)l * INW * 1024), (size_t)256 * 1024 * 2, (size_t)256 * 1024 * 2};
            EpiProj E{QIMG, KIMG, VIMG, UG2, RET, COSA, SINA, COSR, SINR};
            for (int rep = 0; rep < NREP(0); ++rep) pg8::gemm_phase<EpiProj, DenseSched, false>(lds, 1024, 1024, 1024, S, E);
            SEAM(P + 0);
        }
        if (PHM(1) && IN(P + 1)) {
            S5G1Sched S{G, bx, (const char*)UG2, (const char*)(W1S + (size_t)l * 16 * 256 * 1024)};
            EpiS5S E{(float*)(ws + WS_S5S4)};
            for (int rep = 0; rep < NREP(1); ++rep) {
            if (PHM(12)) pg8::gemm_phase<EpiS5S, S5G1Sched, false>(lds, 256, 1280, 1024, S, E);
            __syncthreads();
            if (PHM(13)) {
                if (bx < 128) ret_kv_pair(lds, RET, RKV, 2 * bx, args.lg2f, args.lg2b);
                else for (int k = 0; k < 3; ++k) ret_kv_pair(lds, RET, RKV, 2 * (128 + (bx - 128) * 3 + k), args.lg2f, args.lg2b);
            }
            }
            SEAM(P + 1);
        }
        if (PHM(2) && IN(P + 2)) {
            PH_IDS
            for (int rep = 0; rep < NREP(2); ++rep) {
            if (bx < 128) {
                const int dir = bx & 1, g = (bx >> 1) & 15, b = bx >> 5;
                const size_t pg = ((size_t)(l * 2 + dir) * 16 + g);
                const float aqr = PW[(pg * 64 + lane) * 130 + 128], aqi = PW[(pg * 64 + lane) * 130 + 129];
                const float* sb = (const float*)(ws + WS_S5S4) + ((size_t)g * 512 + b * 128) * 256 + dir * 128 + lane;
                bf16* ob = UG2 + ((size_t)g * 512 + b * 128) * 1280 + 1024 + dir * 128 + lane;
                float sr[16], si[16];
#pragma unroll
                for (int k = 0; k < 16; ++k) { const int cc = 16 * wave + k; const int c = dir == 0 ? cc : 127 - cc; float ar_ = 0.f, ai_ = 0.f;
#pragma unroll
                    for (int q = 0; q < 4; ++q) { ar_ += sb[(size_t)q * (16 * 512 * 256) + (size_t)c * 256]; ai_ += sb[(size_t)q * (16 * 512 * 256) + (size_t)c * 256 + 64]; }
                    sr[k] = ar_; si[k] = ai_; }
                float hr = 0.f, hi2 = 0.f;
#pragma unroll
                for (int k = 0; k < 16; ++k) { const float nr = aqr * hr - aqi * hi2 + sr[k], ni = aqr * hi2 + aqi * hr + si[k]; hr = nr; hi2 = ni; }
                LAS float* seg = (LAS float*)lds;
                seg[(wave * 2 + 0) * 64 + lane] = hr; seg[(wave * 2 + 1) * 64 + lane] = hi2;
                float a16r = aqr, a16i = aqi;
#pragma unroll
                for (int q = 0; q < 4; ++q) { const float tr_ = a16r * a16r - a16i * a16i, ti_ = 2.f * a16r * a16i; a16r = tr_; a16i = ti_; }
                __syncthreads();
                hr = 0.f; hi2 = 0.f;
                for (int w2 = 0; w2 < wave; ++w2) { const float er = seg[(w2 * 2 + 0) * 64 + lane], ei = seg[(w2 * 2 + 1) * 64 + lane]; const float nr = a16r * hr - a16i * hi2 + er, ni = a16r * hi2 + a16i * hr + ei; hr = nr; hi2 = ni; }
#pragma unroll
                for (int k = 0; k < 16; ++k) { const int cc = 16 * wave + k; const int c = dir == 0 ? cc : 127 - cc;
                    ob[(size_t)c * 1280] = (bf16)(pk2(hr, 0.f) & 0xffffu); ob[(size_t)c * 1280 + 64] = (bf16)(pk2(hi2, 0.f) & 0xffffu);
                    const float nr = aqr * hr - aqi * hi2 + sr[k], ni = aqr * hi2 + aqi * hr + si[k]; hr = nr; hi2 = ni; }
                __syncthreads();
            }
            for (int i = gt; i < 2 * 16 * 4096; i += NGT) { const int idx = i & 4095, dir = (i >> 12) & 1, bh = i >> 13, h = bh & 3;
                const float dk = fexp2(128.f * (dir == 0 ? args.lg2f[h] : args.lg2b[h]));
                const float* kv = RKV + (size_t)bh * 64 * 2 * 4096 + dir * 4096 + idx; bf16* rs = RST + (size_t)bh * 64 * 2 * 4096 + dir * 4096 + idx;
                float st = 0.f;
#pragma unroll 16
                for (int nn = 0; nn < 64; ++nn) { const int n = dir == 0 ? nn : 63 - nn; const float v = kv[(size_t)n * 8192]; rs[(size_t)n * 8192] = (bf16)(pk2(st, 0.f) & 0xffffu); st = dk * st + v; }
            }
            }
            SEAM(P + 2);
        }
        if (PHM(3) && IN(P + 3)) {
            float lam;
            { float s1 = 0.f, s2 = 0.f; for (int i = 0; i < 64; ++i) { s1 += lq1[l * 64 + i] * lk1[l * 64 + i]; s2 += lq2[l * 64 + i] * lk2[l * 64 + i]; } lam = expf(s1) - expf(s2) + args.lam_init[l]; }
            if (PHM(14)) for (int rep = 0; rep < NREP(14); ++rep) for (int u = bx; u < 1024; u += G) { const int qb = u & 63, bh = u >> 6; attn_unit(lds, QIMG, KIMG, VIMG, MIX, bh >> 2, bh & 3, qb, lam, subln_g + l * 128, 1.0f - args.lam_init[l]); }
            const int half = G >> 1;
            if (PHM(15)) {
                GroupSched S{4, half, bx < half ? bx : -1, (const char*)UG2, (const char*)(TW + (size_t)l * 16 * 1024 * 1280), (size_t)512 * 1280 * 2, (size_t)1024 * 1280 * 2, (size_t)256 * 1280 * 2, (size_t)256 * 1280 * 2};
                EpiS5Y E{YB, UG2, s5_d + l * 256};
                for (int rep = 0; rep < NREP(15); ++rep) pg8::gemm_phase<EpiS5Y, GroupSched, false>(lds, 1280, 1280, 1280, S, E);
            }
            __syncthreads();
            if (PHM(16)) for (int rep = 0; rep < NREP(16); ++rep) {
                if (bx < half) ret_out_pair(lds, RET, RST, MIX, 2 * bx, args.lg2f, args.lg2b);
                else for (int k = 0; k < 3; ++k) ret_out_pair(lds, RET, RST, MIX, 2 * (half + (bx - half) * 3 + k), args.lg2f, args.lg2b);
            }
            SEAM(P + 3);
        }
        if (PHM(4) && IN(P + 4)) {
            DenseSched S{T / 256, 2, G, bx, (const char*)YB, (const char*)(GLU + (size_t)l * 512 * 256), (size_t)256 * 256 * 2, (size_t)256 * 256 * 2};
            EpiGlu E{MIX, glu_b + l * 512};
            for (int rep = 0; rep < NREP(4); ++rep) pg8::gemm_phase<EpiGlu, DenseSched, false>(lds, 256, 256, 256, S, E);
            SEAM(P + 4);
        }
        if (PHM(5) && IN(P + 5)) {
            DenseSched S{T / 256, 4, G, bx, (const char*)MIX, (const char*)(WOUT + (size_t)l * 1024 * 1024), (size_t)256 * 1024 * 2, (size_t)256 * 1024 * 2};
            EpiOut E{(bf16*)YPRE, modl};
            for (int rep = 0; rep < NREP(5); ++rep) pg8::gemm_phase<EpiOut, DenseSched, false>(lds, 1024, 1024, 1024, S, E);
            SEAM(P + 5);
        }
        if (PHM(6) && IN(P + 6)) {
            PH_IDS
            for (int rep = 0; rep < NREP(6); ++rep) { const bool commit = (rep == NREP(6) - 1);
            __syncthreads();
            LAS float* WT = (LAS float*)lds;
            for (int i = tid; i < 8192; i += NTHR) ((LAS f32x4*)WT)[i] = ((const f32x4*)(ws + WS_ROUTW) + (size_t)l * 8192)[i];
            LAS int* lcnt = (LAS int*)(lds + TAB_OFF); LAS int* lbase = lcnt + 32; LAS int* ent = lbase + 32;
            if (tid < 32) lcnt[tid] = 0;
            __syncthreads();
            const float rbv = router_b[l * 32 + (lane >> 1)];
            int it = 0;
            f32x4 xn[2][4]; u32x2 yn[2][4];
#pragma unroll
            for (int r = 0; r < 2; ++r)
#pragma unroll
                for (int j = 0; j < 4; ++j) { yn[r][j] = *(const u32x2*)((const bf16*)YPRE + (size_t)(gw + r * NGW) * DM + 4 * lane + 256 * j); xn[r][j] = *((const f32x4*)(xcur + (size_t)(gw + r * NGW) * DM) + lane + 64 * j); }
            for (int m0 = gw; m0 < T; m0 += 2 * NGW, ++it) {
                f32x4 v[2][4]; float mean[2], rstd[2];
#pragma unroll
                for (int r = 0; r < 2; ++r)
#pragma unroll
                    for (int j = 0; j < 4; ++j) { const u32x2 ym = yn[r][j]; v[r][j] = xn[r][j] * DN_ALPHA + (f32x4){bflo(ym[0]), bfhi(ym[0]), bflo(ym[1]), bfhi(ym[1])}; }
                { const int mn = (m0 + 2 * NGW < T) ? m0 + 2 * NGW : m0;
#pragma unroll
                  for (int r = 0; r < 2; ++r)
#pragma unroll
                    for (int j = 0; j < 4; ++j) { yn[r][j] = *(const u32x2*)((const bf16*)YPRE + (size_t)(mn + r * NGW) * DM + 4 * lane + 256 * j); xn[r][j] = *((const f32x4*)(xcur + (size_t)(mn + r * NGW) * DM) + lane + 64 * j); } }
#pragma unroll
                for (int r = 0; r < 2; ++r) row_stats(v[r], mean[r], rstd[r]);
#pragma unroll
                for (int j = 0; j < 4; ++j) { const int col = 4 * lane + 256 * j; const f32x4 gg = *(const f32x4*)(ln_g + (size_t)(l * 2) * DM + col), bb = *(const f32x4*)(ln_b + (size_t)(l * 2) * DM + col);
#pragma unroll
                    for (int r = 0; r < 2; ++r) { v[r][j] = (v[r][j] - mean[r]) * rstd[r] * gg + bb; *(f32x4*)(X1 + (size_t)(m0 + r * NGW) * DM + col) = v[r][j]; } }
#pragma unroll
                for (int r = 0; r < 2; ++r) row_stats(v[r], mean[r], rstd[r]);
#pragma unroll
                for (int r = 0; r < 2; ++r) { const int m = m0 + r * NGW; const float* sh = modl + (size_t)(m >> 13) * 6144 + 3 * 1024; const float* sc = sh + 1024;
#pragma unroll
                    for (int j = 0; j < 4; ++j) { const int col = 4 * lane + 256 * j; const f32x4 a = *(const f32x4*)(sc + col), bb = *(const f32x4*)(sh + col);
                        v[r][j] = (v[r][j] - mean[r]) * rstd[r] * (a + 1.0f) + bb; *(u32x2*)(HB + (size_t)m * DM + col) = (u32x2){pk2(v[r][j][0], v[r][j][1]), pk2(v[r][j][2], v[r][j][3])}; } }
#pragma unroll
                for (int r = 0; r < 2; ++r) {
                    float pe[32];
#pragma unroll
                    for (int eg = 0; eg < 8; ++eg) {
#pragma unroll
                        for (int e = 4 * eg; e < 4 * eg + 4; ++e) { f32x2 a01 = (f32x2){0.f, 0.f}, a23 = (f32x2){0.f, 0.f};
#pragma unroll
                            for (int j = 0; j < 4; ++j) { const f32x4 w = *(const LAS f32x4*)(WT + e * 1024 + 4 * lane + 256 * j);
                                a01 = __builtin_elementwise_fma(__builtin_shufflevector(v[r][j], v[r][j], 0, 1), __builtin_shufflevector(w, w, 0, 1), a01);
                                a23 = __builtin_elementwise_fma(__builtin_shufflevector(v[r][j], v[r][j], 2, 3), __builtin_shufflevector(w, w, 2, 3), a23); }
                            const f32x2 s2 = a01 + a23; pe[e] = s2[0] + s2[1]; }
                        asm volatile("" ::: "memory");
                    }
#pragma unroll
                    for (int e = 0; e < 16; e += 4) swap32x4(pe[e], pe[e + 16], pe[e + 1], pe[e + 17], pe[e + 2], pe[e + 18], pe[e + 3], pe[e + 19]);
#pragma unroll
                    for (int e = 0; e < 16; ++e) pe[e] += pe[e + 16];
#pragma unroll
                    for (int e = 0; e < 8; e += 4) swap16x4(pe[e], pe[e + 8], pe[e + 1], pe[e + 9], pe[e + 2], pe[e + 10], pe[e + 3], pe[e + 11]);
#pragma unroll
                    for (int e = 0; e < 8; ++e) pe[e] += pe[e + 8];
                    { const bool b3 = (lane & 8) != 0;
#pragma unroll
                      for (int j = 0; j < 4; ++j) { const float snd = b3 ? pe[j] : pe[j + 4], kp = b3 ? pe[j + 4] : pe[j]; pe[j] = kp + dppmov<0x128>(snd); } }
                    { const bool b2 = (lane & 4) != 0;
#pragma unroll
                      for (int j = 0; j < 2; ++j) { const float snd = b2 ? pe[j] : pe[j + 2], kp = b2 ? pe[j + 2] : pe[j]; pe[j] = kp + dppmov<0x1B>(dppmov<0x141>(snd)); } }
                    { const bool b1 = (lane & 2) != 0; const float snd = b1 ? pe[0] : pe[1], kp = b1 ? pe[1] : pe[0]; pe[0] = kp + dppmov<0x4E>(snd); }
                    float lgv = pe[0] + dppmov<0xB1>(pe[0]) + rbv;
                    int te[4]; float tv[4];
#pragma unroll
                    for (int k = 0; k < 4; ++k) { const float mx = wave_max(lgv); const unsigned long long bm = __ballot(lgv == mx); const int fl = __ffsll((long long)bm) - 1;
                        te[k] = fl >> 1; tv[k] = mx; lgv = ((lane >> 1) == (fl >> 1)) ? -INFINITY : lgv; }
                    float gs = 0.f, ge[4];
#pragma unroll
                    for (int k = 0; k < 4; ++k) { ge[k] = fexp2((tv[k] - tv[0]) * LOG2E); gs += ge[k]; }
                    const float ig = 1.0f / gs;
                    if (lane < 4 && commit) { const int e = lane == 0 ? te[0] : lane == 1 ? te[1] : lane == 2 ? te[2] : te[3]; const float gv = (lane == 0 ? ge[0] : lane == 1 ? ge[1] : lane == 2 ? ge[2] : ge[3]) * ig;
                        const int lp = atomicAdd((int*)&lcnt[e], 1);
                        const int sl = (wave * 32 + it * 2 + r) * 4 + lane; ent[sl * 3] = e; ent[sl * 3 + 1] = lp; ent[sl * 3 + 2] = __float_as_int(gv); }
                }
            }
            if (!commit) continue;
            __syncthreads();
            if (tid < 32) lbase[tid] = (int)atomicAdd(gcnt + tid, (unsigned)lcnt[tid]);
            __syncthreads();
            { int nl = 0; for (int m = gw; m < T; m += NGW, ++nl) { if (lane < 4) { const int sl = (wave * 32 + nl) * 4 + lane; const int e = ent[sl * 3], pos = lbase[e] + ent[sl * 3 + 1];
                    LIST[(size_t)e * T + pos] = m; TOKI[((size_t)m * 4 + lane) * 2] = e; TOKI[((size_t)m * 4 + lane) * 2 + 1] = pos; GATE[(size_t)m * 4 + lane] = __int_as_float(ent[sl * 3 + 2]); } } }
            }
            SEAM(P + 6);
        }
        if (PHM(7) && IN(P + 7)) {
            const int ntile = moe_tables(lds, gcnt);
            LAS int* cnt = (LAS int*)(lds + TAB_OFF);
            MoeSched S{ntile, 8, G, bx, (const char*)HB, (const char*)(W1 + (size_t)l * 32 * 2048 * 1024), (size_t)2048 * 1024 * 2, 0, (size_t)256 * 1024 * 2, cnt, cnt + 32, (const LAS unsigned char*)(cnt + 68), LIST};
            EpiMoe1 E{A2, exp_b1 + (size_t)l * 32 * 2048};
            for (int rep = 0; rep < NREP(7); ++rep) pg8::gemm_phase<EpiMoe1, MoeSched, true>(lds, 1024, 1024, 1024, S, E);
            SEAM(P + 7);
        }
        if (PHM(8) && IN(P + 8)) {
            const int ntile = moe_tables(lds, gcnt);
            LAS int* cnt = (LAS int*)(lds + TAB_OFF);
            MoeSched S{ntile, 4, G, bx, (const char*)A2, (const char*)(W2 + (size_t)l * 32 * 1024 * 1024), (size_t)1024 * 1024 * 2, (size_t)256 * 1024 * 2, (size_t)256 * 1024 * 2, cnt, cnt + 32, (const LAS unsigned char*)(cnt + 68), LIST};
            EpiMoe2 E{YS, exp_b2 + (size_t)l * 32 * 1024};
            for (int rep = 0; rep < NREP(8); ++rep) pg8::gemm_phase<EpiMoe2, MoeSched, false>(lds, 1024, 1024, 1024, S, E);
            SEAM(P + 8);
        }
        if (PHM(9) && IN(P + 9)) {
            PH_IDS
            (void)moe_tables(lds, gcnt);
            const LAS int* tstart = (const LAS int*)(lds + TAB_OFF) + 32;
            for (int rep = 0; rep < NREP(9); ++rep)
            for (int m0 = gw; m0 < T; m0 += 2 * NGW) {
                int te[2][4], tp[2][4]; float tg[2][4];
#pragma unroll
                for (int r = 0; r < 2; ++r) { const int m = m0 + r * NGW; const u32x4 q0 = *(const u32x4*)(TOKI + (size_t)m * 8), q1 = *(const u32x4*)(TOKI + (size_t)m * 8 + 4); const f32x4 gq = *(const f32x4*)(GATE + (size_t)m * 4);
                    te[r][0] = q0[0]; tp[r][0] = q0[1]; te[r][1] = q0[2]; tp[r][1] = q0[3]; te[r][2] = q1[0]; tp[r][2] = q1[1]; te[r][3] = q1[2]; tp[r][3] = q1[3];
                    tg[r][0] = gq[0]; tg[r][1] = gq[1]; tg[r][2] = gq[2]; tg[r][3] = gq[3]; }
                u32x2 yw[2][4][4]; f32x4 xx[2][4];
#pragma unroll
                for (int r = 0; r < 2; ++r) {
#pragma unroll
                    for (int k = 0; k < 4; ++k) { const bf16* yr = YS + ((size_t)tstart[te[r][k]] * 256 + tp[r][k]) * 1024;
#pragma unroll
                        for (int j = 0; j < 4; ++j) yw[r][k][j] = *(const u32x2*)(yr + 4 * lane + 256 * j); }
#pragma unroll
                    for (int j = 0; j < 4; ++j) xx[r][j] = *(const f32x4*)(X1 + (size_t)(m0 + r * NGW) * DM + 4 * lane + 256 * j); }
#pragma unroll
                for (int r = 0; r < 2; ++r) {
                    const int m = m0 + r * NGW, b = m >> 13;
                    const float* g2 = modl + (size_t)b * 6144 + 5 * 1024;
                    f32x4 v[4];
#pragma unroll
                    for (int j = 0; j < 4; ++j) { f32x4 ff = (f32x4){0.f, 0.f, 0.f, 0.f};
#pragma unroll
                        for (int k = 0; k < 4; ++k) { const u32x2 w = yw[r][k][j]; ff += (f32x4){bflo(w[0]), bfhi(w[0]), bflo(w[1]), bfhi(w[1])} * tg[r][k]; }
                        const f32x4 gg = *(const f32x4*)(g2 + 4 * lane + 256 * j); v[j] = xx[r][j] * DN_ALPHA + (gg + 1.0f) * ff; }
                    float mean, rstd; row_stats(v, mean, rstd);
#pragma unroll
                    for (int j = 0; j < 4; ++j) { const int col = 4 * lane + 256 * j; const f32x4 gg = *(const f32x4*)(ln_g + (size_t)(l * 2 + 1) * DM + col), bb = *(const f32x4*)(ln_b + (size_t)(l * 2 + 1) * DM + col);
                        v[j] = (v[j] - mean) * rstd * gg + bb; *(f32x4*)(xnext + (size_t)m * DM + col) = v[j]; }
                    if (l + 1 < DEPTH) { const float* md = MOD + ((size_t)(l + 1) * 4 + b) * 6144; mod_row_store(v, md, md + 1024, HB + (size_t)m * DM, lane); }
                }
            }
            SEAM(P + 9);
        }
    }
#if STAMP_SEL >= 0
    __syncthreads();
    if (bx == 0 && threadIdx.x == 0) args.out[0] = __uint_as_float(MISC[18]);
#endif
#undef IN
#undef SEAM
#undef GRID_BAR
}

extern "C" void kernel_launch(void* const* d_in, const int* in_sizes, int n_in, void* d_out, int out_size, void* d_ws, size_t ws_size, hipStream_t stream) {
    static int grid = 0;
    if (grid == 0) {
        if (n_in != 30 || in_sizes[0] != T * DM || out_size != T * DM || ws_size < WS_END) { fprintf(stderr, "kernel_launch: unexpected problem (n_in %d, in0 %d, out %d, ws %zu)\n", n_in, n_in > 0 ? in_sizes[0] : -1, out_size, ws_size); grid = -1; return; }
        int dev = 0, cus = 0, per_cu = 0;
        if (hipGetDevice(&dev) != hipSuccess || hipDeviceGetAttribute(&cus, hipDeviceAttributeMultiprocessorCount, dev) != hipSuccess) { grid = -1; return; }
        if (hipFuncSetAttribute((const void*)hybrid_fwd, hipFuncAttributeMaxDynamicSharedMemorySize, LDS_BYTES) != hipSuccess) { fprintf(stderr, "kernel_launch: hipFuncSetAttribute failed\n"); grid = -1; return; }
        if (hipOccupancyMaxActiveBlocksPerMultiprocessor(&per_cu, (const void*)hybrid_fwd, NTHR, LDS_BYTES) != hipSuccess || per_cu < 1) { fprintf(stderr, "kernel_launch: occupancy query says %d\n", per_cu); (void)hipGetLastError(); if (per_cu < 1) { grid = -1; return; } }
        grid = cus;
        if (grid > 256) grid = 256;
        if (grid < 128) { grid = -1; return; }
    }
    if (grid < 0) return;
    (void)hipMemsetAsync((char*)d_ws + WS_CTL, 0, CTL_BYTES, stream);
    Args a{};
    for (int i = 0; i < 30; ++i) a.in[i] = d_in[i];
    a.out = (float*)d_out; a.ws = (unsigned char*)d_ws;
    for (int i = 0; i < 32; ++i) { a.invfA[i] = std::pow(10000.0, -(double)i / 32.0); a.invfR[i] = std::pow(10000.0, -(double)i / 31.0); }
    for (int l = 0; l < 4; ++l) a.lam_init[l] = (float)(0.8 - 0.6 * std::exp(-0.3 * l));
    for (int h = 0; h < 4; ++h) { a.lg2f[h] = (float)std::log2(1.0 - std::exp2(-5.0 - h)); a.lg2b[h] = (float)std::log2(1.0 - std::exp2(-5.5 - h)); }
#if MK_SPLIT
    for (int p = 0; p < NPH; ++p) { a.ph_lo = p; a.ph_hi = p + 1; hipLaunchKernelGGL(hybrid_fwd, dim3(grid), dim3(NTHR), LDS_BYTES, stream, a); }
#else
    a.ph_lo = 0; a.ph_hi = NPH;
    hipLaunchKernelGGL(hybrid_fwd, dim3(grid), dim3(NTHR), LDS_BYTES, stream, a);
#endif
}
```

```cpp
#include <hip/hip_runtime.h>
#include <cstdio>
#include <cstdint>
#include <cmath>

#define LAS __attribute__((address_space(3)))
#define GAS __attribute__((address_space(1)))
typedef unsigned short bf16;
typedef short bf16x8 __attribute__((ext_vector_type(8)));
typedef short s16x4 __attribute__((ext_vector_type(4)));
typedef float f32x4 __attribute__((ext_vector_type(4)));
typedef float f32x2 __attribute__((ext_vector_type(2)));
typedef float f32x16 __attribute__((ext_vector_type(16)));
typedef unsigned u32x4 __attribute__((ext_vector_type(4)));
typedef unsigned u32x2 __attribute__((ext_vector_type(2)));
typedef __bf16 bf16x2_t __attribute__((ext_vector_type(2)));

#ifndef STAMP_SEL
#define STAMP_SEL -1
#endif
#ifndef MK_SPLIT
#define MK_SPLIT 0
#endif

constexpr int NB = 4, SEQ = 8192, DM = 1024, T = NB * SEQ, DEPTH = 4;
constexpr int INW = 2816, NE = 32;
constexpr int NTILE_MAX = T * 4 / 256 + NE;
constexpr float LN_EPS = 1e-5f;
constexpr float C2 = 0.125f * 1.4426950408889634f;
constexpr float LOG2E = 1.4426950408889634f;
constexpr float DN_ALPHA = 1.681792830507429f;

constexpr size_t MiB = 1u << 20;
constexpr size_t WS_CTL = 0, CTL_BYTES = 65536;
constexpr size_t WS_MOD = 1 * MiB;
constexpr size_t WS_ROUTW = 1 * MiB + 512 * 1024;
constexpr size_t WS_ROT = 2 * MiB;
constexpr size_t WS_PW = 18 * MiB;
constexpr size_t WS_BB = 23 * MiB;
constexpr size_t WS_WIN = 24 * MiB;
constexpr size_t WS_WOUT = 46 * MiB;
constexpr size_t WS_GLU = 54 * MiB;
constexpr size_t WS_W1S = 56 * MiB;
constexpr size_t WS_TW = 88 * MiB;
constexpr size_t WS_W1 = 248 * MiB;
constexpr size_t WS_W2 = 760 * MiB;
constexpr size_t WS_HB = 1016 * MiB;
constexpr size_t WS_QIMG = 1080 * MiB;
constexpr size_t WS_KIMG = 1112 * MiB;
constexpr size_t WS_VIMG = 1144 * MiB;
constexpr size_t WS_UG2 = 1176 * MiB;
constexpr size_t WS_RET = 1196 * MiB;
constexpr size_t WS_S5S = 1260 * MiB;
constexpr size_t WS_YB = 1268 * MiB;
constexpr size_t WS_RKV = 1284 * MiB;
constexpr size_t WS_RST = 1316 * MiB;
constexpr size_t WS_MIX = 1332 * MiB;
constexpr size_t WS_YPRE = 1396 * MiB;
constexpr size_t WS_X1 = 1524 * MiB;
constexpr size_t WS_XB = 1652 * MiB;
constexpr size_t WS_LIST = 1780 * MiB;
constexpr size_t WS_TOKI = 1784 * MiB;
constexpr size_t WS_GATE = 1785 * MiB;
constexpr size_t WS_A2 = 1786 * MiB;
constexpr size_t WS_YS = 2058 * MiB;
constexpr size_t WS_S5S4 = 2330 * MiB;
constexpr size_t WS_END = 2362 * MiB;

constexpr int CW_TMO = 0, CW_BAR = 1024, CW_CONV = 4608, CW_GCNT = 8192;

constexpr int RING_BYTES = 131072;
constexpr int LDSCTL_OFF = RING_BYTES, MISC_OFF = LDSCTL_OFF + 320, TAB_OFF = LDSCTL_OFF + 512;
constexpr int LDS_BYTES = 147456;
constexpr int NWAVES = 8, NTHR = 512;

#define RLX_AGENT __ATOMIC_RELAXED, __HIP_MEMORY_SCOPE_AGENT
__device__ __forceinline__ unsigned pk2(float lo, float hi) { f32x2 v = {lo, hi}; bf16x2_t b = __builtin_convertvector(v, bf16x2_t); return __builtin_bit_cast(unsigned, b); }
__device__ __forceinline__ float bf2f(unsigned short u) { return __uint_as_float(((unsigned)u) << 16); }
__device__ __forceinline__ float bflo(unsigned u) { return __uint_as_float(u << 16); }
__device__ __forceinline__ float bfhi(unsigned u) { return __uint_as_float(u & 0xffff0000u); }
template <int CTRL> __device__ __forceinline__ float dppadd(float v) { return v + __builtin_bit_cast(float, __builtin_amdgcn_update_dpp(0, __builtin_bit_cast(int, v), CTRL, 0xF, 0xF, true)); }
__device__ __forceinline__ float swap16_add(float v) { float w = v; asm volatile("v_nop\n\tv_nop\n\tv_permlane16_swap_b32 %0, %1\n\tv_nop\n\tv_nop" : "+v"(v), "+v"(w)); return v + w; }
__device__ __forceinline__ float swap32_add(float v) { float w = v; asm volatile("v_nop\n\tv_nop\n\tv_permlane32_swap_b32 %0, %1\n\tv_nop\n\tv_nop" : "+v"(v), "+v"(w)); return v + w; }
__device__ __forceinline__ float swap32_max(float v) { float w = v; asm volatile("v_nop\n\tv_nop\n\tv_permlane32_swap_b32 %0, %1\n\tv_nop\n\tv_nop" : "+v"(v), "+v"(w)); return fmaxf(v, w); }
__device__ __forceinline__ float half_sum(float v) {
    v = dppadd<0xB1>(v); v = dppadd<0x4E>(v); v = dppadd<0x141>(v); v = dppadd<0x140>(v); return swap16_add(v);
}
__device__ __forceinline__ float wave_sum(float v) { return swap32_add(half_sum(v)); }
__device__ __forceinline__ float fexp2(float x) { return __builtin_amdgcn_exp2f(x); }
__device__ __forceinline__ float frcp(float x) { return __builtin_amdgcn_rcpf(x); }
__device__ __forceinline__ float sigmoidf_(float x) { return frcp(1.0f + fexp2(-x * LOG2E)); }
__device__ __forceinline__ int otid() { int t = threadIdx.x; asm volatile("" : "+v"(t)); return t; }
__device__ __forceinline__ int crow(int r, int hi) { return (r & 3) + 8 * (r >> 2) + 4 * hi; }
__device__ __forceinline__ s16x4 vtr(const LAS char* p) { return __builtin_bit_cast(s16x4, __builtin_amdgcn_ds_read_tr16_b64_v4i16((LAS s16x4*)p)); }
__device__ __forceinline__ bf16x8 cat8(s16x4 a, s16x4 b) { return (bf16x8){a[0], a[1], a[2], a[3], b[0], b[1], b[2], b[3]}; }
__device__ __forceinline__ bf16x8 pack8(float a0, float a1, float a2, float a3, float a4, float a5, float a6, float a7) {
    u32x4 w = {pk2(a0, a1), pk2(a2, a3), pk2(a4, a5), pk2(a6, a7)}; return __builtin_bit_cast(bf16x8, w);
}
__device__ __forceinline__ u32x4 pack8u(f32x4 a, f32x4 b) { return (u32x4){pk2(a[0], a[1]), pk2(a[2], a[3]), pk2(b[0], b[1]), pk2(b[2], b[3])}; }

#define XB_TMO      128
#define XB_XCNT(j)  (256  + 64 * (j))
#define XB_XSUB(j)  (1280 + 64 * (j))
#define XB_XGEN(j)  (2304 + 64 * (j))
#define XB_TOP      3328
#define XB_TOPGEN   3392
#define XCD_BAR_WORDS 3456
#define XB_SPIN_CAP (1u << 22)
__device__ __forceinline__ unsigned xb_ld(unsigned* p)              { return __hip_atomic_load(p, __ATOMIC_RELAXED, __HIP_MEMORY_SCOPE_AGENT); }
__device__ __forceinline__ unsigned xb_add(unsigned* p, unsigned v) { return __hip_atomic_fetch_add(p, v, __ATOMIC_RELAXED, __HIP_MEMORY_SCOPE_AGENT); }
__device__ __forceinline__ unsigned xb_xcc_id() { return (unsigned)__builtin_amdgcn_s_getreg((3 << 11) | 20) & 0xFu; }
#define XB_SPIN(cond, bar) do { unsigned _sp = 0; while (cond) { __builtin_amdgcn_s_sleep(1); \
    if ((++_sp & 255u) == 0u) { if (xb_ld(&(bar)[XB_TMO])) break; if (_sp > XB_SPIN_CAP) { atomicAdd(&(bar)[XB_TMO], 1u); break; } } } } while (0)
struct XcdBarrier { unsigned* bar; unsigned x; volatile LAS unsigned* st; };
__device__ __forceinline__ XcdBarrier xcd_barrier_post(unsigned* bar, volatile LAS unsigned* st) {
    XcdBarrier b; b.bar = bar; b.x = xb_xcc_id(); b.st = st;
    if (threadIdx.x == 0) (void)xb_add(&bar[XB_XCNT(b.x)], 1u);
    return b;
}
__device__ __forceinline__ void xcd_barrier_complete(unsigned* bar, unsigned x, unsigned& nloc, unsigned& nx) {
    const unsigned G = gridDim.x * gridDim.y * gridDim.z;
    unsigned sum, cnt, mine, sp = 0u;
    for (;;) {
        sum = 0u; cnt = 0u; mine = 0u;
#pragma unroll
        for (unsigned j = 0; j < 16; ++j) { const unsigned c = xb_ld(&bar[XB_XCNT(j)]); sum += c; cnt += (c > 0u) ? 1u : 0u; mine = (j == x) ? c : mine; }
        if (sum == G) break;
        __builtin_amdgcn_s_sleep(1);
        if ((++sp & 255u) == 0u) { if (xb_ld(&bar[XB_TMO])) break; if (sp > XB_SPIN_CAP) { atomicAdd(&bar[XB_TMO], 1u); break; } }
    }
    nloc = mine > 0u ? mine : 1u; nx = cnt > 0u ? cnt : 1u;
}
__device__ __forceinline__ void xcd_barrier(const XcdBarrier& b) {
    asm volatile("s_waitcnt vmcnt(0)" ::: "memory");
    __syncthreads();
    if (threadIdx.x == 0) {
        unsigned* bar = b.bar;
        __builtin_amdgcn_s_waitcnt(0);
        unsigned nloc = b.st[0], nx = b.st[1];
        if (nloc == 0u) { xcd_barrier_complete(bar, b.x, nloc, nx); b.st[0] = nloc; b.st[1] = nx; }
        const unsigned old = xb_add(&bar[XB_XSUB(b.x)], 1u);
        const unsigned gen = old / nloc;
        if (old + 1u == (gen + 1u) * nloc) {
            __builtin_amdgcn_fence(__ATOMIC_RELEASE, "agent");
            asm volatile("s_waitcnt vmcnt(0)" ::: "memory");
            const unsigned og = xb_add(&bar[XB_TOP], 1u);
            const unsigned tg = og / nx;
            if (og + 1u == (tg + 1u) * nx) xb_add(&bar[XB_TOPGEN], 1u);
            else XB_SPIN(xb_ld(&bar[XB_TOPGEN]) == tg, bar);
            __builtin_amdgcn_fence(__ATOMIC_ACQUIRE, "agent");
            xb_add(&bar[XB_XGEN(b.x)], 1u);
            asm volatile("s_waitcnt vmcnt(0)" ::: "memory");
        } else {
            XB_SPIN(xb_ld(&bar[XB_XGEN(b.x)]) == gen, bar);
            __builtin_amdgcn_fence(__ATOMIC_ACQUIRE, "agent");
            asm volatile("s_waitcnt vmcnt(0)" ::: "memory");
        }
    }
    __syncthreads();
}

namespace pg8 {
constexpr int BM = 256, BK = 64, HALF = 128, HTB = HALF * BK * 2, STAGE_BYTES = 8 * HTB, NXCD = 8, WGM = 8;
__device__ __forceinline__ int lds_byte(int r, int c) { const int st = (r >> 4) * 2 + (c >> 5), rr = r & 15, cc = c & 31, ob = rr * 64 + cc * 2; return st * 1024 + (ob ^ (((ob >> 9) & 1) << 5)); }
__device__ __forceinline__ void stage_rc(int b, int& R, int& C) { const int st = b / 1024, sb = b % 1024, swz = sb ^ (((sb >> 9) & 1) << 5); R = (st >> 1) * 16 + swz / 64; C = (st & 1) * 32 + (swz % 64) / 2; }
__device__ __forceinline__ int perm32(int rho) { const int n = rho >> 4, i = rho & 15; return 8 * (i >> 2) + 4 * n + (i & 3); }
struct Unit { int pm, pn, g; };

__device__ __forceinline__ bool static_order(int i, int G, int c, int nM, int nN, int& pm, int& pn) {
    const int nwg = nM * nN; const long L = (long)i * G + c; if (L >= nwg) return false;
    int wgid = (int)L; { const int q = nwg / NXCD, r = nwg % NXCD, xcd = wgid % NXCD, off = wgid / NXCD; wgid = (xcd < r ? xcd * (q + 1) : r * (q + 1) + (xcd - r) * q) + off; }
    const int nig = WGM * nN, gid = wgid / nig, fm = gid * WGM, gsz = (nM - fm) < WGM ? (nM - fm) : WGM;
    pm = fm + ((wgid % nig) % gsz); pn = (wgid % nig) / gsz; return true;
}

template <class Epi, class Sched, bool GATHER>
__device__ __forceinline__ void gemm_phase(LAS unsigned char* lds, const int K, const int lda, const int ldb, const Sched& S, const Epi& E) {
    const int tid = otid(), wid = __builtin_amdgcn_readfirstlane(tid >> 6), lane = tid & 63, wr = wid >> 2, wc = wid & 3, fr = lane & 15, fq = lane >> 4;
    const int nt = K / BK;
    int Rr[2], Cc[2];
    unsigned voffB[2], vAc[2][2];
#pragma unroll
    for (int i = 0; i < 2; ++i) { int R, C; stage_rc(tid * 16 + i * 8192, R, C); Rr[i] = R; Cc[i] = C; const int Rb = (R & ~31) + perm32(R & 31);
        voffB[i] = (unsigned)(Rb * ldb + C) * 2u;
#pragma unroll
        for (int h = 0; h < 2; ++h) vAc[h][i] = (unsigned)((GATHER ? 0 : R) * lda + C) * 2u; }
    const size_t kstep = (size_t)(BK * 2);
    const size_t hstepB = (size_t)HALF * ldb * 2;
    const size_t hstepA = GATHER ? (size_t)0 : (size_t)HALF * lda * 2;
    const unsigned ldsw = (unsigned)wid * 1024u;
    const int aoff = lds_byte(wr * 64 + fr, fq * 8), boff = lds_byte(wc * 32 + fr, fq * 8);
    LAS int* rowtab = (LAS int*)(lds + TAB_OFF + 2048);
#define PG8_SA(b, h) (((b) * 2 + (h)) * HTB)
#define PG8_SB(b, h) ((4 + (b) * 2 + (h)) * HTB)
#define PG8_STAGE(bufoff, gbase, v0, v1) do { \
        __builtin_amdgcn_global_load_lds((const unsigned*)((const char*)(gbase) + (v0)), (LAS unsigned*)(lds + (bufoff) + ldsw), 16, 0, 0); \
        __builtin_amdgcn_global_load_lds((const unsigned*)((const char*)(gbase) + (v1)), (LAS unsigned*)(lds + (bufoff) + ldsw + 8192), 16, 0, 0); } while (0)
#define PG8_STAGEB(bufoff, gbase) PG8_STAGE(bufoff, gbase, voffB[0], voffB[1])
#define PG8_LDA(dst, b, h) do { _Pragma("unroll") for (int m = 0; m < 4; ++m) _Pragma("unroll") for (int k = 0; k < 2; ++k) dst[m][k] = *(const LAS bf16x8*)(lds + PG8_SA(b, h) + aoff + m * 2048 + k * 1024); } while (0)
#define PG8_LDB(dst, b, h) do { _Pragma("unroll") for (int n = 0; n < 2; ++n) _Pragma("unroll") for (int k = 0; k < 2; ++k) dst[n][k] = *(const LAS bf16x8*)(lds + PG8_SB(b, h) + boff + n * 2048 + k * 1024); } while (0)
#define PG8_MMA(ai, bj, At, Bt) do { __builtin_amdgcn_s_setprio(1); _Pragma("unroll") for (int m = 0; m < 4; ++m) _Pragma("unroll") for (int n = 0; n < 2; ++n) _Pragma("unroll") for (int k = 0; k < 2; ++k) \
        acc[ai][bj][m][n] = __builtin_amdgcn_mfma_f32_16x16x32_bf16(Bt[n][k], At[m][k], acc[ai][bj][m][n], 0, 0, 0); __builtin_amdgcn_s_setprio(0); } while (0)
#define PG8_WAIT_V(n) asm volatile("s_waitcnt vmcnt(" #n ")" ::: "memory")
#define PG8_WAIT_L(n) asm volatile("s_waitcnt lgkmcnt(" #n ")" ::: "memory")
#define PG8_BAR __builtin_amdgcn_s_barrier()
#define PG8_SCHED __builtin_amdgcn_sched_barrier(0)
    Unit cur, nxt; int ui = 0;
    if (!S.next(0, cur)) return;
    f32x4 acc[2][2][4][2];
#pragma unroll
    for (int a = 0; a < 2; ++a)
#pragma unroll
        for (int b = 0; b < 2; ++b)
#pragma unroll
            for (int m = 0; m < 4; ++m)
#pragma unroll
                for (int n = 0; n < 2; ++n) acc[a][b][m][n] = (f32x4){0.f, 0.f, 0.f, 0.f};
    bf16x8 At[4][2], B0[2][2], B1[2][2];
    const char* cA = S.a_base(cur); const char* cB = S.b_base(cur);
    if constexpr (GATHER) {
        if (tid < 256) rowtab[tid] = S.a_row(cur, tid);
        PG8_WAIT_V(0); PG8_WAIT_L(0); PG8_BAR;
#pragma unroll
        for (int h = 0; h < 2; ++h)
#pragma unroll
            for (int i = 0; i < 2; ++i) vAc[h][i] = (unsigned)(rowtab[h * HALF + Rr[i]] * lda + Cc[i]) * 2u;
    }
    PG8_STAGEB(PG8_SB(0, 0), cB); PG8_STAGEB(PG8_SB(0, 1), cB + hstepB); PG8_STAGE(PG8_SA(0, 0), cA, vAc[0][0], vAc[0][1]); PG8_STAGE(PG8_SA(0, 1), cA + hstepA, vAc[1][0], vAc[1][1]);
    if (wr == 1) PG8_BAR;
    PG8_WAIT_V(2); PG8_BAR;
    PG8_STAGEB(PG8_SB(1, 0), cB + kstep); PG8_STAGE(PG8_SA(1, 0), cA + kstep, vAc[0][0], vAc[0][1]); PG8_STAGEB(PG8_SB(1, 1), cB + hstepB + kstep);
    PG8_WAIT_V(6); PG8_BAR;
    for (;;) {
        const bool has_next = S.next(ui + 1, nxt);
        const char* nA = has_next ? S.a_base(nxt) : cA; const char* nB = has_next ? S.b_base(nxt) : cB;
        if constexpr (GATHER) {
            if (tid < 256) rowtab[((ui + 1) & 1) * 256 + tid] = has_next ? S.a_row(nxt, tid) : 0;
            PG8_WAIT_V(0);
        }
#pragma unroll 1
        for (int t = 0; t < nt; t += 2) {
            const bool last = (t == nt - 2);
            const char* a1 = cA + (size_t)(t + 1) * kstep;
            const char* a2 = last ? nA : cA + (size_t)(t + 2) * kstep; const char* b2 = last ? nB : cB + (size_t)(t + 2) * kstep;
            const char* a3 = a2 + kstep; const char* b3 = b2 + kstep;
            unsigned v2[2][2];
#pragma unroll
            for (int h = 0; h < 2; ++h)
#pragma unroll
                for (int i = 0; i < 2; ++i) v2[h][i] = vAc[h][i];
            if constexpr (GATHER) { if (last && has_next) {
#pragma unroll
                for (int h = 0; h < 2; ++h)
#pragma unroll
                    for (int i = 0; i < 2; ++i) v2[h][i] = (unsigned)(rowtab[((ui + 1) & 1) * 256 + h * HALF + Rr[i]] * lda + Cc[i]) * 2u; } }
            PG8_LDB(B0, 0, 0); PG8_LDB(B1, 0, 1); PG8_SCHED; PG8_LDA(At, 0, 0); PG8_STAGE(PG8_SA(1, 1), a1 + hstepA, vAc[1][0], vAc[1][1]);
            PG8_WAIT_V(8); PG8_WAIT_L(0); PG8_BAR; PG8_MMA(0, 0, At, B0); PG8_MMA(0, 1, At, B1); PG8_BAR; PG8_SCHED;
            PG8_LDA(At, 0, 1); PG8_STAGEB(PG8_SB(0, 0), b2); PG8_STAGEB(PG8_SB(0, 1), b2 + hstepB); PG8_STAGE(PG8_SA(0, 0), a2, v2[0][0], v2[0][1]);
            PG8_WAIT_V(8); PG8_WAIT_L(0); PG8_BAR; PG8_MMA(1, 0, At, B0); PG8_MMA(1, 1, At, B1); PG8_BAR; PG8_SCHED;
            PG8_LDB(B0, 1, 0); PG8_LDB(B1, 1, 1); PG8_SCHED; PG8_LDA(At, 1, 0); PG8_STAGE(PG8_SA(0, 1), a2 + hstepA, v2[1][0], v2[1][1]);
            PG8_WAIT_V(8); PG8_WAIT_L(0); PG8_BAR; PG8_MMA(0, 0, At, B0); PG8_MMA(0, 1, At, B1); PG8_BAR; PG8_SCHED;
            PG8_LDA(At, 1, 1); PG8_STAGEB(PG8_SB(1, 0), b3); PG8_STAGEB(PG8_SB(1, 1), b3 + hstepB); PG8_STAGE(PG8_SA(1, 0), a3, v2[0][0], v2[0][1]);
            PG8_WAIT_V(8); PG8_WAIT_L(0); PG8_BAR; PG8_MMA(1, 0, At, B0); PG8_MMA(1, 1, At, B1); PG8_BAR; PG8_SCHED;
        }
        if (wr == 0) PG8_BAR;
        { int efr = fr, efq = fq; asm volatile("" : "+v"(efr), "+v"(efq)); E(acc, cur, wr, wc, efr, efq); }
        if (!has_next) break;
#pragma unroll
        for (int a = 0; a < 2; ++a)
#pragma unroll
            for (int b = 0; b < 2; ++b)
#pragma unroll
                for (int m = 0; m < 4; ++m)
#pragma unroll
                    for (int n = 0; n < 2; ++n) acc[a][b][m][n] = (f32x4){0.f, 0.f, 0.f, 0.f};
        cur = nxt; cA = nA; cB = nB; ++ui;
        if constexpr (GATHER) {
#pragma unroll
            for (int h = 0; h < 2; ++h)
#pragma unroll
                for (int i = 0; i < 2; ++i) vAc[h][i] = (unsigned)(rowtab[(ui & 1) * 256 + h * HALF + Rr[i]] * lda + Cc[i]) * 2u;
        }
        if (wr == 1) PG8_BAR;
    }
    PG8_WAIT_V(0);
    PG8_BAR;
#undef PG8_SA
#undef PG8_SB
#undef PG8_STAGE
#undef PG8_STAGEB
#undef PG8_LDA
#undef PG8_LDB
#undef PG8_MMA
#undef PG8_WAIT_V
#undef PG8_WAIT_L
#undef PG8_BAR
#undef PG8_SCHED
}
}
using pg8::Unit;

struct DenseSched {
    int nM, nN, G, c; const char* A; const char* Bt; size_t atile, btile;
    __device__ __forceinline__ bool next(int i, Unit& u) const { u.g = 0; return pg8::static_order(i, G, c, nM, nN, u.pm, u.pn); }
    __device__ __forceinline__ const char* a_base(const Unit& u) const { return A + (size_t)u.pm * atile; }
    __device__ __forceinline__ const char* b_base(const Unit& u) const { return Bt + (size_t)u.pn * btile; }
    __device__ __forceinline__ int a_row(const Unit&, int) const { return 0; }
};
struct GroupSched {
    int nN, G, c; const char* A; const char* Bt; size_t agroup, bgroup, atile, btile;
    __device__ __forceinline__ bool next(int i, Unit& u) const { const long L = (long)i * G + c; if (c < 0 || L >= 16 * 2 * nN) return false; const int per = 2 * nN; u.g = (int)L / per; const int r = (int)L % per; u.pm = r % 2; u.pn = r / 2; return true; }
    __device__ __forceinline__ const char* a_base(const Unit& u) const { return A + (size_t)u.g * agroup + (size_t)u.pm * atile; }
    __device__ __forceinline__ const char* b_base(const Unit& u) const { return Bt + (size_t)u.g * bgroup + (size_t)u.pn * btile; }
    __device__ __forceinline__ int a_row(const Unit&, int) const { return 0; }
};
struct S5G1Sched {
    int G, c; const char* A; const char* Bt;
    __device__ __forceinline__ bool next(int i, Unit& u) const { const long L = (long)i * G + c; if (L >= 128) return false; u.g = (int)L >> 3; u.pm = (int)L & 1; u.pn = ((int)L >> 1) & 3; return true; }
    __device__ __forceinline__ const char* a_base(const Unit& u) const { return A + ((size_t)u.g * 512 + u.pm * 256) * 1280 * 2 + (size_t)u.pn * 512; }
    __device__ __forceinline__ const char* b_base(const Unit& u) const { return Bt + (size_t)u.g * 256 * 1024 * 2 + (size_t)u.pn * 512; }
    __device__ __forceinline__ int a_row(const Unit&, int) const { return 0; }
};
struct MoeSched {
    int nM, nN, G, c; const char* A; const char* W; size_t wexp, atile, btile;
    const LAS int* cnt; const LAS int* tstart; const LAS unsigned char* tile_e; const int* list;
    __device__ __forceinline__ bool next(int i, Unit& u) const { const bool ok = pg8::static_order(i, G, c, nM, nN, u.pm, u.pn); u.g = ok ? (int)tile_e[u.pm] : 0; return ok; }
    __device__ __forceinline__ const char* a_base(const Unit& u) const { return A + (size_t)u.pm * atile; }
    __device__ __forceinline__ const char* b_base(const Unit& u) const { return W + (size_t)u.g * wexp + (size_t)u.pn * btile; }
    __device__ __forceinline__ int a_row(const Unit& u, int r) const { const int slot = (u.pm - tstart[u.g]) * 256 + r; return slot < cnt[u.g] ? list[(size_t)u.g * T + slot] : 0; }
};

typedef f32x4 Acc[2][2][4][2];
struct EpiProj {
    bf16 *Qimg, *Kimg, *Vimg, *Ug2, *RET; const float *cosA, *sinA, *cosR, *sinR;
    __device__ __forceinline__ void operator()(const Acc& acc, const Unit& u, int wr, int wc, int fr, int fq) const {
        const int pn = u.pn;
#pragma unroll
        for (int ai = 0; ai < 2; ++ai)
#pragma unroll
            for (int m = 0; m < 4; ++m) {
                const int row = u.pm * 256 + ai * 128 + wr * 64 + m * 16 + fr; const int b = row >> 13, t = row & 8191;
                if (pn < 4 || pn == 7 || pn == 8) {
                    const size_t to = (size_t)row * 32 + 8 * fq;
                    const float* ct = (pn < 4 ? cosA : cosR) + to; const float* st = (pn < 4 ? sinA : sinR) + to;
                    const f32x4 c0 = *(const f32x4*)ct, c1 = *(const f32x4*)(ct + 4), s0 = *(const f32x4*)st, s1 = *(const f32x4*)(st + 4);
                    const f32x4 xa0 = acc[ai][0][m][0], xa1 = acc[ai][0][m][1], xb0 = acc[ai][1][m][0], xb1 = acc[ai][1][m][1];
                    const float sc = (pn < 2) ? C2 : (pn == 8 ? 0.125f : 1.0f);
                    const f32x4 o10 = (xa0 * c0 - xb0 * s0) * sc, o11 = (xa1 * c1 - xb1 * s1) * sc, o20 = (xb0 * c0 + xa0 * s0) * sc, o21 = (xb1 * c1 + xa1 * s1) * sc;
                    const u32x4 w1 = pack8u(o10, o11), w2 = pack8u(o20, o21);
                    if (pn < 2) { const int hc = 4 * pn + wc; bf16* p = Qimg + ((size_t)(b * 8 + hc) * 8192 + t) * 64 + 8 * fq; *(u32x4*)p = w1; *(u32x4*)(p + 32) = w2; }
                    else if (pn < 4) { const int hc = 4 * (pn - 2) + wc; bf16* p = Kimg + ((size_t)((b * 8 + hc) * 128 + (t >> 6)) * 8 + fq) * 512 + (t & 63) * 8; *(u32x4*)p = w1; *(u32x4*)(p + 4 * 512) = w2; }
                    else { bf16* p = RET + (size_t)row * 1024 + (pn - 7) * 256 + 64 * wc + 8 * fq; *(u32x4*)p = w1; *(u32x4*)(p + 32) = w2; }
                } else {
#pragma unroll
                    for (int bj = 0; bj < 2; ++bj) {
                        const u32x4 w = pack8u(acc[ai][bj][m][0], acc[ai][bj][m][1]);
                        bf16* p;
                        if (pn < 6) { const int h = 2 * (pn - 4) + bj; p = Vimg + ((size_t)((b * 4 + h) * 128 + (t >> 6)) * 4 + wc) * 2048 + (t & 63) * 32 + 8 * fq; }
                        else if (pn == 6) { const int g = 8 * bj + 2 * wc + (fq >> 1); p = Ug2 + ((size_t)(g * 512 + b * 128 + (t >> 6))) * 1280 + (t & 63) * 16 + 8 * (fq & 1); }
                        else { p = RET + (size_t)row * 1024 + 512 + (pn - 9) * 256 + 128 * bj + 32 * wc + 8 * fq; }
                        *(u32x4*)p = w;
                    }
                }
                asm volatile("" ::: "memory");
            }
    }
};
struct EpiS5S {
    float* S;
    __device__ __forceinline__ void operator()(const Acc& acc, const Unit& u, int wr, int wc, int fr, int fq) const {
#pragma unroll
        for (int ai = 0; ai < 2; ++ai)
#pragma unroll
            for (int m = 0; m < 4; ++m) { float* rowp = S + (size_t)u.pn * (16 * 512 * 256) + ((size_t)u.g * 512 + u.pm * 256 + ai * 128 + wr * 64 + m * 16 + fr) * 256 + wc * 32 + 8 * fq;
#pragma unroll
                for (int bj = 0; bj < 2; ++bj) { *(f32x4*)(rowp + bj * 128) = acc[ai][bj][m][0]; *(f32x4*)(rowp + bj * 128 + 4) = acc[ai][bj][m][1]; } }
    }
};
struct EpiS5Y {
    bf16* Yb; const bf16* Ug2; const float* dskip;
    __device__ __forceinline__ void operator()(const Acc& acc, const Unit& u, int wr, int wc, int fr, int fq) const {
#pragma unroll
        for (int ai = 0; ai < 2; ++ai)
#pragma unroll
            for (int m = 0; m < 4; ++m) { const int bc = u.pm * 256 + ai * 128 + wr * 64 + m * 16 + fr;
#pragma unroll
                for (int bj = 0; bj < 2; ++bj) { const int col = u.pn * 256 + bj * 128 + wc * 32 + 8 * fq; const int j = col >> 4, n0 = col & 15;
                    const int tok = bc * 64 + j; const int ch = u.g * 16 + n0;
                    const u32x4 uu = *(const u32x4*)(Ug2 + ((size_t)u.g * 512 + bc) * 1280 + col);
                    const f32x4 d0 = *(const f32x4*)(dskip + ch), d1 = *(const f32x4*)(dskip + ch + 4);
                    float y[8] = {acc[ai][bj][m][0][0] + d0[0] * bflo(uu[0]), acc[ai][bj][m][0][1] + d0[1] * bfhi(uu[0]), acc[ai][bj][m][0][2] + d0[2] * bflo(uu[1]), acc[ai][bj][m][0][3] + d0[3] * bfhi(uu[1]),
                                  acc[ai][bj][m][1][0] + d1[0] * bflo(uu[2]), acc[ai][bj][m][1][1] + d1[1] * bfhi(uu[2]), acc[ai][bj][m][1][2] + d1[2] * bflo(uu[3]), acc[ai][bj][m][1][3] + d1[3] * bfhi(uu[3])};
#pragma unroll
                    for (int e = 0; e < 8; ++e) { const float v = y[e]; const float uarg = 1.5957691216057308f * (v + 0.044715f * v * v * v); y[e] = v * sigmoidf_(uarg); }
                    *(u32x4*)(Yb + (size_t)tok * 256 + ch) = (u32x4){pk2(y[0], y[1]), pk2(y[2], y[3]), pk2(y[4], y[5]), pk2(y[6], y[7])};
                    asm volatile("" ::: "memory");
                } }
    }
};
struct EpiGlu {
    bf16* MIX; const float* bias;
    __device__ __forceinline__ void operator()(const Acc& acc, const Unit& u, int wr, int wc, int fr, int fq) const {
        const int col = u.pn * 128 + wc * 32 + 8 * fq;
#pragma unroll
        for (int ai = 0; ai < 2; ++ai)
#pragma unroll
            for (int m = 0; m < 4; ++m) { const int row = u.pm * 256 + ai * 128 + wr * 64 + m * 16 + fr;
                const f32x4 ba0 = *(const f32x4*)(bias + col), ba1 = *(const f32x4*)(bias + col + 4), bb0 = *(const f32x4*)(bias + 256 + col), bb1 = *(const f32x4*)(bias + 256 + col + 4);
                const f32x4 a0 = acc[ai][0][m][0] + ba0, a1 = acc[ai][0][m][1] + ba1, g0 = acc[ai][1][m][0] + bb0, g1 = acc[ai][1][m][1] + bb1;
                f32x4 o0, o1;
#pragma unroll
                for (int e = 0; e < 4; ++e) { o0[e] = a0[e] * sigmoidf_(g0[e]); o1[e] = a1[e] * sigmoidf_(g1[e]); }
                *(u32x4*)(MIX + (size_t)row * 1024 + 512 + col) = pack8u(o0, o1); asm volatile("" ::: "memory"); }
    }
};
struct EpiOut {
    bf16* YM; const float* mod;
    __device__ __forceinline__ void operator()(const Acc& acc, const Unit& u, int wr, int wc, int fr, int fq) const {
        const int b = (u.pm * 256) >> 13;
#pragma unroll
        for (int bj = 0; bj < 2; ++bj) { const int col = u.pn * 256 + bj * 128 + wc * 32 + 8 * fq; const float* gp = mod + (size_t)b * 6144 + 2048 + col;
            const f32x4 g0 = *(const f32x4*)gp + 1.0f, g1 = *(const f32x4*)(gp + 4) + 1.0f;
#pragma unroll
            for (int ai = 0; ai < 2; ++ai)
#pragma unroll
                for (int m = 0; m < 4; ++m) { const int row = u.pm * 256 + ai * 128 + wr * 64 + m * 16 + fr;
                    *(u32x4*)(YM + (size_t)row * 1024 + col) = pack8u(g0 * acc[ai][bj][m][0], g1 * acc[ai][bj][m][1]); } }
    }
};
struct EpiMoe1 {
    bf16* A2; const float* b1;
    __device__ __forceinline__ void operator()(const Acc& acc, const Unit& u, int wr, int wc, int fr, int fq) const {
        const int j0 = u.pn * 128 + wc * 32 + 8 * fq;
        const float* bp = b1 + (size_t)u.g * 2048 + 2 * j0;
#pragma unroll
        for (int ai = 0; ai < 2; ++ai)
#pragma unroll
            for (int m = 0; m < 4; ++m) { const size_t slot = (size_t)u.pm * 256 + ai * 128 + wr * 64 + m * 16 + fr;
                const f32x4 q0 = *(const f32x4*)bp, q1 = *(const f32x4*)(bp + 4), q2 = *(const f32x4*)(bp + 8), q3 = *(const f32x4*)(bp + 12);
                const float bg[8] = {q0[0], q0[2], q1[0], q1[2], q2[0], q2[2], q3[0], q3[2]}, bl[8] = {q0[1], q0[3], q1[1], q1[3], q2[1], q2[3], q3[1], q3[3]};
                float o[8];
#pragma unroll
                for (int e = 0; e < 8; ++e) { float zg = acc[ai][0][m][e >> 2][e & 3] + bg[e], zl = acc[ai][1][m][e >> 2][e & 3] + bl[e];
                    zg = fminf(zg, 7.0f); zl = fminf(fmaxf(zl, -7.0f), 7.0f); o[e] = zg * sigmoidf_(1.702f * zg) * (zl + 1.0f); }
                *(u32x4*)(A2 + slot * 1024 + j0) = (u32x4){pk2(o[0], o[1]), pk2(o[2], o[3]), pk2(o[4], o[5]), pk2(o[6], o[7])}; asm volatile("" ::: "memory"); }
    }
};
struct EpiMoe2 {
    bf16* YS; const float* b2;
    __device__ __forceinline__ void operator()(const Acc& acc, const Unit& u, int wr, int wc, int fr, int fq) const {
#pragma unroll
        for (int bj = 0; bj < 2; ++bj) { const int col = u.pn * 256 + bj * 128 + wc * 32 + 8 * fq; const float* bp = b2 + (size_t)u.g * 1024 + col;
            const f32x4 c0 = *(const f32x4*)bp, c1 = *(const f32x4*)(bp + 4);
#pragma unroll
            for (int ai = 0; ai < 2; ++ai)
#pragma unroll
                for (int m = 0; m < 4; ++m) { const size_t slot = (size_t)u.pm * 256 + ai * 128 + wr * 64 + m * 16 + fr;
                    *(u32x4*)(YS + slot * 1024 + col) = pack8u(acc[ai][bj][m][0] + c0, acc[ai][bj][m][1] + c1); } asm volatile("" ::: "memory"); }
    }
};

struct Args {
    const void* in[30]; float* out; unsigned char* ws;
    double invfA[32], invfR[32];
    float lam_init[4];
    float lg2f[4], lg2b[4];
    int ph_lo, ph_hi;
};

template <int PERM>
__device__ __forceinline__ int perm_row(int o) {
    if (PERM == 1) { const int pn = o >> 8; if (pn < 4 || pn == 7 || pn == 8) { const int x = o & 255; return (o & ~255) + 128 * ((x >> 5) & 1) + 32 * (x >> 6) + (x & 31); } return o; }
    if (PERM == 2) return (o >> 8) * 256 + 128 * (o & 1) + ((o >> 1) & 127);
    if (PERM == 3) return 256 * ((o >> 7) & 1) + 128 * (o >> 8) + (o & 127);
    return o;
}
template <int PERM>
__device__ __forceinline__ void transpose_item(const float* W, int K, int N, bf16* WT, LAS float* scr, int item, int lane) {
    const int nblk = N / 32, kb = item / nblk, nb = item % nblk, k0 = 64 * kb, n0 = 32 * nb;
#pragma unroll 8
    for (int i = 0; i < 32; ++i) { const int kk = 2 * i + (lane >> 5); scr[kk * 33 + (lane & 31)] = W[(size_t)(k0 + kk) * N + n0 + (lane & 31)]; }
    asm volatile("s_waitcnt lgkmcnt(0)" ::: "memory");
    const int c = lane & 7;
#pragma unroll
    for (int j = 0; j < 4; ++j) { const int n = (lane >> 3) + 8 * j; const LAS float* s = scr + (8 * c) * 33 + n;
        u32x4 o; o.x = pk2(s[0 * 33], s[1 * 33]); o.y = pk2(s[2 * 33], s[3 * 33]); o.z = pk2(s[4 * 33], s[5 * 33]); o.w = pk2(s[6 * 33], s[7 * 33]);
        *(u32x4*)(WT + (size_t)perm_row<PERM>(n0 + n) * K + k0 + 8 * c) = o; }
    asm volatile("s_waitcnt lgkmcnt(0)" ::: "memory");
}
__device__ __forceinline__ void sincos_rev(double ang, float& c, float& s) {
    double rev = ang * 0.15915494309189535; rev -= __builtin_rint(rev); const float r = (float)rev;
    c = __builtin_amdgcn_cosf(r); s = __builtin_amdgcn_sinf(r);
}

__device__ __forceinline__ void row_stats(const f32x4 (&v)[4], float& mean, float& rstd) {
    float s = 0.f;
#pragma unroll
    for (int j = 0; j < 4; ++j) s += (v[j][0] + v[j][1]) + (v[j][2] + v[j][3]);
    mean = wave_sum(s) * (1.f / DM); float q = 0.f;
#pragma unroll
    for (int j = 0; j < 4; ++j) { const f32x4 d = v[j] - mean; q += (d[0] * d[0] + d[1] * d[1]) + (d[2] * d[2] + d[3] * d[3]); }
    rstd = 1.0f / sqrtf(wave_sum(q) * (1.f / DM) + LN_EPS);
}
__device__ __forceinline__ void mod_row_store(const f32x4 (&v)[4], const float* sh, const float* sc, bf16* orow, int lane) {
    float mean, rstd; row_stats(v, mean, rstd);
#pragma unroll
    for (int j = 0; j < 4; ++j) { const int col = 4 * lane + 256 * j; const f32x4 a = *(const f32x4*)(sc + col), b = *(const f32x4*)(sh + col);
        const f32x4 h = (v[j] - mean) * rstd * (a + 1.0f) + b; *(u32x2*)(orow + col) = (u32x2){pk2(h[0], h[1]), pk2(h[2], h[3])}; }
}

__device__ __forceinline__ void swap32x4(float& a0, float& b0, float& a1, float& b1, float& a2, float& b2, float& a3, float& b3) {
    asm volatile("v_nop\n\tv_nop\n\tv_permlane32_swap_b32 %0, %1\n\tv_permlane32_swap_b32 %2, %3\n\tv_permlane32_swap_b32 %4, %5\n\tv_permlane32_swap_b32 %6, %7\n\tv_nop\n\tv_nop"
                 : "+v"(a0), "+v"(b0), "+v"(a1), "+v"(b1), "+v"(a2), "+v"(b2), "+v"(a3), "+v"(b3)); }
__device__ __forceinline__ void swap16x4(float& a0, float& b0, float& a1, float& b1, float& a2, float& b2, float& a3, float& b3) {
    asm volatile("v_nop\n\tv_nop\n\tv_permlane16_swap_b32 %0, %1\n\tv_permlane16_swap_b32 %2, %3\n\tv_permlane16_swap_b32 %4, %5\n\tv_permlane16_swap_b32 %6, %7\n\tv_nop\n\tv_nop"
                 : "+v"(a0), "+v"(b0), "+v"(a1), "+v"(b1), "+v"(a2), "+v"(b2), "+v"(a3), "+v"(b3)); }
template <int CTRL> __device__ __forceinline__ float dppmov(float v) { return __builtin_bit_cast(float, __builtin_amdgcn_update_dpp(0, __builtin_bit_cast(int, v), CTRL, 0xF, 0xF, true)); }
__device__ __forceinline__ float wave_max(float v) {
    v = fmaxf(v, dppmov<0xB1>(v)); v = fmaxf(v, dppmov<0x4E>(v)); v = fmaxf(v, dppmov<0x141>(v)); v = fmaxf(v, dppmov<0x140>(v));
    { float w = v; asm volatile("v_nop\n\tv_nop\n\tv_permlane16_swap_b32 %0, %1\n\tv_nop\n\tv_nop" : "+v"(v), "+v"(w)); v = fmaxf(v, w); }
    return swap32_max(v);
}
struct Top4 { float t0, t1, t2, t3; int i0, i1, i2, i3; };
__device__ __forceinline__ void top4_init(Top4& q) { q.t0 = q.t1 = q.t2 = q.t3 = -INFINITY; q.i0 = q.i1 = q.i2 = q.i3 = 0; }
__device__ __forceinline__ void top4_insert(Top4& q, float x, int e) {
    const bool c3 = x > q.t3; q.t3 = c3 ? x : q.t3; q.i3 = c3 ? e : q.i3;
    const bool c2 = q.t3 > q.t2; { const float a = q.t2, b = q.t3; const int ia = q.i2, ib = q.i3; q.t2 = c2 ? b : a; q.t3 = c2 ? a : b; q.i2 = c2 ? ib : ia; q.i3 = c2 ? ia : ib; }
    const bool c1 = q.t2 > q.t1; { const float a = q.t1, b = q.t2; const int ia = q.i1, ib = q.i2; q.t1 = c1 ? b : a; q.t2 = c1 ? a : b; q.i1 = c1 ? ib : ia; q.i2 = c1 ? ia : ib; }
    const bool c0 = q.t1 > q.t0; { const float a = q.t0, b = q.t1; const int ia = q.i0, ib = q.i1; q.t0 = c0 ? b : a; q.t1 = c0 ? a : b; q.i0 = c0 ? ib : ia; q.i1 = c0 ? ia : ib; }
}

__device__ __forceinline__ void attn_unit(LAS unsigned char* lds, const bf16* Qimg, const bf16* Kimg, const bf16* Vimg, bf16* MIX, const int b, const int h, const int qb,
                                          const float lam, const float* subg, const float outscale) {
    const int tid = otid(), lane = tid & 63, r32 = lane & 31, hi = lane >> 5; const int wid = __builtin_amdgcn_readfirstlane(tid >> 6);
    const int comp = wid & 1, qsub = (wid >> 1) & 3, grp = wid >> 2, hc = 2 * h + comp;
    const bf16* Qw = Qimg + ((size_t)(b * 8 + hc) * 8192 + qb * 128 + qsub * 32 + r32) * 64;
    bf16x8 qr[4];
#pragma unroll
    for (int d0 = 0; d0 < 4; ++d0) qr[d0] = *(const bf16x8*)(Qw + d0 * 16 + hi * 8);
    asm volatile("s_waitcnt vmcnt(0)" ::: "memory");
    const bf16* K1 = Kimg + (size_t)((b * 8 + 2 * h) * 128) * 4096 + tid * 8;
    const bf16* K2 = Kimg + (size_t)((b * 8 + 2 * h + 1) * 128) * 4096 + tid * 8;
    const bf16* Vg = Vimg + (size_t)((b * 4 + h) * 128) * 8192 + tid * 8;
    LAS float* wsf = (LAS float*)(lds + TAB_OFF) + wid * 64;
    f32x16 o[4];
#pragma unroll
    for (int d = 0; d < 4; ++d) o[d] = (f32x16){};
    float mrow = 0.f, lrow = 0.f;
    const unsigned ldsw = (unsigned)wid * 1024u;
#define ATT_DMA(tt) do { const size_t tt_ = (size_t)(tt); LAS unsigned char* sb_ = lds + ((tt) & 3) * 32768 + ldsw; \
        __builtin_amdgcn_global_load_lds((const unsigned*)(K1 + tt_ * 4096), (LAS unsigned*)(sb_), 16, 0, 0); \
        __builtin_amdgcn_global_load_lds((const unsigned*)(K2 + tt_ * 4096), (LAS unsigned*)(sb_ + 8192), 16, 0, 0); \
        __builtin_amdgcn_global_load_lds((const unsigned*)(Vg + tt_ * 8192), (LAS unsigned*)(sb_ + 16384), 16, 0, 0); \
        __builtin_amdgcn_global_load_lds((const unsigned*)(Vg + tt_ * 8192 + 4096), (LAS unsigned*)(sb_ + 24576), 16, 0, 0); } while (0)
#define ATT_QK(P0, P1, tt) do { const LAS unsigned char* Ks_ = lds + ((tt) & 3) * 32768 + comp * 8192 + hi * 1024 + r32 * 16; \
        { const bf16x8 a0_ = *(const LAS bf16x8*)(Ks_), a1_ = *(const LAS bf16x8*)(Ks_ + 512); \
          P0 = __builtin_amdgcn_mfma_f32_32x32x16_bf16(a0_, qr[0], negm, 0, 0, 0); P1 = __builtin_amdgcn_mfma_f32_32x32x16_bf16(a1_, qr[0], negm, 0, 0, 0); } \
        _Pragma("unroll") for (int d0_ = 1; d0_ < 4; ++d0_) { const bf16x8 a0_ = *(const LAS bf16x8*)(Ks_ + d0_ * 2048), a1_ = *(const LAS bf16x8*)(Ks_ + d0_ * 2048 + 512); \
          P0 = __builtin_amdgcn_mfma_f32_32x32x16_bf16(a0_, qr[d0_], P0, 0, 0, 0); P1 = __builtin_amdgcn_mfma_f32_32x32x16_bf16(a1_, qr[d0_], P1, 0, 0, 0); } } while (0)
    ATT_DMA(0); ATT_DMA(1); ATT_DMA(2);
    asm volatile("s_waitcnt vmcnt(8)" ::: "memory");
    __builtin_amdgcn_s_barrier();
    const int vlane = ((lane & 15) >> 2) * 64 + ((lane >> 4) & 1) * 32 + (lane & 3) * 8 + hi * 256;
    f32x16 p0, p1;
    { const f32x16 negm = (f32x16){}; ATT_QK(p0, p1, 0); }
    asm volatile("s_waitcnt vmcnt(4) lgkmcnt(0)" ::: "memory");
    __builtin_amdgcn_s_barrier();
    if (grp == 1) { __builtin_amdgcn_s_setprio(1); __builtin_amdgcn_s_barrier(); }
    for (int i = 0; i < 128; ++i) {
        float rm, rm2;
        asm("v_max3_f32 %0, %1, %2, %3" : "=v"(rm) : "v"(p0[0]), "v"(p0[1]), "v"(p0[2]));
        asm("v_max3_f32 %0, %1, %2, %3" : "=v"(rm2) : "v"(p1[0]), "v"(p1[1]), "v"(p1[2]));
#pragma unroll
        for (int r = 3; r < 15; r += 2) { asm("v_max3_f32 %0, %1, %2, %3" : "=v"(rm) : "v"(rm), "v"(p0[r]), "v"(p0[r + 1])); asm("v_max3_f32 %0, %1, %2, %3" : "=v"(rm2) : "v"(rm2), "v"(p1[r]), "v"(p1[r + 1])); }
        asm("v_max3_f32 %0, %1, %2, %3" : "=v"(rm) : "v"(rm), "v"(p0[15]), "v"(p1[15]));
        rm = swap32_max(fmaxf(rm, rm2));
        const bool need = (i == 0) || (rm > 6.0f);
        if (__any(need)) {
            const float dl = need ? rm : 0.f;
            mrow += dl;
#pragma unroll
            for (int r = 0; r < 16; ++r) { p0[r] -= dl; p1[r] -= dl; }
            if (i > 0) {
                const float f = fexp2(-dl); lrow *= f;
                if (hi == 0) wsf[r32] = f;
                asm volatile("s_waitcnt lgkmcnt(0)" ::: "memory");
#pragma unroll
                for (int r = 0; r < 16; ++r) { const float fr_ = wsf[crow(r, hi)];
#pragma unroll
                    for (int d = 0; d < 4; ++d) o[d][r] *= fr_; }
            }
        }
        float ls0 = 0.f, ls1 = 0.f;
#pragma unroll
        for (int r = 0; r < 16; ++r) { p0[r] = fexp2(p0[r]); p1[r] = fexp2(p1[r]); ls0 += p0[r]; ls1 += p1[r]; }
        lrow += ls0 + ls1;
        const bf16x8 pa0 = pack8(p0[0], p0[1], p0[2], p0[3], p0[4], p0[5], p0[6], p0[7]), pa1 = pack8(p0[8], p0[9], p0[10], p0[11], p0[12], p0[13], p0[14], p0[15]);
        const bf16x8 pa2 = pack8(p1[0], p1[1], p1[2], p1[3], p1[4], p1[5], p1[6], p1[7]), pa3 = pack8(p1[8], p1[9], p1[10], p1[11], p1[12], p1[13], p1[14], p1[15]);
        bf16x8 kf[4], kg[4];
        const LAS unsigned char* Ks_ = lds + ((i + 1) & 3) * 32768 + comp * 8192 + hi * 1024 + r32 * 16;
        kf[0] = *(const LAS bf16x8*)(Ks_); kf[1] = *(const LAS bf16x8*)(Ks_ + 512); kf[2] = *(const LAS bf16x8*)(Ks_ + 2048); kf[3] = *(const LAS bf16x8*)(Ks_ + 2560);
        asm volatile("s_waitcnt vmcnt(0) lgkmcnt(0)" ::: "memory");
        __builtin_amdgcn_s_barrier();
        __builtin_amdgcn_sched_barrier(0);
        const LAS char* Vs = (const LAS char*)lds + (i & 3) * 32768 + 16384 + vlane;
#define ATT_LDV(dst, d) do { dst[0] = cat8(vtr(Vs + (d) * 4096), vtr(Vs + (d) * 4096 + 512)); dst[1] = cat8(vtr(Vs + (d) * 4096 + 1024), vtr(Vs + (d) * 4096 + 1536)); \
        dst[2] = cat8(vtr(Vs + (d) * 4096 + 2048), vtr(Vs + (d) * 4096 + 2560)); dst[3] = cat8(vtr(Vs + (d) * 4096 + 3072), vtr(Vs + (d) * 4096 + 3584)); } while (0)
#define ATT_PV(d, vv) do { asm volatile("" : "+v"(o[d])); o[d] = __builtin_amdgcn_mfma_f32_32x32x16_bf16(pa0, vv[0], o[d], 0, 0, 0); o[d] = __builtin_amdgcn_mfma_f32_32x32x16_bf16(pa1, vv[1], o[d], 0, 0, 0); \
        o[d] = __builtin_amdgcn_mfma_f32_32x32x16_bf16(pa2, vv[2], o[d], 0, 0, 0); o[d] = __builtin_amdgcn_mfma_f32_32x32x16_bf16(pa3, vv[3], o[d], 0, 0, 0); } while (0)
        bf16x8 va[4], vb[4];
        kg[0] = *(const LAS bf16x8*)(Ks_ + 4096); kg[1] = *(const LAS bf16x8*)(Ks_ + 4608); kg[2] = *(const LAS bf16x8*)(Ks_ + 6144); kg[3] = *(const LAS bf16x8*)(Ks_ + 6656);
        ATT_LDV(va, 0);
        __builtin_amdgcn_sched_barrier(0);
        if (i + 1 < 128) {
            f32x16 negm; { const float nm_ = -mrow;
#pragma unroll
                for (int r = 0; r < 16; ++r) negm[r] = nm_; }
            p0 = __builtin_amdgcn_mfma_f32_32x32x16_bf16(kf[0], qr[0], negm, 0, 0, 0); p1 = __builtin_amdgcn_mfma_f32_32x32x16_bf16(kf[1], qr[0], negm, 0, 0, 0);
            p0 = __builtin_amdgcn_mfma_f32_32x32x16_bf16(kf[2], qr[1], p0, 0, 0, 0); p1 = __builtin_amdgcn_mfma_f32_32x32x16_bf16(kf[3], qr[1], p1, 0, 0, 0);
            asm volatile("s_waitcnt lgkmcnt(8)" ::: "memory"); __builtin_amdgcn_sched_barrier(0);
            p0 = __builtin_amdgcn_mfma_f32_32x32x16_bf16(kg[0], qr[2], p0, 0, 0, 0); p1 = __builtin_amdgcn_mfma_f32_32x32x16_bf16(kg[1], qr[2], p1, 0, 0, 0);
            p0 = __builtin_amdgcn_mfma_f32_32x32x16_bf16(kg[2], qr[3], p0, 0, 0, 0); p1 = __builtin_amdgcn_mfma_f32_32x32x16_bf16(kg[3], qr[3], p1, 0, 0, 0);
        }
        __builtin_amdgcn_sched_barrier(0);
        ATT_LDV(vb, 1);
        asm volatile("s_waitcnt lgkmcnt(8)" ::: "memory"); __builtin_amdgcn_sched_barrier(0);
        ATT_PV(0, va);
        __builtin_amdgcn_sched_barrier(0);
        ATT_LDV(va, 2);
        asm volatile("s_waitcnt lgkmcnt(8)" ::: "memory"); __builtin_amdgcn_sched_barrier(0);
        ATT_PV(1, vb);
        __builtin_amdgcn_sched_barrier(0);
        ATT_LDV(vb, 3);
        asm volatile("s_waitcnt lgkmcnt(8)" ::: "memory"); __builtin_amdgcn_sched_barrier(0);
        ATT_PV(2, va);
        asm volatile("s_waitcnt lgkmcnt(0)" ::: "memory"); __builtin_amdgcn_sched_barrier(0);
        ATT_PV(3, vb);
        __builtin_amdgcn_sched_barrier(0);
#undef ATT_LDV
#undef ATT_PV
        if (i + 3 < 128) { ATT_DMA(i + 3); asm volatile("s_waitcnt vmcnt(4) lgkmcnt(0)" ::: "memory"); }
        else asm volatile("s_waitcnt vmcnt(0) lgkmcnt(0)" ::: "memory");
        __builtin_amdgcn_s_barrier();
        __builtin_amdgcn_sched_barrier(0);
    }
    if (grp == 0) __builtin_amdgcn_s_barrier(); else __builtin_amdgcn_s_setprio(0);
#undef ATT_DMA
#undef ATT_QK
    lrow = swap32_add(lrow);
    if (hi == 0) wsf[r32] = frcp(lrow);
    asm volatile("s_waitcnt lgkmcnt(0)" ::: "memory");
#pragma unroll
    for (int r = 0; r < 16; ++r) { const float il = wsf[crow(r, hi)];
#pragma unroll
        for (int d = 0; d < 4; ++d) o[d][r] *= il; }
    LAS float* xb = (LAS float*)lds + (size_t)qsub * 4096 + lane;
    if (comp == 1) {
#pragma unroll
        for (int d = 0; d < 4; ++d)
#pragma unroll
            for (int r = 0; r < 16; ++r) xb[(d * 16 + r) * 64] = o[d][r];
    }
    __syncthreads();
    if (comp == 0) {
        float ss[16];
#pragma unroll
        for (int r = 0; r < 16; ++r) { ss[r] = 0.f;
#pragma unroll
            for (int d = 0; d < 4; ++d) { const float v = o[d][r] - lam * xb[(d * 16 + r) * 64]; o[d][r] = v; ss[r] += v * v; } }
        float gcol[4];
#pragma unroll
        for (int d = 0; d < 4; ++d) gcol[d] = subg[d * 32 + r32] * outscale;
#pragma unroll
        for (int r = 0; r < 16; ++r) { const float tot = half_sum(ss[r]); const float rs = 1.0f / sqrtf(tot * (1.f / 128.f) + LN_EPS);
            bf16* orow = MIX + ((size_t)b * 8192 + qb * 128 + qsub * 32 + crow(r, hi)) * 1024 + h * 128 + r32;
#pragma unroll
            for (int d = 0; d < 4; ++d) orow[d * 32] = (bf16)(pk2(o[d][r] * rs * gcol[d], 0.f) & 0xffffu); }
    }
    __syncthreads();
}

__device__ __forceinline__ void ret_kv_pair(LAS unsigned char* lds, const bf16* RET, float* RKV, const int unit0, const float* lg2f, const float* lg2b) {
    const int tid = otid(), lane = tid & 63, r32 = lane & 31, hi = lane >> 5; const int wid = __builtin_amdgcn_readfirstlane(tid >> 6);
    const int wg = wid >> 2, w4 = wid & 3, t4 = tid & 255;
    const int unit = unit0 + wg; const int bh = unit >> 6, n = unit & 63, b = bh >> 2, h = bh & 3;
    LAS unsigned char* base = lds + wg * 49152;
    const float l2f = lg2f[h], l2b = lg2b[h];
    const bf16* src = RET + ((size_t)b * 8192 + n * 128) * 1024 + 64 * h;
#pragma unroll
    for (int i = 0; i < 4; ++i) { const int idx = t4 + 256 * i; const int j = idx >> 3, c = idx & 7;
        const u32x4 kk = *(const u32x4*)(src + (size_t)j * 1024 + 256 + c * 8); const u32x4 vv = *(const u32x4*)(src + (size_t)j * 1024 + 512 + c * 8);
        const float wf = fexp2((float)(127 - j) * l2f), wb = fexp2((float)j * l2b);
        u32x4 vf, vb;
#pragma unroll
        for (int e = 0; e < 4; ++e) { const float lo = bflo(vv[e]), hh = bfhi(vv[e]); vf[e] = pk2(lo * wf, hh * wf); vb[e] = pk2(lo * wb, hh * wb); }
        *(LAS u32x4*)(base + j * 128 + c * 16) = kk; *(LAS u32x4*)(base + 16384 + j * 128 + c * 16) = vf; *(LAS u32x4*)(base + 32768 + j * 128 + c * 16) = vb; }
    __syncthreads();
    const int da = w4 >> 1, eb = w4 & 1;
    const int rowoff = (8 * hi + ((lane & 15) >> 2)) * 128 + (16 * ((lane >> 4) & 1) + 4 * (lane & 3)) * 2;
    f32x16 af = (f32x16){}, ab = (f32x16){};
#pragma unroll
    for (int s = 0; s < 8; ++s) {
        const LAS char* kp = (const LAS char*)base + s * 2048 + rowoff + da * 64;
        const LAS char* vp = (const LAS char*)base + 16384 + s * 2048 + rowoff + eb * 64;
        const bf16x8 ka = cat8(vtr(kp), vtr(kp + 512));
        const bf16x8 vf = cat8(vtr(vp), vtr(vp + 512)), vb = cat8(vtr(vp + 16384), vtr(vp + 16384 + 512));
        af = __builtin_amdgcn_mfma_f32_32x32x16_bf16(ka, vf, af, 0, 0, 0);
        ab = __builtin_amdgcn_mfma_f32_32x32x16_bf16(ka, vb, ab, 0, 0, 0);
    }
    float* of = RKV + ((size_t)(bh * 64 + n) * 2) * 4096 + eb * 32 + r32;
#pragma unroll
    for (int r = 0; r < 16; ++r) { const int d = da * 32 + crow(r, hi); of[d * 64] = af[r]; of[4096 + d * 64] = ab[r]; }
    __syncthreads();
}
__device__ __forceinline__ void ret_out_pair(LAS unsigned char* lds, const bf16* RET, const bf16* RST, bf16* MIX, const int unit0, const float* lg2f, const float* lg2b) {
    const int tid = otid(), lane = tid & 63, r32 = lane & 31, hi = lane >> 5; const int wid = __builtin_amdgcn_readfirstlane(tid >> 6);
    const int wg = wid >> 2, w4 = wid & 3, t4 = tid & 255;
    const int unit = unit0 + wg; const int bh = unit >> 6, n = unit & 63, b = bh >> 2, h = bh & 3;
    LAS unsigned char* base = lds + wg * 49152;
    const float l2f = lg2f[h], l2b = lg2b[h];
    const size_t row0 = (size_t)b * 8192 + n * 128;
    const bf16* src = RET + row0 * 1024 + 64 * h;
#pragma unroll
    for (int i = 0; i < 4; ++i) { const int idx = t4 + 256 * i; const int j = idx >> 3, c = idx & 7;
        *(LAS u32x4*)(base + j * 128 + c * 16) = *(const u32x4*)(src + (size_t)j * 1024 + 256 + c * 8);
        *(LAS u32x4*)(base + 16384 + j * 128 + c * 16) = *(const u32x4*)(src + (size_t)j * 1024 + 512 + c * 8); }
    const bf16* rs = RST + ((size_t)(bh * 64 + n) * 2) * 4096;
#pragma unroll
    for (int i = 0; i < 4; ++i) { const int idx = t4 + 256 * i;
        *(LAS u32x4*)(base + 32768 + idx * 16) = *(const u32x4*)(rs + (size_t)idx * 8); }
    bf16x8 qr[4];
    const bf16* qp = src + (size_t)(32 * w4 + r32) * 1024;
#pragma unroll
    for (int d0 = 0; d0 < 4; ++d0) qr[d0] = *(const bf16x8*)(qp + d0 * 16 + hi * 8);
    __syncthreads();
    const int cq = 32 * w4 + r32;
    f32x16 yi[2] = {(f32x16){}, (f32x16){}}, yf[2] = {(f32x16){}, (f32x16){}}, yb[2] = {(f32x16){}, (f32x16){}};
    const int trl = ((lane & 15) >> 2) * 128 + (16 * ((lane >> 4) & 1) + 4 * (lane & 3)) * 2;
#pragma unroll
    for (int kb = 0; kb < 4; ++kb) {
        f32x16 p = (f32x16){};
#pragma unroll
        for (int d0 = 0; d0 < 4; ++d0) { const bf16x8 a = *(const LAS bf16x8*)(base + (32 * kb + r32) * 128 + (16 * d0 + 8 * hi) * 2); p = __builtin_amdgcn_mfma_f32_32x32x16_bf16(a, qr[d0], p, 0, 0, 0); }
#pragma unroll
        for (int r = 0; r < 16; ++r) { const int j = 32 * kb + crow(r, hi); const int rel = cq - j; p[r] *= fexp2(rel >= 0 ? (float)rel * l2f : (float)(-rel) * l2b); }
        const bf16x8 pa0 = pack8(p[0], p[1], p[2], p[3], p[4], p[5], p[6], p[7]), pa1 = pack8(p[8], p[9], p[10], p[11], p[12], p[13], p[14], p[15]);
#pragma unroll
        for (int eb = 0; eb < 2; ++eb) {
            const LAS char* vp = (const LAS char*)base + 16384 + (32 * kb + 4 * hi) * 128 + trl + eb * 64;
            const bf16x8 v0 = cat8(vtr(vp), vtr(vp + 8 * 128)), v1 = cat8(vtr(vp + 16 * 128), vtr(vp + 24 * 128));
            yi[eb] = __builtin_amdgcn_mfma_f32_32x32x16_bf16(pa0, v0, yi[eb], 0, 0, 0);
            yi[eb] = __builtin_amdgcn_mfma_f32_32x32x16_bf16(pa1, v1, yi[eb], 0, 0, 0);
        }
    }
#pragma unroll
    for (int d0 = 0; d0 < 4; ++d0)
#pragma unroll
        for (int eb = 0; eb < 2; ++eb) {
            const LAS char* rp = (const LAS char*)base + 32768 + (16 * d0 + 8 * hi) * 128 + trl + eb * 64;
            const bf16x8 rf = cat8(vtr(rp), vtr(rp + 4 * 128)), rb = cat8(vtr(rp + 8192), vtr(rp + 8192 + 4 * 128));
            yf[eb] = __builtin_amdgcn_mfma_f32_32x32x16_bf16(qr[d0], rf, yf[eb], 0, 0, 0);
            yb[eb] = __builtin_amdgcn_mfma_f32_32x32x16_bf16(qr[d0], rb, yb[eb], 0, 0, 0);
        }
#pragma unroll
    for (int r = 0; r < 16; ++r) {
        const int c = 32 * w4 + crow(r, hi);
        const float sf = fexp2((float)(c + 1) * l2f), sb = fexp2((float)(128 - c) * l2b);
        const float y0 = yi[0][r] + sf * yf[0][r] + sb * yb[0][r], y1 = yi[1][r] + sf * yf[1][r] + sb * yb[1][r];
        const float mean = half_sum(y0 + y1) * (1.f / 64.f); const float d0_ = y0 - mean, d1_ = y1 - mean;
        const float var = half_sum(d0_ * d0_ + d1_ * d1_) * (1.f / 64.f); const float rstd = 1.0f / sqrtf(var + LN_EPS);
        const bf16* gp = RET + (row0 + c) * 1024 + 768 + 64 * h + r32; bf16* op = MIX + (row0 + c) * 1024 + 768 + 64 * h + r32;
        const float g0 = bf2f(gp[0]), g1 = bf2f(gp[32]);
        op[0] = (bf16)(pk2(g0 * sigmoidf_(g0) * d0_ * rstd, 0.f) & 0xffffu); op[32] = (bf16)(pk2(g1 * sigmoidf_(g1) * d1_ * rstd, 0.f) & 0xffffu);
    }
    __syncthreads();
}

__device__ __forceinline__ int moe_tables(LAS unsigned char* lds, const unsigned* gcnt) {
    LAS int* cnt = (LAS int*)(lds + TAB_OFF); LAS int* tstart = cnt + 32; LAS unsigned char* tile_e = (LAS unsigned char*)(tstart + 36);
    const int tid = otid();
    if (tid < 32) cnt[tid] = (int)gcnt[tid];
    __syncthreads();
    if (tid == 0) { int s = 0; for (int e = 0; e < 32; ++e) { tstart[e] = s; s += (cnt[e] + 255) >> 8; } tstart[32] = s; }
    __syncthreads();
    const int ntile = tstart[32];
    for (int p = tid; p < ntile; p += NTHR) { int e = 0;
#pragma unroll
        for (int k = 1; k < 32; ++k) e += (tstart[k] <= p) ? 1 : 0;
        tile_e[p] = (unsigned char)e; }
    __syncthreads();
    return ntile;
}

constexpr int NPH_LAYER = 10, NPH = 3 + DEPTH * NPH_LAYER;
#ifndef PH_MASK
#define PH_MASK 0x1FFFF
#endif
#define PHM(j) (((PH_MASK) >> (j)) & 1)
#ifndef DUP_MASK
#define DUP_MASK 0x0
#endif
#define NREP(j) (1 + (((DUP_MASK) >> (j)) & 1))
__global__ void __launch_bounds__(NTHR, 2) hybrid_fwd(Args args) {
    extern __shared__ __attribute__((aligned(16))) unsigned char lds_raw[];
    LAS unsigned char* lds = (LAS unsigned char*)lds_raw;
    volatile LAS unsigned* MISC = (volatile LAS unsigned*)(lds + MISC_OFF);
    const int G = gridDim.x, bx = blockIdx.x;
    const int NGW = G * NWAVES, NGT = G * NTHR;
#define PH_IDS const int tid = otid(); const int lane = tid & 63; const int wave = __builtin_amdgcn_readfirstlane(tid >> 6); const int gw = bx * NWAVES + wave; const int gt = bx * NTHR + tid; (void)lane; (void)gw; (void)gt; (void)wave;
    unsigned char* ws = args.ws;
    unsigned* ctl = (unsigned*)(ws + WS_CTL);
    for (int u = threadIdx.x; u < (LDS_BYTES - LDSCTL_OFF) / 4; u += NTHR) ((LAS unsigned*)(lds + LDSCTL_OFF))[u] = 0u;
    __syncthreads();
#if MK_SPLIT
    XcdBarrier bar; bar.bar = ctl + CW_BAR; bar.x = 0; bar.st = nullptr;
#define GRID_BAR() do { } while (0)
#else
    XcdBarrier bar = xcd_barrier_post(ctl + CW_BAR, MISC + 8);
#define GRID_BAR() xcd_barrier(bar)
#endif
    const int lo = args.ph_lo, hi_ph = args.ph_hi;
#define IN(k) (lo <= (k) && (k) < hi_ph)
#ifndef BAR_REP
#define BAR_REP 1
#endif
#define SEAM(k) do { if (IN((k) + 1)) { for (int br_ = 0; br_ < BAR_REP; ++br_) GRID_BAR(); } STAMP(k); } while (0)
#if STAMP_SEL >= 0
    if (threadIdx.x == 0) { const unsigned long long t0_ = __builtin_amdgcn_s_memrealtime(); MISC[16] = (unsigned)t0_; MISC[17] = (unsigned)(t0_ >> 32); MISC[18] = 0u; }
#define STAMP(k) do { if (threadIdx.x == 0) { const unsigned long long now_ = __builtin_amdgcn_s_memrealtime(); const unsigned long long last_ = (unsigned long long)MISC[16] | ((unsigned long long)MISC[17] << 32); \
        if ((k) == STAMP_SEL) MISC[18] = __float_as_uint((float)(now_ - last_) * 0.0002f); MISC[16] = (unsigned)now_; MISC[17] = (unsigned)(now_ >> 32); } } while (0)
#else
#define STAMP(k) do { } while (0)
#endif

    const float* x_in = (const float*)args.in[0]; const float* c_in = (const float*)args.in[1]; const int* pos_in = (const int*)args.in[2];
    const float* ada_w = (const float*)args.in[3]; const float* ada_b = (const float*)args.in[4];
    const float* w_in = (const float*)args.in[5]; const float* w_out = (const float*)args.in[6];
    const float* lq1 = (const float*)args.in[7]; const float* lk1 = (const float*)args.in[8]; const float* lq2 = (const float*)args.in[9]; const float* lk2 = (const float*)args.in[10];
    const float* subln_g = (const float*)args.in[11];
    const float* s5_lre = (const float*)args.in[12]; const float* s5_lim = (const float*)args.in[13]; const float* s5_ls = (const float*)args.in[14];
    const float* s5_bre = (const float*)args.in[15]; const float* s5_bim = (const float*)args.in[16]; const float* s5_cre = (const float*)args.in[17]; const float* s5_cim = (const float*)args.in[18];
    const float* s5_d = (const float*)args.in[19]; const float* glu_w = (const float*)args.in[20]; const float* glu_b = (const float*)args.in[21];
    const float* ln_g = (const float*)args.in[22]; const float* ln_b = (const float*)args.in[23];
    const float* router_w = (const float*)args.in[24]; const float* router_b = (const float*)args.in[25];
    const float* exp_w1 = (const float*)args.in[26]; const float* exp_b1 = (const float*)args.in[27]; const float* exp_w2 = (const float*)args.in[28]; const float* exp_b2 = (const float*)args.in[29];
    float* MOD = (float*)(ws + WS_MOD); float* ROT = (float*)(ws + WS_ROT); float* PW = (float*)(ws + WS_PW); float* BB = (float*)(ws + WS_BB);
    bf16* WIN = (bf16*)(ws + WS_WIN); bf16* WOUT = (bf16*)(ws + WS_WOUT); bf16* GLU = (bf16*)(ws + WS_GLU); bf16* W1S = (bf16*)(ws + WS_W1S); bf16* TW = (bf16*)(ws + WS_TW);
    bf16* W1 = (bf16*)(ws + WS_W1); bf16* W2 = (bf16*)(ws + WS_W2); bf16* HB = (bf16*)(ws + WS_HB);
    bf16* QIMG = (bf16*)(ws + WS_QIMG); bf16* KIMG = (bf16*)(ws + WS_KIMG); bf16* VIMG = (bf16*)(ws + WS_VIMG); bf16* UG2 = (bf16*)(ws + WS_UG2); bf16* RET = (bf16*)(ws + WS_RET);
    float* S5S = (float*)(ws + WS_S5S); bf16* YB = (bf16*)(ws + WS_YB); float* RKV = (float*)(ws + WS_RKV); bf16* RST = (bf16*)(ws + WS_RST); bf16* MIX = (bf16*)(ws + WS_MIX);
    float* YPRE = (float*)(ws + WS_YPRE); float* X1 = (float*)(ws + WS_X1); float* XB = (float*)(ws + WS_XB);
    int* LIST = (int*)(ws + WS_LIST); int* TOKI = (int*)(ws + WS_TOKI); float* GATE = (float*)(ws + WS_GATE); bf16* A2 = (bf16*)(ws + WS_A2); bf16* YS = (bf16*)(ws + WS_YS);
    float* COSA = ROT, *SINA = ROT + (size_t)T * 32, *COSR = ROT + (size_t)T * 64, *SINR = ROT + (size_t)T * 96;

    if (PHM(10) && IN(0)) {
        PH_IDS
        for (int rep = 0; rep < NREP(10); ++rep) {
        LAS float* cond = (LAS float*)lds; LAS float* red = (LAS float*)(lds + 16384);
        for (int i = tid; i < 4096; i += NTHR) { const float v = c_in[i]; cond[i] = v * sigmoidf_(v); }
        __syncthreads();
        for (int it = bx; it < 4 * 96; it += G) {
            const int l = it / 96, n0 = (it % 96) * 64;
            float a0 = 0.f, a1 = 0.f, a2 = 0.f, a3 = 0.f;
            const float* wp = ada_w + ((size_t)l * 1024 + wave * 128) * 6144 + n0 + lane;
#pragma unroll 32
            for (int kk = 0; kk < 128; ++kk) { const float wv = wp[(size_t)kk * 6144]; const int k = wave * 128 + kk; a0 += cond[k] * wv; a1 += cond[1024 + k] * wv; a2 += cond[2048 + k] * wv; a3 += cond[3072 + k] * wv; }
            red[(wave * 4 + 0) * 64 + lane] = a0; red[(wave * 4 + 1) * 64 + lane] = a1; red[(wave * 4 + 2) * 64 + lane] = a2; red[(wave * 4 + 3) * 64 + lane] = a3;
            __syncthreads();
            if (tid < 256) { const int b = tid >> 6; float s = ada_b[(size_t)l * 6144 + n0 + lane];
#pragma unroll
                for (int w = 0; w < 8; ++w) s += red[(w * 4 + b) * 64 + lane];
                MOD[((size_t)l * 4 + b) * 6144 + n0 + lane] = s; }
            __syncthreads();
        }
        for (int i = gt; i < T * 32; i += NGT) { const int row = i >> 5, f = i & 31; const double p = (double)pos_in[row];
            float c, s; sincos_rev(p * args.invfA[f], c, s); COSA[i] = c; SINA[i] = s; sincos_rev(p * args.invfR[f], c, s); COSR[i] = c; SINR[i] = s; }
        for (int i = gt; i < DEPTH * 32 * 1024; i += NGT) { const int k = i & 1023, e = (i >> 10) & 31, ll = i >> 15; ((float*)(ws + WS_ROUTW))[i] = router_w[((size_t)ll * 1024 + k) * 32 + e]; }
        for (int q = gt; q < 4 * 2 * 16 * 64 * 65; q += NGT) {
            const int i = q / 65, tau = q - i * 65; const int g = (i >> 6) & 15, ld = i >> 10;
            const float lr = fminf(s5_lre[i], -1e-4f), li = s5_lim[i]; const float dt = expf(s5_ls[ld * 16 + g]);
            const float mag = expf((float)tau * lr * dt); float c, sn; sincos_rev((double)tau * (double)li * (double)dt, c, sn);
            PW[(size_t)i * 130 + 2 * tau] = mag * c; PW[(size_t)i * 130 + 2 * tau + 1] = mag * sn;
        }
        for (int q = gt; q < 4 * 2 * 16 * 64 * 16; q += NGT) {
            const int i = q >> 4, n = q & 15; const int g = (i >> 6) & 15, ld = i >> 10;
            const float lr = fminf(s5_lre[i], -1e-4f), li = s5_lim[i]; const float dt = expf(s5_ls[ld * 16 + g]);
            const float mag = expf(lr * dt); float c, sn; sincos_rev((double)li * (double)dt, c, sn);
            const float ar = mag * c, ai = mag * sn, den = lr * lr + li * li;
            const float fre = ((ar - 1.0f) * lr + ai * li) / den, fim = (ai * lr - (ar - 1.0f) * li) / den;
            const float br = s5_bre[q], bi = s5_bim[q]; BB[(size_t)q * 2] = fre * br - fim * bi; BB[(size_t)q * 2 + 1] = fre * bi + fim * br;
        }
        __syncthreads(); }
        SEAM(0);
    }
    if (PHM(11) && IN(1)) {
        PH_IDS
        for (int rep = 0; rep < NREP(11); ++rep) {
        if (wave >= 4) {
        const int gw2 = bx * 4 + (wave - 4), NGW2 = G * 4, bt = bx * 256 + (tid - 256), NBT = G * 256;
        for (int m0 = gw2; m0 < T; m0 += 4 * NGW2) { f32x4 v[4][4];
#pragma unroll
            for (int r = 0; r < 4; ++r) { const f32x4* xr = (const f32x4*)(x_in + (size_t)(m0 + r * NGW2) * DM) + lane;
#pragma unroll
                for (int j = 0; j < 4; ++j) v[r][j] = xr[64 * j]; }
#pragma unroll
            for (int r = 0; r < 4; ++r) { const int m = m0 + r * NGW2; const float* md = MOD + (size_t)(m >> 13) * 6144; mod_row_store(v[r], md, md + 1024, HB + (size_t)m * DM, lane); } }
        float* KT = S5S;
#pragma unroll 2
        for (int i = bt; i < 4 * 16 * 2 * 64 * 256; i += NBT) {
            const int mm = i & 15, n = (i >> 4) & 15, tau = (i >> 8) & 63, dir = (i >> 14) & 1, g = (i >> 15) & 15, l = i >> 19;
            const size_t pg = ((size_t)(l * 2 + dir) * 16 + g);
            const float* cr = s5_cre + (pg * 16 + n) * 64; const float* ci = s5_cim + (pg * 16 + n) * 64;
            const float* pw = PW + pg * 64 * 130 + 2 * tau; const float* bb = BB + (pg * 64 * 16 + mm) * 2;
            float acc = 0.f;
#pragma unroll 8
            for (int p = 0; p < 64; ++p) { const float pr = pw[(size_t)p * 130], pi = pw[(size_t)p * 130 + 1], br = bb[(size_t)p * 32], bi = bb[(size_t)p * 32 + 1];
                acc += cr[p] * (pr * br - pi * bi) - ci[p] * (pr * bi + pi * br); }
            KT[i] = acc;
        }
#pragma unroll 2
        for (int i = bt; i < 4 * 16 * 1024 * 32; i += NBT) {
            const int c8 = i & 31, rowj = (i >> 5) & 1023, g = (i >> 15) & 15, l = i >> 19;
            const int col = c8 * 8, dir = col >> 7, part = (col >> 6) & 1, p0 = col & 63;
            const size_t pg = ((size_t)(l * 2 + dir) * 16 + g);
            const int j = rowj >> 4, n = rowj & 15; const int tau = dir == 0 ? j + 1 : 64 - j;
            const float* cp = s5_cre + (pg * 16 + n) * 64 + p0; const float* cq = s5_cim + (pg * 16 + n) * 64 + p0;
            const f32x4 cr0 = *(const f32x4*)cp, cr1 = *(const f32x4*)(cp + 4), ci0 = *(const f32x4*)cq, ci1 = *(const f32x4*)(cq + 4);
            float v[8];
#pragma unroll
            for (int e = 0; e < 8; ++e) { const f32x2 a = *(const f32x2*)(PW + (pg * 64 + p0 + e) * 130 + 2 * tau); const float cr = e < 4 ? cr0[e & 3] : cr1[e & 3], ci = e < 4 ? ci0[e & 3] : ci1[e & 3];
                v[e] = part == 0 ? (cr * a[0] - ci * a[1]) : -(cr * a[1] + ci * a[0]); }
            *(u32x4*)(TW + ((size_t)(l * 16 + g) * 1024 + rowj) * 1280 + 1024 + col) = (u32x4){pk2(v[0], v[1]), pk2(v[2], v[3]), pk2(v[4], v[5]), pk2(v[6], v[7])};
        }
#pragma unroll 2
        for (int i = bt; i < 4 * 16 * 256 * 128; i += NBT) {
            const int c8 = i & 127, p2 = (i >> 7) & 255, g = (i >> 15) & 15, l = i >> 19;
            const int dir = p2 >> 7, part = (p2 >> 6) & 1, p = p2 & 63;
            const size_t pg = ((size_t)(l * 2 + dir) * 16 + g);
            const int sidx = c8 >> 1, m0 = (c8 & 1) * 8; const int tau = dir == 0 ? 63 - sidx : sidx;
            const f32x2 pwv = *(const f32x2*)(PW + (pg * 64 + p) * 130 + 2 * tau);
            const float* bp = BB + ((pg * 64 + p) * 16 + m0) * 2;
            const f32x4 b0 = *(const f32x4*)bp, b1 = *(const f32x4*)(bp + 4), b2 = *(const f32x4*)(bp + 8), b3 = *(const f32x4*)(bp + 12);
            const float br[8] = {b0[0], b0[2], b1[0], b1[2], b2[0], b2[2], b3[0], b3[2]}, bi[8] = {b0[1], b0[3], b1[1], b1[3], b2[1], b2[3], b3[1], b3[3]};
            float v[8];
#pragma unroll
            for (int e = 0; e < 8; ++e) v[e] = part == 0 ? (pwv[0] * br[e] - pwv[1] * bi[e]) : (pwv[0] * bi[e] + pwv[1] * br[e]);
            *(u32x4*)(W1S + (size_t)i * 8) = (u32x4){pk2(v[0], v[1]), pk2(v[2], v[3]), pk2(v[4], v[5]), pk2(v[6], v[7])};
        }
        }
        {
            LAS float* scr = (LAS float*)(lds + 32768 + wave * 8704);
            constexpr int I_IN = 16 * 88, I_OUT = 16 * 32, I_GLU = 4 * 16, I_W1 = 16 * 64, I_W2 = 16 * 32;
            constexpr int N_SMALL = DEPTH * (I_IN + I_OUT + I_GLU);
            constexpr int N_ALL = N_SMALL + DEPTH * NE * (I_W1 + I_W2);
            for (;;) {
                int it0 = 0; if (lane == 0) it0 = (int)__hip_atomic_fetch_add(ctl + CW_CONV, 16u, __ATOMIC_RELAXED, __HIP_MEMORY_SCOPE_AGENT);
                it0 = __builtin_amdgcn_readfirstlane(it0);
                if (it0 >= N_ALL) break;
                for (int it = it0; it < it0 + 16 && it < N_ALL; ++it) {
                int r = it;
                if (r < N_SMALL) {
                    const int l = r / (I_IN + I_OUT + I_GLU); r %= (I_IN + I_OUT + I_GLU);
                    if (r < I_IN) transpose_item<1>(w_in + (size_t)l * 1024 * INW, 1024, INW, WIN + (size_t)l * INW * 1024, scr, r, lane);
                    else if (r < I_IN + I_OUT) transpose_item<0>(w_out + (size_t)l * 1024 * 1024, 1024, 1024, WOUT + (size_t)l * 1024 * 1024, scr, r - I_IN, lane);
                    else transpose_item<3>(glu_w + (size_t)l * 256 * 512, 256, 512, GLU + (size_t)l * 512 * 256, scr, r - I_IN - I_OUT, lane);
                } else {
                    r -= N_SMALL; const int le = r / (I_W1 + I_W2); r %= (I_W1 + I_W2);
                    if (r < I_W1) transpose_item<2>(exp_w1 + (size_t)le * 1024 * 2048, 1024, 2048, W1 + (size_t)le * 2048 * 1024, scr, r, lane);
                    else transpose_item<0>(exp_w2 + (size_t)le * 1024 * 1024, 1024, 1024, W2 + (size_t)le * 1024 * 1024, scr, r - I_W1, lane);
                }
                }
            }
        }
        }
        SEAM(1);
    }
    if (PHM(11) && IN(2)) {
        PH_IDS
        const float* KT = S5S;
        LAS float* slab = (LAS float*)lds;
        for (int it = bx; it < 4 * 16 * 16; it += G) {
            const int n = it & 15, lg = it >> 4;
            for (int q = tid; q < 512; q += NTHR) { const int dt = q >> 2, c4 = q & 3;
                *(LAS f32x4*)(slab + dt * 16 + c4 * 4) = *(const f32x4*)(KT + (((size_t)lg * 128 + dt) * 16 + n) * 16 + c4 * 4); }
            __syncthreads();
#pragma unroll 4
            for (int q = tid; q < 64 * 128; q += NTHR) { const int c8 = q & 127, j = q >> 7; const int sidx = c8 >> 1, m0 = (c8 & 1) * 8;
                const int d = j - sidx; const int tau = d >= 0 ? d : -d; const LAS float* kf = slab + ((d >= 0 ? 0 : 64) + tau) * 16 + m0;
                f32x4 a0 = *(const LAS f32x4*)kf, a1 = *(const LAS f32x4*)(kf + 4);
                if (d == 0) { a0 += *(const LAS f32x4*)(kf + 1024); a1 += *(const LAS f32x4*)(kf + 1028); }
                *(u32x4*)(TW + ((size_t)lg * 1024 + j * 16 + n) * 1280 + sidx * 16 + m0) = pack8u(a0, a1); }
            __syncthreads();
        }
        SEAM(2);
    }

    for (int l = 0; l < DEPTH; ++l) {
        const int P = 3 + l * NPH_LAYER;
        const float* xcur = (l == 0) ? x_in : XB;
        float* xnext = (l == DEPTH - 1) ? args.out : XB;
        const float* modl = MOD + (size_t)l * 4 * 6144;
        unsigned* gcnt = ctl + CW_GCNT + 64 * l;
        if (PHM(0) && IN(P + 0)) {
            DenseSched S{T / 256, INW / 256, G, bx, (const char*)HB, (const char*)(WIN + (size_t)l * INW * 1024), (size_t)256 * 1024 * 2, (size_t)256 * 1024 * 2};
            EpiProj E{QIMG, KIMG, VIMG, UG2, RET, COSA, SINA, COSR, SINR};
            for (int rep = 0; rep < NREP(0); ++rep) pg8::gemm_phase<EpiProj, DenseSched, false>(lds, 1024, 1024, 1024, S, E);
            SEAM(P + 0);
        }
        if (PHM(1) && IN(P + 1)) {
            S5G1Sched S{G, bx, (const char*)UG2, (const char*)(W1S + (size_t)l * 16 * 256 * 1024)};
            EpiS5S E{(float*)(ws + WS_S5S4)};
            for (int rep = 0; rep < NREP(1); ++rep) {
            if (PHM(12)) pg8::gemm_phase<EpiS5S, S5G1Sched, false>(lds, 256, 1280, 1024, S, E);
            __syncthreads();
            if (PHM(13)) {
                if (bx < 128) ret_kv_pair(lds, RET, RKV, 2 * bx, args.lg2f, args.lg2b);
                else for (int k = 0; k < 3; ++k) ret_kv_pair(lds, RET, RKV, 2 * (128 + (bx - 128) * 3 + k), args.lg2f, args.lg2b);
            }
            }
            SEAM(P + 1);
        }
        if (PHM(2) && IN(P + 2)) {
            PH_IDS
            for (int rep = 0; rep < NREP(2); ++rep) {
            if (bx < 128) {
                const int dir = bx & 1, g = (bx >> 1) & 15, b = bx >> 5;
                const size_t pg = ((size_t)(l * 2 + dir) * 16 + g);
                const float aqr = PW[(pg * 64 + lane) * 130 + 128], aqi = PW[(pg * 64 + lane) * 130 + 129];
                const float* sb = (const float*)(ws + WS_S5S4) + ((size_t)g * 512 + b * 128) * 256 + dir * 128 + lane;
                bf16* ob = UG2 + ((size_t)g * 512 + b * 128) * 1280 + 1024 + dir * 128 + lane;
                float sr[16], si[16];
#pragma unroll
                for (int k = 0; k < 16; ++k) { const int cc = 16 * wave + k; const int c = dir == 0 ? cc : 127 - cc; float ar_ = 0.f, ai_ = 0.f;
#pragma unroll
                    for (int q = 0; q < 4; ++q) { ar_ += sb[(size_t)q * (16 * 512 * 256) + (size_t)c * 256]; ai_ += sb[(size_t)q * (16 * 512 * 256) + (size_t)c * 256 + 64]; }
                    sr[k] = ar_; si[k] = ai_; }
                float hr = 0.f, hi2 = 0.f;
#pragma unroll
                for (int k = 0; k < 16; ++k) { const float nr = aqr * hr - aqi * hi2 + sr[k], ni = aqr * hi2 + aqi * hr + si[k]; hr = nr; hi2 = ni; }
                LAS float* seg = (LAS float*)lds;
                seg[(wave * 2 + 0) * 64 + lane] = hr; seg[(wave * 2 + 1) * 64 + lane] = hi2;
                float a16r = aqr, a16i = aqi;
#pragma unroll
                for (int q = 0; q < 4; ++q) { const float tr_ = a16r * a16r - a16i * a16i, ti_ = 2.f * a16r * a16i; a16r = tr_; a16i = ti_; }
                __syncthreads();
                hr = 0.f; hi2 = 0.f;
                for (int w2 = 0; w2 < wave; ++w2) { const float er = seg[(w2 * 2 + 0) * 64 + lane], ei = seg[(w2 * 2 + 1) * 64 + lane]; const float nr = a16r * hr - a16i * hi2 + er, ni = a16r * hi2 + a16i * hr + ei; hr = nr; hi2 = ni; }
#pragma unroll
                for (int k = 0; k < 16; ++k) { const int cc = 16 * wave + k; const int c = dir == 0 ? cc : 127 - cc;
                    ob[(size_t)c * 1280] = (bf16)(pk2(hr, 0.f) & 0xffffu); ob[(size_t)c * 1280 + 64] = (bf16)(pk2(hi2, 0.f) & 0xffffu);
                    const float nr = aqr * hr - aqi * hi2 + sr[k], ni = aqr * hi2 + aqi * hr + si[k]; hr = nr; hi2 = ni; }
                __syncthreads();
            }
            for (int i = gt; i < 2 * 16 * 4096; i += NGT) { const int idx = i & 4095, dir = (i >> 12) & 1, bh = i >> 13, h = bh & 3;
                const float dk = fexp2(128.f * (dir == 0 ? args.lg2f[h] : args.lg2b[h]));
                const float* kv = RKV + (size_t)bh * 64 * 2 * 4096 + dir * 4096 + idx; bf16* rs = RST + (size_t)bh * 64 * 2 * 4096 + dir * 4096 + idx;
                float st = 0.f;
#pragma unroll 16
                for (int nn = 0; nn < 64; ++nn) { const int n = dir == 0 ? nn : 63 - nn; const float v = kv[(size_t)n * 8192]; rs[(size_t)n * 8192] = (bf16)(pk2(st, 0.f) & 0xffffu); st = dk * st + v; }
            }
            }
            SEAM(P + 2);
        }
        if (PHM(3) && IN(P + 3)) {
            float lam;
            { float s1 = 0.f, s2 = 0.f; for (int i = 0; i < 64; ++i) { s1 += lq1[l * 64 + i] * lk1[l * 64 + i]; s2 += lq2[l * 64 + i] * lk2[l * 64 + i]; } lam = expf(s1) - expf(s2) + args.lam_init[l]; }
            if (PHM(14)) for (int rep = 0; rep < NREP(14); ++rep) for (int u = bx; u < 1024; u += G) { const int qb = u & 63, bh = u >> 6; attn_unit(lds, QIMG, KIMG, VIMG, MIX, bh >> 2, bh & 3, qb, lam, subln_g + l * 128, 1.0f - args.lam_init[l]); }
            const int half = G >> 1;
            if (PHM(15)) {
                GroupSched S{4, half, bx < half ? bx : -1, (const char*)UG2, (const char*)(TW + (size_t)l * 16 * 1024 * 1280), (size_t)512 * 1280 * 2, (size_t)1024 * 1280 * 2, (size_t)256 * 1280 * 2, (size_t)256 * 1280 * 2};
                EpiS5Y E{YB, UG2, s5_d + l * 256};
                for (int rep = 0; rep < NREP(15); ++rep) pg8::gemm_phase<EpiS5Y, GroupSched, false>(lds, 1280, 1280, 1280, S, E);
            }
            __syncthreads();
            if (PHM(16)) for (int rep = 0; rep < NREP(16); ++rep) {
                if (bx < half) ret_out_pair(lds, RET, RST, MIX, 2 * bx, args.lg2f, args.lg2b);
                else for (int k = 0; k < 3; ++k) ret_out_pair(lds, RET, RST, MIX, 2 * (half + (bx - half) * 3 + k), args.lg2f, args.lg2b);
            }
            SEAM(P + 3);
        }
        if (PHM(4) && IN(P + 4)) {
            DenseSched S{T / 256, 2, G, bx, (const char*)YB, (const char*)(GLU + (size_t)l * 512 * 256), (size_t)256 * 256 * 2, (size_t)256 * 256 * 2};
            EpiGlu E{MIX, glu_b + l * 512};
            for (int rep = 0; rep < NREP(4); ++rep) pg8::gemm_phase<EpiGlu, DenseSched, false>(lds, 256, 256, 256, S, E);
            SEAM(P + 4);
        }
        if (PHM(5) && IN(P + 5)) {
            DenseSched S{T / 256, 4, G, bx, (const char*)MIX, (const char*)(WOUT + (size_t)l * 1024 * 1024), (size_t)256 * 1024 * 2, (size_t)256 * 1024 * 2};
            EpiOut E{(bf16*)YPRE, modl};
            for (int rep = 0; rep < NREP(5); ++rep) pg8::gemm_phase<EpiOut, DenseSched, false>(lds, 1024, 1024, 1024, S, E);
            SEAM(P + 5);
        }
        if (PHM(6) && IN(P + 6)) {
            PH_IDS
            for (int rep = 0; rep < NREP(6); ++rep) { const bool commit = (rep == NREP(6) - 1);
            __syncthreads();
            LAS float* WT = (LAS float*)lds;
            for (int i = tid; i < 8192; i += NTHR) ((LAS f32x4*)WT)[i] = ((const f32x4*)(ws + WS_ROUTW) + (size_t)l * 8192)[i];
            LAS int* lcnt = (LAS int*)(lds + TAB_OFF); LAS int* lbase = lcnt + 32; LAS int* ent = lbase + 32;
            if (tid < 32) lcnt[tid] = 0;
            __syncthreads();
            const float rbv = router_b[l * 32 + (lane >> 1)];
            int it = 0;
            f32x4 xn[2][4]; u32x2 yn[2][4];
#pragma unroll
            for (int r = 0; r < 2; ++r)
#pragma unroll
                for (int j = 0; j < 4; ++j) { yn[r][j] = __builtin_nontemporal_load((const u32x2*)((const bf16*)YPRE + (size_t)(gw + r * NGW) * DM + 4 * lane + 256 * j)); xn[r][j] = __builtin_nontemporal_load((const f32x4*)(xcur + (size_t)(gw + r * NGW) * DM) + lane + 64 * j); }
            for (int m0 = gw; m0 < T; m0 += 2 * NGW, ++it) {
                f32x4 v[2][4]; float mean[2], rstd[2];
#pragma unroll
                for (int r = 0; r < 2; ++r)
#pragma unroll
                    for (int j = 0; j < 4; ++j) { const u32x2 ym = yn[r][j]; v[r][j] = xn[r][j] * DN_ALPHA + (f32x4){bflo(ym[0]), bfhi(ym[0]), bflo(ym[1]), bfhi(ym[1])}; }
                { const int mn = (m0 + 2 * NGW < T) ? m0 + 2 * NGW : m0;
#pragma unroll
                  for (int r = 0; r < 2; ++r)
#pragma unroll
                    for (int j = 0; j < 4; ++j) { yn[r][j] = __builtin_nontemporal_load((const u32x2*)((const bf16*)YPRE + (size_t)(mn + r * NGW) * DM + 4 * lane + 256 * j)); xn[r][j] = __builtin_nontemporal_load((const f32x4*)(xcur + (size_t)(mn + r * NGW) * DM) + lane + 64 * j); } }
#pragma unroll
                for (int r = 0; r < 2; ++r) row_stats(v[r], mean[r], rstd[r]);
#pragma unroll
                for (int j = 0; j < 4; ++j) { const int col = 4 * lane + 256 * j; const f32x4 gg = *(const f32x4*)(ln_g + (size_t)(l * 2) * DM + col), bb = *(const f32x4*)(ln_b + (size_t)(l * 2) * DM + col);
#pragma unroll
                    for (int r = 0; r < 2; ++r) { v[r][j] = (v[r][j] - mean[r]) * rstd[r] * gg + bb; *(f32x4*)(X1 + (size_t)(m0 + r * NGW) * DM + col) = v[r][j]; } }
#pragma unroll
                for (int r = 0; r < 2; ++r) row_stats(v[r], mean[r], rstd[r]);
#pragma unroll
                for (int r = 0; r < 2; ++r) { const int m = m0 + r * NGW; const float* sh = modl + (size_t)(m >> 13) * 6144 + 3 * 1024; const float* sc = sh + 1024;
#pragma unroll
                    for (int j = 0; j < 4; ++j) { const int col = 4 * lane + 256 * j; const f32x4 a = *(const f32x4*)(sc + col), bb = *(const f32x4*)(sh + col);
                        v[r][j] = (v[r][j] - mean[r]) * rstd[r] * (a + 1.0f) + bb; *(u32x2*)(HB + (size_t)m * DM + col) = (u32x2){pk2(v[r][j][0], v[r][j][1]), pk2(v[r][j][2], v[r][j][3])}; } }
#pragma unroll
                for (int r = 0; r < 2; ++r) {
                    float pe[32];
#pragma unroll
                    for (int eg = 0; eg < 8; ++eg) {
#pragma unroll
                        for (int e = 4 * eg; e < 4 * eg + 4; ++e) { f32x2 a01 = (f32x2){0.f, 0.f}, a23 = (f32x2){0.f, 0.f};
#pragma unroll
                            for (int j = 0; j < 4; ++j) { const f32x4 w = *(const LAS f32x4*)(WT + e * 1024 + 4 * lane + 256 * j);
                                a01 = __builtin_elementwise_fma(__builtin_shufflevector(v[r][j], v[r][j], 0, 1), __builtin_shufflevector(w, w, 0, 1), a01);
                                a23 = __builtin_elementwise_fma(__builtin_shufflevector(v[r][j], v[r][j], 2, 3), __builtin_shufflevector(w, w, 2, 3), a23); }
                            const f32x2 s2 = a01 + a23; pe[e] = s2[0] + s2[1]; }
                        asm volatile("" ::: "memory");
                    }
#pragma unroll
                    for (int e = 0; e < 16; e += 4) swap32x4(pe[e], pe[e + 16], pe[e + 1], pe[e + 17], pe[e + 2], pe[e + 18], pe[e + 3], pe[e + 19]);
#pragma unroll
                    for (int e = 0; e < 16; ++e) pe[e] += pe[e + 16];
#pragma unroll
                    for (int e = 0; e < 8; e += 4) swap16x4(pe[e], pe[e + 8], pe[e + 1], pe[e + 9], pe[e + 2], pe[e + 10], pe[e + 3], pe[e + 11]);
#pragma unroll
                    for (int e = 0; e < 8; ++e) pe[e] += pe[e + 8];
                    { const bool b3 = (lane & 8) != 0;
#pragma unroll
                      for (int j = 0; j < 4; ++j) { const float snd = b3 ? pe[j] : pe[j + 4], kp = b3 ? pe[j + 4] : pe[j]; pe[j] = kp + dppmov<0x128>(snd); } }
                    { const bool b2 = (lane & 4) != 0;
#pragma unroll
                      for (int j = 0; j < 2; ++j) { const float snd = b2 ? pe[j] : pe[j + 2], kp = b2 ? pe[j + 2] : pe[j]; pe[j] = kp + dppmov<0x1B>(dppmov<0x141>(snd)); } }
                    { const bool b1 = (lane & 2) != 0; const float snd = b1 ? pe[0] : pe[1], kp = b1 ? pe[1] : pe[0]; pe[0] = kp + dppmov<0x4E>(snd); }
                    float lgv = pe[0] + dppmov<0xB1>(pe[0]) + rbv;
                    int te[4]; float tv[4];
#pragma unroll
                    for (int k = 0; k < 4; ++k) { const float mx = wave_max(lgv); const unsigned long long bm = __ballot(lgv == mx); const int fl = __ffsll((long long)bm) - 1;
                        te[k] = fl >> 1; tv[k] = mx; lgv = ((lane >> 1) == (fl >> 1)) ? -INFINITY : lgv; }
                    float gs = 0.f, ge[4];
#pragma unroll
                    for (int k = 0; k < 4; ++k) { ge[k] = fexp2((tv[k] - tv[0]) * LOG2E); gs += ge[k]; }
                    const float ig = 1.0f / gs;
                    if (lane < 4 && commit) { const int e = lane == 0 ? te[0] : lane == 1 ? te[1] : lane == 2 ? te[2] : te[3]; const float gv = (lane == 0 ? ge[0] : lane == 1 ? ge[1] : lane == 2 ? ge[2] : ge[3]) * ig;
                        const int lp = atomicAdd((int*)&lcnt[e], 1);
                        const int sl = (wave * 32 + it * 2 + r) * 4 + lane; ent[sl * 3] = e; ent[sl * 3 + 1] = lp; ent[sl * 3 + 2] = __float_as_int(gv); }
                }
            }
            if (!commit) continue;
            __syncthreads();
            if (tid < 32) lbase[tid] = (int)atomicAdd(gcnt + tid, (unsigned)lcnt[tid]);
            __syncthreads();
            { int nl = 0; for (int m = gw; m < T; m += NGW, ++nl) { if (lane < 4) { const int sl = (wave * 32 + nl) * 4 + lane; const int e = ent[sl * 3], pos = lbase[e] + ent[sl * 3 + 1];
                    LIST[(size_t)e * T + pos] = m; TOKI[((size_t)m * 4 + lane) * 2] = e; TOKI[((size_t)m * 4 + lane) * 2 + 1] = pos; GATE[(size_t)m * 4 + lane] = __int_as_float(ent[sl * 3 + 2]); } } }
            }
            SEAM(P + 6);
        }
        if (PHM(7) && IN(P + 7)) {
            const int ntile = moe_tables(lds, gcnt);
            LAS int* cnt = (LAS int*)(lds + TAB_OFF);
            MoeSched S{ntile, 8, G, bx, (const char*)HB, (const char*)(W1 + (size_t)l * 32 * 2048 * 1024), (size_t)2048 * 1024 * 2, 0, (size_t)256 * 1024 * 2, cnt, cnt + 32, (const LAS unsigned char*)(cnt + 68), LIST};
            EpiMoe1 E{A2, exp_b1 + (size_t)l * 32 * 2048};
            for (int rep = 0; rep < NREP(7); ++rep) pg8::gemm_phase<EpiMoe1, MoeSched, true>(lds, 1024, 1024, 1024, S, E);
            SEAM(P + 7);
        }
        if (PHM(8) && IN(P + 8)) {
            const int ntile = moe_tables(lds, gcnt);
            LAS int* cnt = (LAS int*)(lds + TAB_OFF);
            MoeSched S{ntile, 4, G, bx, (const char*)A2, (const char*)(W2 + (size_t)l * 32 * 1024 * 1024), (size_t)1024 * 1024 * 2, (size_t)256 * 1024 * 2, (size_t)256 * 1024 * 2, cnt, cnt + 32, (const LAS unsigned char*)(cnt + 68), LIST};
            EpiMoe2 E{YS, exp_b2 + (size_t)l * 32 * 1024};
            for (int rep = 0; rep < NREP(8); ++rep) pg8::gemm_phase<EpiMoe2, MoeSched, false>(lds, 1024, 1024, 1024, S, E);
            SEAM(P + 8);
        }
        if (PHM(9) && IN(P + 9)) {
            PH_IDS
            (void)moe_tables(lds, gcnt);
            const LAS int* tstart = (const LAS int*)(lds + TAB_OFF) + 32;
            for (int rep = 0; rep < NREP(9); ++rep)
            for (int m0 = gw; m0 < T; m0 += 2 * NGW) {
                int te[2][4], tp[2][4]; float tg[2][4];
#pragma unroll
                for (int r = 0; r < 2; ++r) { const int m = m0 + r * NGW; const u32x4 q0 = *(const u32x4*)(TOKI + (size_t)m * 8), q1 = *(const u32x4*)(TOKI + (size_t)m * 8 + 4); const f32x4 gq = *(const f32x4*)(GATE + (size_t)m * 4);
                    te[r][0] = q0[0]; tp[r][0] = q0[1]; te[r][1] = q0[2]; tp[r][1] = q0[3]; te[r][2] = q1[0]; tp[r][2] = q1[1]; te[r][3] = q1[2]; tp[r][3] = q1[3];
                    tg[r][0] = gq[0]; tg[r][1] = gq[1]; tg[r][2] = gq[2]; tg[r][3] = gq[3]; }
                u32x2 yw[2][4][4]; f32x4 xx[2][4];
#pragma unroll
                for (int r = 0; r < 2; ++r) {
#pragma unroll
                    for (int k = 0; k < 4; ++k) { const bf16* yr = YS + ((size_t)tstart[te[r][k]] * 256 + tp[r][k]) * 1024;
#pragma unroll
                        for (int j = 0; j < 4; ++j) yw[r][k][j] = __builtin_nontemporal_load((const u32x2*)(yr + 4 * lane + 256 * j)); }
#pragma unroll
                    for (int j = 0; j < 4; ++j) xx[r][j] = __builtin_nontemporal_load((const f32x4*)(X1 + (size_t)(m0 + r * NGW) * DM + 4 * lane + 256 * j)); }
#pragma unroll
                for (int r = 0; r < 2; ++r) {
                    const int m = m0 + r * NGW, b = m >> 13;
                    const float* g2 = modl + (size_t)b * 6144 + 5 * 1024;
                    f32x4 v[4];
#pragma unroll
                    for (int j = 0; j < 4; ++j) { f32x4 ff = (f32x4){0.f, 0.f, 0.f, 0.f};
#pragma unroll
                        for (int k = 0; k < 4; ++k) { const u32x2 w = yw[r][k][j]; ff += (f32x4){bflo(w[0]), bfhi(w[0]), bflo(w[1]), bfhi(w[1])} * tg[r][k]; }
                        const f32x4 gg = *(const f32x4*)(g2 + 4 * lane + 256 * j); v[j] = xx[r][j] * DN_ALPHA + (gg + 1.0f) * ff; }
                    float mean, rstd; row_stats(v, mean, rstd);
#pragma unroll
                    for (int j = 0; j < 4; ++j) { const int col = 4 * lane + 256 * j; const f32x4 gg = *(const f32x4*)(ln_g + (size_t)(l * 2 + 1) * DM + col), bb = *(const f32x4*)(ln_b + (size_t)(l * 2 + 1) * DM + col);
                        v[j] = (v[j] - mean) * rstd * gg + bb; *(f32x4*)(xnext + (size_t)m * DM + col) = v[j]; }
                    if (l + 1 < DEPTH) { const float* md = MOD + ((size_t)(l + 1) * 4 + b) * 6144; mod_row_store(v, md, md + 1024, HB + (size_t)m * DM, lane); }
                }
            }
            SEAM(P + 9);
        }
    }
#if STAMP_SEL >= 0
    __syncthreads();
    if (bx == 0 && threadIdx.x == 0) args.out[0] = __uint_as_float(MISC[18]);
#endif
#undef IN
#undef SEAM
#undef GRID_BAR
}

extern "C" void kernel_launch(void* const* d_in, const int* in_sizes, int n_in, void* d_out, int out_size, void* d_ws, size_t ws_size, hipStream_t stream) {
    static int grid = 0;
    if (grid == 0) {
        if (n_in != 30 || in_sizes[0] != T * DM || out_size != T * DM || ws_size < WS_END) { fprintf(stderr, "kernel_launch: unexpected problem (n_in %d, in0 %d, out %d, ws %zu)\n", n_in, n_in > 0 ? in_sizes[0] : -1, out_size, ws_size); grid = -1; return; }
        int dev = 0, cus = 0, per_cu = 0;
        if (hipGetDevice(&dev) != hipSuccess || hipDeviceGetAttribute(&cus, hipDeviceAttributeMultiprocessorCount, dev) != hipSuccess) { grid = -1; return; }
        if (hipFuncSetAttribute((const void*)hybrid_fwd, hipFuncAttributeMaxDynamicSharedMemorySize, LDS_BYTES) != hipSuccess) { fprintf(stderr, "kernel_launch: hipFuncSetAttribute failed\n"); grid = -1; return; }
        if (hipOccupancyMaxActiveBlocksPerMultiprocessor(&per_cu, (const void*)hybrid_fwd, NTHR, LDS_BYTES) != hipSuccess || per_cu < 1) { fprintf(stderr, "kernel_launch: occupancy query says %d\n", per_cu); (void)hipGetLastError(); if (per_cu < 1) { grid = -1; return; } }
        grid = cus;
        if (grid > 256) grid = 256;
        if (grid < 128) { grid = -1; return; }
    }
    if (grid < 0) return;
    (void)hipMemsetAsync((char*)d_ws + WS_CTL, 0, CTL_BYTES, stream);
    Args a{};
    for (int i = 0; i < 30; ++i) a.in[i] = d_in[i];
    a.out = (float*)d_out; a.ws = (unsigned char*)d_ws;
    for (int i = 0; i < 32; ++i) { a.invfA[i] = std::pow(10000.0, -(double)i / 32.0); a.invfR[i] = std::pow(10000.0, -(double)i / 31.0); }
    for (int l = 0; l < 4; ++l) a.lam_init[l] = (float)(0.8 - 0.6 * std::exp(-0.3 * l));
    for (int h = 0; h < 4; ++h) { a.lg2f[h] = (float)std::log2(1.0 - std::exp2(-5.0 - h)); a.lg2b[h] = (float)std::log2(1.0 - std::exp2(-5.5 - h)); }
#if MK_SPLIT
    for (int p = 0; p < NPH; ++p) { a.ph_lo = p; a.ph_hi = p + 1; hipLaunchKernelGGL(hybrid_fwd, dim3(grid), dim3(NTHR), LDS_BYTES, stream, a); }
#else
    a.ph_lo = 0; a.ph_hi = NPH;
    hipLaunchKernelGGL(hybrid_fwd, dim3(grid), dim3(NTHR), LDS_BYTES, stream, a);
#endif
}
```

```cpp
#include <hip/hip_runtime.h>
#include <cstdio>
#include <cstdint>
#include <cmath>

#define LAS __attribute__((address_space(3)))
#define GAS __attribute__((address_space(1)))
typedef unsigned short bf16;
typedef short bf16x8 __attribute__((ext_vector_type(8)));
typedef short s16x4 __attribute__((ext_vector_type(4)));
typedef float f32x4 __attribute__((ext_vector_type(4)));
typedef float f32x2 __attribute__((ext_vector_type(2)));
typedef float f32x16 __attribute__((ext_vector_type(16)));
typedef unsigned u32x4 __attribute__((ext_vector_type(4)));
typedef unsigned u32x2 __attribute__((ext_vector_type(2)));
typedef __bf16 bf16x2_t __attribute__((ext_vector_type(2)));

#ifndef STAMP_SEL
#define STAMP_SEL -1
#endif
#ifndef MK_SPLIT
#define MK_SPLIT 0
#endif

constexpr int NB = 4, SEQ = 8192, DM = 1024, T = NB * SEQ, DEPTH = 4;
constexpr int INW = 2816, NE = 32;
constexpr int NTILE_MAX = T * 4 / 256 + NE;
constexpr float LN_EPS = 1e-5f;
constexpr float C2 = 0.125f * 1.4426950408889634f;
constexpr float LOG2E = 1.4426950408889634f;
constexpr float DN_ALPHA = 1.681792830507429f;

constexpr size_t MiB = 1u << 20;
constexpr size_t WS_CTL = 0, CTL_BYTES = 65536;
constexpr size_t WS_MOD = 1 * MiB;
constexpr size_t WS_ROUTW = 1 * MiB + 512 * 1024;
constexpr size_t WS_ROT = 2 * MiB;
constexpr size_t WS_PW = 18 * MiB;
constexpr size_t WS_BB = 23 * MiB;
constexpr size_t WS_WIN = 24 * MiB;
constexpr size_t WS_WOUT = 46 * MiB;
constexpr size_t WS_GLU = 54 * MiB;
constexpr size_t WS_W1S = 56 * MiB;
constexpr size_t WS_TW = 88 * MiB;
constexpr size_t WS_W1 = 248 * MiB;
constexpr size_t WS_W2 = 760 * MiB;
constexpr size_t WS_HB = 1016 * MiB;
constexpr size_t WS_QIMG = 1080 * MiB;
constexpr size_t WS_KIMG = 1112 * MiB;
constexpr size_t WS_VIMG = 1144 * MiB;
constexpr size_t WS_UG2 = 1176 * MiB;
constexpr size_t WS_RET = 1196 * MiB;
constexpr size_t WS_S5S = 1260 * MiB;
constexpr size_t WS_YB = 1268 * MiB;
constexpr size_t WS_RKV = 1284 * MiB;
constexpr size_t WS_RST = 1316 * MiB;
constexpr size_t WS_MIX = 1332 * MiB;
constexpr size_t WS_YPRE = 1396 * MiB;
constexpr size_t WS_X1 = 1524 * MiB;
constexpr size_t WS_XB = 1652 * MiB;
constexpr size_t WS_LIST = 1780 * MiB;
constexpr size_t WS_TOKI = 1784 * MiB;
constexpr size_t WS_GATE = 1785 * MiB;
constexpr size_t WS_A2 = 1786 * MiB;
constexpr size_t WS_YS = 2058 * MiB;
constexpr size_t WS_S5S4 = 2330 * MiB;
constexpr size_t WS_END = 2362 * MiB;

constexpr int CW_TMO = 0, CW_BAR = 1024, CW_CONV = 4608, CW_GCNT = 8192;

constexpr int RING_BYTES = 131072;
constexpr int LDSCTL_OFF = RING_BYTES, MISC_OFF = LDSCTL_OFF + 320, TAB_OFF = LDSCTL_OFF + 512;
constexpr int LDS_BYTES = 147456;
constexpr int NWAVES = 8, NTHR = 512;

#define RLX_AGENT __ATOMIC_RELAXED, __HIP_MEMORY_SCOPE_AGENT
__device__ __forceinline__ unsigned pk2(float lo, float hi) { f32x2 v = {lo, hi}; bf16x2_t b = __builtin_convertvector(v, bf16x2_t); return __builtin_bit_cast(unsigned, b); }
__device__ __forceinline__ float bf2f(unsigned short u) { return __uint_as_float(((unsigned)u) << 16); }
__device__ __forceinline__ float bflo(unsigned u) { return __uint_as_float(u << 16); }
__device__ __forceinline__ float bfhi(unsigned u) { return __uint_as_float(u & 0xffff0000u); }
template <int CTRL> __device__ __forceinline__ float dppadd(float v) { return v + __builtin_bit_cast(float, __builtin_amdgcn_update_dpp(0, __builtin_bit_cast(int, v), CTRL, 0xF, 0xF, true)); }
__device__ __forceinline__ float swap16_add(float v) { float w = v; asm volatile("v_nop\n\tv_nop\n\tv_permlane16_swap_b32 %0, %1\n\tv_nop\n\tv_nop" : "+v"(v), "+v"(w)); return v + w; }
__device__ __forceinline__ float swap32_add(float v) { float w = v; asm volatile("v_nop\n\tv_nop\n\tv_permlane32_swap_b32 %0, %1\n\tv_nop\n\tv_nop" : "+v"(v), "+v"(w)); return v + w; }
__device__ __forceinline__ float swap32_max(float v) { float w = v; asm volatile("v_nop\n\tv_nop\n\tv_permlane32_swap_b32 %0, %1\n\tv_nop\n\tv_nop" : "+v"(v), "+v"(w)); return fmaxf(v, w); }
__device__ __forceinline__ float half_sum(float v) {
    v = dppadd<0xB1>(v); v = dppadd<0x4E>(v); v = dppadd<0x141>(v); v = dppadd<0x140>(v); return swap16_add(v);
}
__device__ __forceinline__ float wave_sum(float v) { return swap32_add(half_sum(v)); }
__device__ __forceinline__ float fexp2(float x) { return __builtin_amdgcn_exp2f(x); }
__device__ __forceinline__ float frcp(float x) { return __builtin_amdgcn_rcpf(x); }
__device__ __forceinline__ float sigmoidf_(float x) { return frcp(1.0f + fexp2(-x * LOG2E)); }
__device__ __forceinline__ int otid() { int t = threadIdx.x; asm volatile("" : "+v"(t)); return t; }
__device__ __forceinline__ int crow(int r, int hi) { return (r & 3) + 8 * (r >> 2) + 4 * hi; }
__device__ __forceinline__ s16x4 vtr(const LAS char* p) { return __builtin_bit_cast(s16x4, __builtin_amdgcn_ds_read_tr16_b64_v4i16((LAS s16x4*)p)); }
__device__ __forceinline__ bf16x8 cat8(s16x4 a, s16x4 b) { return (bf16x8){a[0], a[1], a[2], a[3], b[0], b[1], b[2], b[3]}; }
__device__ __forceinline__ bf16x8 pack8(float a0, float a1, float a2, float a3, float a4, float a5, float a6, float a7) {
    u32x4 w = {pk2(a0, a1), pk2(a2, a3), pk2(a4, a5), pk2(a6, a7)}; return __builtin_bit_cast(bf16x8, w);
}
__device__ __forceinline__ u32x4 pack8u(f32x4 a, f32x4 b) { return (u32x4){pk2(a[0], a[1]), pk2(a[2], a[3]), pk2(b[0], b[1]), pk2(b[2], b[3])}; }

#define XB_TMO      128
#define XB_XCNT(j)  (256  + 64 * (j))
#define XB_XSUB(j)  (1280 + 64 * (j))
#define XB_XGEN(j)  (2304 + 64 * (j))
#define XB_TOP      3328
#define XB_TOPGEN   3392
#define XCD_BAR_WORDS 3456
#define XB_SPIN_CAP (1u << 22)
__device__ __forceinline__ unsigned xb_ld(unsigned* p)              { return __hip_atomic_load(p, __ATOMIC_RELAXED, __HIP_MEMORY_SCOPE_AGENT); }
__device__ __forceinline__ unsigned xb_add(unsigned* p, unsigned v) { return __hip_atomic_fetch_add(p, v, __ATOMIC_RELAXED, __HIP_MEMORY_SCOPE_AGENT); }
__device__ __forceinline__ unsigned xb_xcc_id() { return (unsigned)__builtin_amdgcn_s_getreg((3 << 11) | 20) & 0xFu; }
#define XB_SPIN(cond, bar) do { unsigned _sp = 0; while (cond) { __builtin_amdgcn_s_sleep(1); \
    if ((++_sp & 255u) == 0u) { if (xb_ld(&(bar)[XB_TMO])) break; if (_sp > XB_SPIN_CAP) { atomicAdd(&(bar)[XB_TMO], 1u); break; } } } } while (0)
struct XcdBarrier { unsigned* bar; unsigned x; volatile LAS unsigned* st; };
__device__ __forceinline__ XcdBarrier xcd_barrier_post(unsigned* bar, volatile LAS unsigned* st) {
    XcdBarrier b; b.bar = bar; b.x = xb_xcc_id(); b.st = st;
    if (threadIdx.x == 0) (void)xb_add(&bar[XB_XCNT(b.x)], 1u);
    return b;
}
__device__ __forceinline__ void xcd_barrier_complete(unsigned* bar, unsigned x, unsigned& nloc, unsigned& nx) {
    const unsigned G = gridDim.x * gridDim.y * gridDim.z;
    unsigned sum, cnt, mine, sp = 0u;
    for (;;) {
        sum = 0u; cnt = 0u; mine = 0u;
#pragma unroll
        for (unsigned j = 0; j < 16; ++j) { const unsigned c = xb_ld(&bar[XB_XCNT(j)]); sum += c; cnt += (c > 0u) ? 1u : 0u; mine = (j == x) ? c : mine; }
        if (sum == G) break;
        __builtin_amdgcn_s_sleep(1);
        if ((++sp & 255u) == 0u) { if (xb_ld(&bar[XB_TMO])) break; if (sp > XB_SPIN_CAP) { atomicAdd(&bar[XB_TMO], 1u); break; } }
    }
    nloc = mine > 0u ? mine : 1u; nx = cnt > 0u ? cnt : 1u;
}
__device__ __forceinline__ void xcd_barrier(const XcdBarrier& b) {
    asm volatile("s_waitcnt vmcnt(0)" ::: "memory");
    __syncthreads();
    if (threadIdx.x == 0) {
        unsigned* bar = b.bar;
        __builtin_amdgcn_s_waitcnt(0);
        unsigned nloc = b.st[0], nx = b.st[1];
        if (nloc == 0u) { xcd_barrier_complete(bar, b.x, nloc, nx); b.st[0] = nloc; b.st[1] = nx; }
        const unsigned old = xb_add(&bar[XB_XSUB(b.x)], 1u);
        const unsigned gen = old / nloc;
        if (old + 1u == (gen + 1u) * nloc) {
            __builtin_amdgcn_fence(__ATOMIC_RELEASE, "agent");
            asm volatile("s_waitcnt vmcnt(0)" ::: "memory");
            const unsigned og = xb_add(&bar[XB_TOP], 1u);
            const unsigned tg = og / nx;
            if (og + 1u == (tg + 1u) * nx) xb_add(&bar[XB_TOPGEN], 1u);
            else XB_SPIN(xb_ld(&bar[XB_TOPGEN]) == tg, bar);
            __builtin_amdgcn_fence(__ATOMIC_ACQUIRE, "agent");
            xb_add(&bar[XB_XGEN(b.x)], 1u);
            asm volatile("s_waitcnt vmcnt(0)" ::: "memory");
        } else {
            XB_SPIN(xb_ld(&bar[XB_XGEN(b.x)]) == gen, bar);
            __builtin_amdgcn_fence(__ATOMIC_ACQUIRE, "agent");
            asm volatile("s_waitcnt vmcnt(0)" ::: "memory");
        }
    }
    __syncthreads();
}

namespace pg8 {
constexpr int BM = 256, BK = 64, HALF = 128, HTB = HALF * BK * 2, STAGE_BYTES = 8 * HTB, NXCD = 8, WGM = 8;
__device__ __forceinline__ int lds_byte(int r, int c) { const int st = (r >> 4) * 2 + (c >> 5), rr = r & 15, cc = c & 31, ob = rr * 64 + cc * 2; return st * 1024 + (ob ^ (((ob >> 9) & 1) << 5)); }
__device__ __forceinline__ void stage_rc(int b, int& R, int& C) { const int st = b / 1024, sb = b % 1024, swz = sb ^ (((sb >> 9) & 1) << 5); R = (st >> 1) * 16 + swz / 64; C = (st & 1) * 32 + (swz % 64) / 2; }
__device__ __forceinline__ int perm32(int rho) { const int n = rho >> 4, i = rho & 15; return 8 * (i >> 2) + 4 * n + (i & 3); }
struct Unit { int pm, pn, g; };

__device__ __forceinline__ bool static_order(int i, int G, int c, int nM, int nN, int& pm, int& pn) {
    const int nwg = nM * nN; const long L = (long)i * G + c; if (L >= nwg) return false;
    int wgid = (int)L; { const int q = nwg / NXCD, r = nwg % NXCD, xcd = wgid % NXCD, off = wgid / NXCD; wgid = (xcd < r ? xcd * (q + 1) : r * (q + 1) + (xcd - r) * q) + off; }
    const int nig = WGM * nN, gid = wgid / nig, fm = gid * WGM, gsz = (nM - fm) < WGM ? (nM - fm) : WGM;
    pm = fm + ((wgid % nig) % gsz); pn = (wgid % nig) / gsz; return true;
}

template <class Epi, class Sched, bool GATHER>
__device__ __forceinline__ void gemm_phase(LAS unsigned char* lds, const int K, const int lda, const int ldb, const Sched& S, const Epi& E) {
    const int tid = otid(), wid = __builtin_amdgcn_readfirstlane(tid >> 6), lane = tid & 63, wr = wid >> 2, wc = wid & 3, fr = lane & 15, fq = lane >> 4;
    const int nt = K / BK;
    int Rr[2], Cc[2];
    unsigned voffB[2], vAc[2][2];
#pragma unroll
    for (int i = 0; i < 2; ++i) { int R, C; stage_rc(tid * 16 + i * 8192, R, C); Rr[i] = R; Cc[i] = C; const int Rb = (R & ~31) + perm32(R & 31);
        voffB[i] = (unsigned)(Rb * ldb + C) * 2u;
#pragma unroll
        for (int h = 0; h < 2; ++h) vAc[h][i] = (unsigned)((GATHER ? 0 : R) * lda + C) * 2u; }
    const size_t kstep = (size_t)(BK * 2);
    const size_t hstepB = (size_t)HALF * ldb * 2;
    const size_t hstepA = GATHER ? (size_t)0 : (size_t)HALF * lda * 2;
    const unsigned ldsw = (unsigned)wid * 1024u;
    const int aoff = lds_byte(wr * 64 + fr, fq * 8), boff = lds_byte(wc * 32 + fr, fq * 8);
    LAS int* rowtab = (LAS int*)(lds + TAB_OFF + 2048);
#define PG8_SA(b, h) (((b) * 2 + (h)) * HTB)
#define PG8_SB(b, h) ((4 + (b) * 2 + (h)) * HTB)
#define PG8_STAGE(bufoff, gbase, v0, v1) do { \
        __builtin_amdgcn_global_load_lds((const unsigned*)((const char*)(gbase) + (v0)), (LAS unsigned*)(lds + (bufoff) + ldsw), 16, 0, 0); \
        __builtin_amdgcn_global_load_lds((const unsigned*)((const char*)(gbase) + (v1)), (LAS unsigned*)(lds + (bufoff) + ldsw + 8192), 16, 0, 0); } while (0)
#define PG8_STAGEB(bufoff, gbase) PG8_STAGE(bufoff, gbase, voffB[0], voffB[1])
#define PG8_LDA(dst, b, h) do { _Pragma("unroll") for (int m = 0; m < 4; ++m) _Pragma("unroll") for (int k = 0; k < 2; ++k) dst[m][k] = *(const LAS bf16x8*)(lds + PG8_SA(b, h) + aoff + m * 2048 + k * 1024); } while (0)
#define PG8_LDB(dst, b, h) do { _Pragma("unroll") for (int n = 0; n < 2; ++n) _Pragma("unroll") for (int k = 0; k < 2; ++k) dst[n][k] = *(const LAS bf16x8*)(lds + PG8_SB(b, h) + boff + n * 2048 + k * 1024); } while (0)
#define PG8_MMA(ai, bj, At, Bt) do { __builtin_amdgcn_s_setprio(1); _Pragma("unroll") for (int m = 0; m < 4; ++m) _Pragma("unroll") for (int n = 0; n < 2; ++n) _Pragma("unroll") for (int k = 0; k < 2; ++k) \
        acc[ai][bj][m][n] = __builtin_amdgcn_mfma_f32_16x16x32_bf16(Bt[n][k], At[m][k], acc[ai][bj][m][n], 0, 0, 0); __builtin_amdgcn_s_setprio(0); } while (0)
#define PG8_WAIT_V(n) asm volatile("s_waitcnt vmcnt(" #n ")" ::: "memory")
#define PG8_WAIT_L(n) asm volatile("s_waitcnt lgkmcnt(" #n ")" ::: "memory")
#define PG8_BAR __builtin_amdgcn_s_barrier()
#define PG8_SCHED __builtin_amdgcn_sched_barrier(0)
    Unit cur, nxt; int ui = 0;
    if (!S.next(0, cur)) return;
    f32x4 acc[2][2][4][2];
#pragma unroll
    for (int a = 0; a < 2; ++a)
#pragma unroll
        for (int b = 0; b < 2; ++b)
#pragma unroll
            for (int m = 0; m < 4; ++m)
#pragma unroll
                for (int n = 0; n < 2; ++n) acc[a][b][m][n] = (f32x4){0.f, 0.f, 0.f, 0.f};
    bf16x8 At[4][2], B0[2][2], B1[2][2];
    const char* cA = S.a_base(cur); const char* cB = S.b_base(cur);
    if constexpr (GATHER) {
        if (tid < 256) rowtab[tid] = S.a_row(cur, tid);
        PG8_WAIT_V(0); PG8_WAIT_L(0); PG8_BAR;
#pragma unroll
        for (int h = 0; h < 2; ++h)
#pragma unroll
            for (int i = 0; i < 2; ++i) vAc[h][i] = (unsigned)(rowtab[h * HALF + Rr[i]] * lda + Cc[i]) * 2u;
    }
    PG8_STAGEB(PG8_SB(0, 0), cB); PG8_STAGEB(PG8_SB(0, 1), cB + hstepB); PG8_STAGE(PG8_SA(0, 0), cA, vAc[0][0], vAc[0][1]); PG8_STAGE(PG8_SA(0, 1), cA + hstepA, vAc[1][0], vAc[1][1]);
    if (wr == 1) PG8_BAR;
    PG8_WAIT_V(2); PG8_BAR;
    PG8_STAGEB(PG8_SB(1, 0), cB + kstep); PG8_STAGE(PG8_SA(1, 0), cA + kstep, vAc[0][0], vAc[0][1]); PG8_STAGEB(PG8_SB(1, 1), cB + hstepB + kstep);
    PG8_WAIT_V(6); PG8_BAR;
    for (;;) {
        const bool has_next = S.next(ui + 1, nxt);
        const char* nA = has_next ? S.a_base(nxt) : cA; const char* nB = has_next ? S.b_base(nxt) : cB;
        if constexpr (GATHER) {
            if (tid < 256) rowtab[((ui + 1) & 1) * 256 + tid] = has_next ? S.a_row(nxt, tid) : 0;
            PG8_WAIT_V(0);
        }
#pragma unroll 1
        for (int t = 0; t < nt; t += 2) {
            const bool last = (t == nt - 2);
            const char* a1 = cA + (size_t)(t + 1) * kstep;
            const char* a2 = last ? nA : cA + (size_t)(t + 2) * kstep; const char* b2 = last ? nB : cB + (size_t)(t + 2) * kstep;
            const char* a3 = a2 + kstep; const char* b3 = b2 + kstep;
            unsigned v2[2][2];
#pragma unroll
            for (int h = 0; h < 2; ++h)
#pragma unroll
                for (int i = 0; i < 2; ++i) v2[h][i] = vAc[h][i];
            if constexpr (GATHER) { if (last && has_next) {
#pragma unroll
                for (int h = 0; h < 2; ++h)
#pragma unroll
                    for (int i = 0; i < 2; ++i) v2[h][i] = (unsigned)(rowtab[((ui + 1) & 1) * 256 + h * HALF + Rr[i]] * lda + Cc[i]) * 2u; } }
            PG8_LDB(B0, 0, 0); PG8_LDB(B1, 0, 1); PG8_SCHED; PG8_LDA(At, 0, 0); PG8_STAGE(PG8_SA(1, 1), a1 + hstepA, vAc[1][0], vAc[1][1]);
            PG8_WAIT_V(8); PG8_WAIT_L(0); PG8_BAR; PG8_MMA(0, 0, At, B0); PG8_MMA(0, 1, At, B1); PG8_BAR; PG8_SCHED;
            PG8_LDA(At, 0, 1); PG8_STAGEB(PG8_SB(0, 0), b2); PG8_STAGEB(PG8_SB(0, 1), b2 + hstepB); PG8_STAGE(PG8_SA(0, 0), a2, v2[0][0], v2[0][1]);
            PG8_WAIT_V(8); PG8_WAIT_L(0); PG8_BAR; PG8_MMA(1, 0, At, B0); PG8_MMA(1, 1, At, B1); PG8_BAR; PG8_SCHED;
            PG8_LDB(B0, 1, 0); PG8_LDB(B1, 1, 1); PG8_SCHED; PG8_LDA(At, 1, 0); PG8_STAGE(PG8_SA(0, 1), a2 + hstepA, v2[1][0], v2[1][1]);
            PG8_WAIT_V(8); PG8_WAIT_L(0); PG8_BAR; PG8_MMA(0, 0, At, B0); PG8_MMA(0, 1, At, B1); PG8_BAR; PG8_SCHED;
            PG8_LDA(At, 1, 1); PG8_STAGEB(PG8_SB(1, 0), b3); PG8_STAGEB(PG8_SB(1, 1), b3 + hstepB); PG8_STAGE(PG8_SA(1, 0), a3, v2[0][0], v2[0][1]);
            PG8_WAIT_V(8); PG8_WAIT_L(0); PG8_BAR; PG8_MMA(1, 0, At, B0); PG8_MMA(1, 1, At, B1); PG8_BAR; PG8_SCHED;
        }
        if (wr == 0) PG8_BAR;
        { int efr = fr, efq = fq; asm volatile("" : "+v"(efr), "+v"(efq)); E(acc, cur, wr, wc, efr, efq); }
        if (!has_next) break;
#pragma unroll
        for (int a = 0; a < 2; ++a)
#pragma unroll
            for (int b = 0; b < 2; ++b)
#pragma unroll
                for (int m = 0; m < 4; ++m)
#pragma unroll
                    for (int n = 0; n < 2; ++n) acc[a][b][m][n] = (f32x4){0.f, 0.f, 0.f, 0.f};
        cur = nxt; cA = nA; cB = nB; ++ui;
        if constexpr (GATHER) {
#pragma unroll
            for (int h = 0; h < 2; ++h)
#pragma unroll
                for (int i = 0; i < 2; ++i) vAc[h][i] = (unsigned)(rowtab[(ui & 1) * 256 + h * HALF + Rr[i]] * lda + Cc[i]) * 2u;
        }
        if (wr == 1) PG8_BAR;
    }
    PG8_WAIT_V(0);
    PG8_BAR;
#undef PG8_SA
#undef PG8_SB
#undef PG8_STAGE
#undef PG8_STAGEB
#undef PG8_LDA
#undef PG8_LDB
#undef PG8_MMA
#undef PG8_WAIT_V
#undef PG8_WAIT_L
#undef PG8_BAR
#undef PG8_SCHED
}
}
using pg8::Unit;

struct DenseSched {
    int nM, nN, G, c; const char* A; const char* Bt; size_t atile, btile;
    __device__ __forceinline__ bool next(int i, Unit& u) const { u.g = 0; return pg8::static_order(i, G, c, nM, nN, u.pm, u.pn); }
    __device__ __forceinline__ const char* a_base(const Unit& u) const { return A + (size_t)u.pm * atile; }
    __device__ __forceinline__ const char* b_base(const Unit& u) const { return Bt + (size_t)u.pn * btile; }
    __device__ __forceinline__ int a_row(const Unit&, int) const { return 0; }
};
struct GroupSched {
    int nN, G, c; const char* A; const char* Bt; size_t agroup, bgroup, atile, btile;
    __device__ __forceinline__ bool next(int i, Unit& u) const { const long L = (long)i * G + c; if (c < 0 || L >= 16 * 2 * nN) return false; const int per = 2 * nN; u.g = (int)L / per; const int r = (int)L % per; u.pm = r % 2; u.pn = r / 2; return true; }
    __device__ __forceinline__ const char* a_base(const Unit& u) const { return A + (size_t)u.g * agroup + (size_t)u.pm * atile; }
    __device__ __forceinline__ const char* b_base(const Unit& u) const { return Bt + (size_t)u.g * bgroup + (size_t)u.pn * btile; }
    __device__ __forceinline__ int a_row(const Unit&, int) const { return 0; }
};
struct S5G1Sched {
    int G, c; const char* A; const char* Bt;
    __device__ __forceinline__ bool next(int i, Unit& u) const { const long L = (long)i * G + c; if (L >= 128) return false; u.g = (int)L >> 3; u.pm = (int)L & 1; u.pn = ((int)L >> 1) & 3; return true; }
    __device__ __forceinline__ const char* a_base(const Unit& u) const { return A + ((size_t)u.g * 512 + u.pm * 256) * 1280 * 2 + (size_t)u.pn * 512; }
    __device__ __forceinline__ const char* b_base(const Unit& u) const { return Bt + (size_t)u.g * 256 * 1024 * 2 + (size_t)u.pn * 512; }
    __device__ __forceinline__ int a_row(const Unit&, int) const { return 0; }
};
struct MoeSched {
    int nM, nN, G, c; const char* A; const char* W; size_t wexp, atile, btile;
    const LAS int* cnt; const LAS int* tstart; const LAS unsigned char* tile_e; const int* list;
    __device__ __forceinline__ bool next(int i, Unit& u) const { const bool ok = pg8::static_order(i, G, c, nM, nN, u.pm, u.pn); u.g = ok ? (int)tile_e[u.pm] : 0; return ok; }
    __device__ __forceinline__ const char* a_base(const Unit& u) const { return A + (size_t)u.pm * atile; }
    __device__ __forceinline__ const char* b_base(const Unit& u) const { return W + (size_t)u.g * wexp + (size_t)u.pn * btile; }
    __device__ __forceinline__ int a_row(const Unit& u, int r) const { const int slot = (u.pm - tstart[u.g]) * 256 + r; return slot < cnt[u.g] ? list[(size_t)u.g * T + slot] : 0; }
};

typedef f32x4 Acc[2][2][4][2];
struct EpiProj {
    bf16 *Qimg, *Kimg, *Vimg, *Ug2, *RET; const float *cosA, *sinA, *cosR, *sinR;
    __device__ __forceinline__ void operator()(const Acc& acc, const Unit& u, int wr, int wc, int fr, int fq) const {
        const int pn = u.pn;
#pragma unroll
        for (int ai = 0; ai < 2; ++ai)
#pragma unroll
            for (int m = 0; m < 4; ++m) {
                const int row = u.pm * 256 + ai * 128 + wr * 64 + m * 16 + fr; const int b = row >> 13, t = row & 8191;
                if (pn < 4 || pn == 7 || pn == 8) {
                    const size_t to = (size_t)row * 32 + 8 * fq;
                    const float* ct = (pn < 4 ? cosA : cosR) + to; const float* st = (pn < 4 ? sinA : sinR) + to;
                    const f32x4 c0 = *(const f32x4*)ct, c1 = *(const f32x4*)(ct + 4), s0 = *(const f32x4*)st, s1 = *(const f32x4*)(st + 4);
                    const f32x4 xa0 = acc[ai][0][m][0], xa1 = acc[ai][0][m][1], xb0 = acc[ai][1][m][0], xb1 = acc[ai][1][m][1];
                    const float sc = (pn < 2) ? C2 : (pn == 8 ? 0.125f : 1.0f);
                    const f32x4 o10 = (xa0 * c0 - xb0 * s0) * sc, o11 = (xa1 * c1 - xb1 * s1) * sc, o20 = (xb0 * c0 + xa0 * s0) * sc, o21 = (xb1 * c1 + xa1 * s1) * sc;
                    const u32x4 w1 = pack8u(o10, o11), w2 = pack8u(o20, o21);
                    if (pn < 2) { const int hc = 4 * pn + wc; bf16* p = Qimg + ((size_t)(b * 8 + hc) * 8192 + t) * 64 + 8 * fq; *(u32x4*)p = w1; *(u32x4*)(p + 32) = w2; }
                    else if (pn < 4) { const int hc = 4 * (pn - 2) + wc; bf16* p = Kimg + ((size_t)((b * 8 + hc) * 128 + (t >> 6)) * 8 + fq) * 512 + (t & 63) * 8; *(u32x4*)p = w1; *(u32x4*)(p + 4 * 512) = w2; }
                    else { bf16* p = RET + (size_t)row * 1024 + (pn - 7) * 256 + 64 * wc + 8 * fq; *(u32x4*)p = w1; *(u32x4*)(p + 32) = w2; }
                } else {
#pragma unroll
                    for (int bj = 0; bj < 2; ++bj) {
                        const u32x4 w = pack8u(acc[ai][bj][m][0], acc[ai][bj][m][1]);
                        bf16* p;
                        if (pn < 6) { const int h = 2 * (pn - 4) + bj; p = Vimg + ((size_t)((b * 4 + h) * 128 + (t >> 6)) * 4 + wc) * 2048 + (t & 63) * 32 + 8 * fq; }
                        else if (pn == 6) { const int g = 8 * bj + 2 * wc + (fq >> 1); p = Ug2 + ((size_t)(g * 512 + b * 128 + (t >> 6))) * 1280 + (t & 63) * 16 + 8 * (fq & 1); }
                        else { p = RET + (size_t)row * 1024 + 512 + (pn - 9) * 256 + 128 * bj + 32 * wc + 8 * fq; }
                        *(u32x4*)p = w;
                    }
                }
                asm volatile("" ::: "memory");
            }
    }
};
struct EpiS5S {
    float* S;
    __device__ __forceinline__ void operator()(const Acc& acc, const Unit& u, int wr, int wc, int fr, int fq) const {
#pragma unroll
        for (int ai = 0; ai < 2; ++ai)
#pragma unroll
            for (int m = 0; m < 4; ++m) { float* rowp = S + (size_t)u.pn * (16 * 512 * 256) + ((size_t)u.g * 512 + u.pm * 256 + ai * 128 + wr * 64 + m * 16 + fr) * 256 + wc * 32 + 8 * fq;
#pragma unroll
                for (int bj = 0; bj < 2; ++bj) { *(f32x4*)(rowp + bj * 128) = acc[ai][bj][m][0]; *(f32x4*)(rowp + bj * 128 + 4) = acc[ai][bj][m][1]; } }
    }
};
struct EpiS5Y {
    bf16* Yb; const bf16* Ug2; const float* dskip;
    __device__ __forceinline__ void operator()(const Acc& acc, const Unit& u, int wr, int wc, int fr, int fq) const {
        int colb[2], chb[2]; f32x4 dk[2][2];
#pragma unroll
        for (int bj = 0; bj < 2; ++bj) { colb[bj] = u.pn * 256 + bj * 128 + wc * 32 + 8 * fq; chb[bj] = u.g * 16 + (colb[bj] & 15); dk[bj][0] = *(const f32x4*)(dskip + chb[bj]); dk[bj][1] = *(const f32x4*)(dskip + chb[bj] + 4); }
        const int bc0 = u.pm * 256 + wr * 64 + fr;
#define S5Y_BC(it) (bc0 + ((it) >> 3) * 128 + (((it) >> 1) & 3) * 16)
        u32x4 ub[4];
#pragma unroll
        for (int it = 0; it < 4; ++it) ub[it] = *(const u32x4*)(Ug2 + ((size_t)u.g * 512 + S5Y_BC(it)) * 1280 + colb[it & 1]);
        asm volatile("" ::: "memory");
#pragma unroll
        for (int it = 0; it < 16; ++it) {
            const int ai = it >> 3, m = (it >> 1) & 3, bj = it & 1; const int bc = S5Y_BC(it);
            const u32x4 uu = ub[it & 3];
            if (it + 4 < 16) ub[it & 3] = *(const u32x4*)(Ug2 + ((size_t)u.g * 512 + S5Y_BC(it + 4)) * 1280 + colb[(it + 4) & 1]);
            const int tok = bc * 64 + (colb[bj] >> 4);
            const f32x4 d0 = dk[bj][0], d1 = dk[bj][1];
            float y[8] = {acc[ai][bj][m][0][0] + d0[0] * bflo(uu[0]), acc[ai][bj][m][0][1] + d0[1] * bfhi(uu[0]), acc[ai][bj][m][0][2] + d0[2] * bflo(uu[1]), acc[ai][bj][m][0][3] + d0[3] * bfhi(uu[1]),
                          acc[ai][bj][m][1][0] + d1[0] * bflo(uu[2]), acc[ai][bj][m][1][1] + d1[1] * bfhi(uu[2]), acc[ai][bj][m][1][2] + d1[2] * bflo(uu[3]), acc[ai][bj][m][1][3] + d1[3] * bfhi(uu[3])};
#pragma unroll
            for (int e = 0; e < 8; ++e) { const float v = y[e]; const float uarg = 1.5957691216057308f * (v + 0.044715f * v * v * v); y[e] = v * sigmoidf_(uarg); }
            *(u32x4*)(Yb + (size_t)tok * 256 + chb[bj]) = (u32x4){pk2(y[0], y[1]), pk2(y[2], y[3]), pk2(y[4], y[5]), pk2(y[6], y[7])};
            asm volatile("" ::: "memory");
        }
#undef S5Y_BC
    }
};
struct EpiGlu {
    bf16* MIX; const float* bias;
    __device__ __forceinline__ void operator()(const Acc& acc, const Unit& u, int wr, int wc, int fr, int fq) const {
        const int col = u.pn * 128 + wc * 32 + 8 * fq;
#pragma unroll
        for (int ai = 0; ai < 2; ++ai)
#pragma unroll
            for (int m = 0; m < 4; ++m) { const int row = u.pm * 256 + ai * 128 + wr * 64 + m * 16 + fr;
                const f32x4 ba0 = *(const f32x4*)(bias + col), ba1 = *(const f32x4*)(bias + col + 4), bb0 = *(const f32x4*)(bias + 256 + col), bb1 = *(const f32x4*)(bias + 256 + col + 4);
                const f32x4 a0 = acc[ai][0][m][0] + ba0, a1 = acc[ai][0][m][1] + ba1, g0 = acc[ai][1][m][0] + bb0, g1 = acc[ai][1][m][1] + bb1;
                f32x4 o0, o1;
#pragma unroll
                for (int e = 0; e < 4; ++e) { o0[e] = a0[e] * sigmoidf_(g0[e]); o1[e] = a1[e] * sigmoidf_(g1[e]); }
                *(u32x4*)(MIX + (size_t)row * 1024 + 512 + col) = pack8u(o0, o1); asm volatile("" ::: "memory"); }
    }
};
struct EpiOut {
    bf16* YM; const float* mod;
    __device__ __forceinline__ void operator()(const Acc& acc, const Unit& u, int wr, int wc, int fr, int fq) const {
        const int b = (u.pm * 256) >> 13;
        f32x4 gv[2][2];
#pragma unroll
        for (int bj = 0; bj < 2; ++bj) { const float* gp = mod + (size_t)b * 6144 + 2048 + u.pn * 256 + bj * 128 + wc * 32 + 8 * fq; gv[bj][0] = *(const f32x4*)gp; gv[bj][1] = *(const f32x4*)(gp + 4); }
#pragma unroll
        for (int bj = 0; bj < 2; ++bj) { const int col = u.pn * 256 + bj * 128 + wc * 32 + 8 * fq;
            const f32x4 g0 = gv[bj][0] + 1.0f, g1 = gv[bj][1] + 1.0f;
#pragma unroll
            for (int ai = 0; ai < 2; ++ai)
#pragma unroll
                for (int m = 0; m < 4; ++m) { const int row = u.pm * 256 + ai * 128 + wr * 64 + m * 16 + fr;
                    *(u32x4*)(YM + (size_t)row * 1024 + col) = pack8u(g0 * acc[ai][bj][m][0], g1 * acc[ai][bj][m][1]); } }
    }
};
struct EpiMoe1 {
    bf16* A2; const float* b1;
    __device__ __forceinline__ void operator()(const Acc& acc, const Unit& u, int wr, int wc, int fr, int fq) const {
        const int j0 = u.pn * 128 + wc * 32 + 8 * fq;
        const float* bp = b1 + (size_t)u.g * 2048 + 2 * j0;
        const f32x4 q0 = *(const f32x4*)bp, q1 = *(const f32x4*)(bp + 4), q2 = *(const f32x4*)(bp + 8), q3 = *(const f32x4*)(bp + 12);
#pragma unroll
        for (int ai = 0; ai < 2; ++ai)
#pragma unroll
            for (int m = 0; m < 4; ++m) { const size_t slot = (size_t)u.pm * 256 + ai * 128 + wr * 64 + m * 16 + fr;
                const float bg[8] = {q0[0], q0[2], q1[0], q1[2], q2[0], q2[2], q3[0], q3[2]}, bl[8] = {q0[1], q0[3], q1[1], q1[3], q2[1], q2[3], q3[1], q3[3]};
                float o[8];
#pragma unroll
                for (int e = 0; e < 8; ++e) { float zg = acc[ai][0][m][e >> 2][e & 3] + bg[e], zl = acc[ai][1][m][e >> 2][e & 3] + bl[e];
                    zg = fminf(zg, 7.0f); zl = fminf(fmaxf(zl, -7.0f), 7.0f); o[e] = zg * sigmoidf_(1.702f * zg) * (zl + 1.0f); }
                *(u32x4*)(A2 + slot * 1024 + j0) = (u32x4){pk2(o[0], o[1]), pk2(o[2], o[3]), pk2(o[4], o[5]), pk2(o[6], o[7])}; asm volatile("" ::: "memory"); }
    }
};
struct EpiMoe2 {
    bf16* YS; const float* b2;
    __device__ __forceinline__ void operator()(const Acc& acc, const Unit& u, int wr, int wc, int fr, int fq) const {
        f32x4 cb[2][2];
#pragma unroll
        for (int bj = 0; bj < 2; ++bj) { const float* bp = b2 + (size_t)u.g * 1024 + u.pn * 256 + bj * 128 + wc * 32 + 8 * fq; cb[bj][0] = *(const f32x4*)bp; cb[bj][1] = *(const f32x4*)(bp + 4); }
#pragma unroll
        for (int bj = 0; bj < 2; ++bj) { const int col = u.pn * 256 + bj * 128 + wc * 32 + 8 * fq;
            const f32x4 c0 = cb[bj][0], c1 = cb[bj][1];
#pragma unroll
            for (int ai = 0; ai < 2; ++ai)
#pragma unroll
                for (int m = 0; m < 4; ++m) { const size_t slot = (size_t)u.pm * 256 + ai * 128 + wr * 64 + m * 16 + fr;
                    *(u32x4*)(YS + slot * 1024 + col) = pack8u(acc[ai][bj][m][0] + c0, acc[ai][bj][m][1] + c1); } asm volatile("" ::: "memory"); }
    }
};

struct Args {
    const void* in[30]; float* out; unsigned char* ws;
    double invfA[32], invfR[32];
    float lam_init[4];
    float lg2f[4], lg2b[4];
    int ph_lo, ph_hi;
};

template <int PERM>
__device__ __forceinline__ int perm_row(int o) {
    if (PERM == 1) { const int pn = o >> 8; if (pn < 4 || pn == 7 || pn == 8) { const int x = o & 255; return (o & ~255) + 128 * ((x >> 5) & 1) + 32 * (x >> 6) + (x & 31); } return o; }
    if (PERM == 2) return (o >> 8) * 256 + 128 * (o & 1) + ((o >> 1) & 127);
    if (PERM == 3) return 256 * ((o >> 7) & 1) + 128 * (o >> 8) + (o & 127);
    return o;
}
template <int PERM, int PART>
__device__ __forceinline__ void transpose_part(const float* W, int K, int N, bf16* WT, LAS unsigned* scr, int item, int lane, float (&v)[32], int h) {
    const int nblk = N / 64, kb = item / nblk, nb = item % nblk, k0 = 64 * kb, n0 = 64 * nb;
    if constexpr (PART == 0) {
        const float* p = W + (size_t)(k0 + 32 * h) * N + n0 + lane;
#pragma unroll
        for (int i = 0; i < 32; ++i) v[i] = __builtin_nontemporal_load(p + (size_t)i * N);
    } else if constexpr (PART == 1) {
#pragma unroll
        for (int i = 0; i < 16; ++i) scr[lane * 33 + 16 * h + i] = pk2(v[2 * i], v[2 * i + 1]);
    } else {
        asm volatile("s_waitcnt lgkmcnt(0)" ::: "memory");
        const int c = lane & 7;
#pragma unroll
        for (int j = 0; j < 8; ++j) { const int n = (lane >> 3) + 8 * j; const LAS unsigned* s = scr + n * 33 + 4 * c;
            u32x4 o; o.x = s[0]; o.y = s[1]; o.z = s[2]; o.w = s[3];
            *(u32x4*)(WT + (size_t)perm_row<PERM>(n0 + n) * K + k0 + 8 * c) = o; }
        asm volatile("s_waitcnt lgkmcnt(0)" ::: "memory");
    }
}
__device__ __forceinline__ void sincos_rev(double ang, float& c, float& s) {
    double rev = ang * 0.15915494309189535; rev -= __builtin_rint(rev); const float r = (float)rev;
    c = __builtin_amdgcn_cosf(r); s = __builtin_amdgcn_sinf(r);
}

__device__ __forceinline__ void row_stats(const f32x4 (&v)[4], float& mean, float& rstd) {
    float s = 0.f;
#pragma unroll
    for (int j = 0; j < 4; ++j) s += (v[j][0] + v[j][1]) + (v[j][2] + v[j][3]);
    mean = wave_sum(s) * (1.f / DM); float q = 0.f;
#pragma unroll
    for (int j = 0; j < 4; ++j) { const f32x4 d = v[j] - mean; q += (d[0] * d[0] + d[1] * d[1]) + (d[2] * d[2] + d[3] * d[3]); }
    rstd = __builtin_amdgcn_rsqf(wave_sum(q) * (1.f / DM) + LN_EPS);
}
__device__ __forceinline__ void mod_row_store(const f32x4 (&v)[4], const float* sh, const float* sc, bf16* orow, int lane) {
    float mean, rstd; row_stats(v, mean, rstd);
#pragma unroll
    for (int j = 0; j < 4; ++j) { const int col = 4 * lane + 256 * j; const f32x4 a = *(const f32x4*)(sc + col), b = *(const f32x4*)(sh + col);
        const f32x4 h = (v[j] - mean) * rstd * (a + 1.0f) + b; *(u32x2*)(orow + col) = (u32x2){pk2(h[0], h[1]), pk2(h[2], h[3])}; }
}

__device__ __forceinline__ void swap32x4(float& a0, float& b0, float& a1, float& b1, float& a2, float& b2, float& a3, float& b3) {
    asm volatile("v_nop\n\tv_nop\n\tv_permlane32_swap_b32 %0, %1\n\tv_permlane32_swap_b32 %2, %3\n\tv_permlane32_swap_b32 %4, %5\n\tv_permlane32_swap_b32 %6, %7\n\tv_nop\n\tv_nop"
                 : "+v"(a0), "+v"(b0), "+v"(a1), "+v"(b1), "+v"(a2), "+v"(b2), "+v"(a3), "+v"(b3)); }
__device__ __forceinline__ void swap16x4(float& a0, float& b0, float& a1, float& b1, float& a2, float& b2, float& a3, float& b3) {
    asm volatile("v_nop\n\tv_nop\n\tv_permlane16_swap_b32 %0, %1\n\tv_permlane16_swap_b32 %2, %3\n\tv_permlane16_swap_b32 %4, %5\n\tv_permlane16_swap_b32 %6, %7\n\tv_nop\n\tv_nop"
                 : "+v"(a0), "+v"(b0), "+v"(a1), "+v"(b1), "+v"(a2), "+v"(b2), "+v"(a3), "+v"(b3)); }
template <int CTRL> __device__ __forceinline__ float dppmov(float v) { return __builtin_bit_cast(float, __builtin_amdgcn_update_dpp(0, __builtin_bit_cast(int, v), CTRL, 0xF, 0xF, true)); }
__device__ __forceinline__ float wave_max(float v) {
    v = fmaxf(v, dppmov<0xB1>(v)); v = fmaxf(v, dppmov<0x4E>(v)); v = fmaxf(v, dppmov<0x141>(v)); v = fmaxf(v, dppmov<0x140>(v));
    { float w = v; asm volatile("v_nop\n\tv_nop\n\tv_permlane16_swap_b32 %0, %1\n\tv_nop\n\tv_nop" : "+v"(v), "+v"(w)); v = fmaxf(v, w); }
    return swap32_max(v);
}
struct Top4 { float t0, t1, t2, t3; int i0, i1, i2, i3; };
__device__ __forceinline__ void top4_init(Top4& q) { q.t0 = q.t1 = q.t2 = q.t3 = -INFINITY; q.i0 = q.i1 = q.i2 = q.i3 = 0; }
__device__ __forceinline__ void top4_insert(Top4& q, float x, int e) {
    const bool c3 = x > q.t3; q.t3 = c3 ? x : q.t3; q.i3 = c3 ? e : q.i3;
    const bool c2 = q.t3 > q.t2; { const float a = q.t2, b = q.t3; const int ia = q.i2, ib = q.i3; q.t2 = c2 ? b : a; q.t3 = c2 ? a : b; q.i2 = c2 ? ib : ia; q.i3 = c2 ? ia : ib; }
    const bool c1 = q.t2 > q.t1; { const float a = q.t1, b = q.t2; const int ia = q.i1, ib = q.i2; q.t1 = c1 ? b : a; q.t2 = c1 ? a : b; q.i1 = c1 ? ib : ia; q.i2 = c1 ? ia : ib; }
    const bool c0 = q.t1 > q.t0; { const float a = q.t0, b = q.t1; const int ia = q.i0, ib = q.i1; q.t0 = c0 ? b : a; q.t1 = c0 ? a : b; q.i0 = c0 ? ib : ia; q.i1 = c0 ? ia : ib; }
}

__device__ __forceinline__ void attn_unit(LAS unsigned char* lds, const bf16* Qimg, const bf16* Kimg, const bf16* Vimg, bf16* MIX, const int b, const int h, const int qb,
                                          const float lam, const float* subg, const float outscale) {
    const int tid = otid(), lane = tid & 63, r32 = lane & 31, hi = lane >> 5; const int wid = __builtin_amdgcn_readfirstlane(tid >> 6);
    const int comp = wid & 1, qsub = (wid >> 1) & 3, grp = wid >> 2, hc = 2 * h + comp;
    const bf16* Qw = Qimg + ((size_t)(b * 8 + hc) * 8192 + qb * 128 + qsub * 32 + r32) * 64;
    bf16x8 qr[4];
#pragma unroll
    for (int d0 = 0; d0 < 4; ++d0) qr[d0] = *(const bf16x8*)(Qw + d0 * 16 + hi * 8);
    asm volatile("s_waitcnt vmcnt(0)" ::: "memory");
    const bf16* K1 = Kimg + (size_t)((b * 8 + 2 * h) * 128) * 4096 + tid * 8;
    const bf16* K2 = Kimg + (size_t)((b * 8 + 2 * h + 1) * 128) * 4096 + tid * 8;
    const bf16* Vg = Vimg + (size_t)((b * 4 + h) * 128) * 8192 + tid * 8;
    LAS float* wsf = (LAS float*)(lds + TAB_OFF) + wid * 64;
    f32x16 o[4];
#pragma unroll
    for (int d = 0; d < 4; ++d) o[d] = (f32x16){};
    float mrow = 0.f, lrow = 0.f;
    const unsigned ldsw = (unsigned)wid * 1024u;
#define ATT_DMA(tt) do { const size_t tt_ = (size_t)(tt); LAS unsigned char* sb_ = lds + ((tt) & 3) * 32768 + ldsw; \
        __builtin_amdgcn_global_load_lds((const unsigned*)(K1 + tt_ * 4096), (LAS unsigned*)(sb_), 16, 0, 0); \
        __builtin_amdgcn_global_load_lds((const unsigned*)(K2 + tt_ * 4096), (LAS unsigned*)(sb_ + 8192), 16, 0, 0); \
        __builtin_amdgcn_global_load_lds((const unsigned*)(Vg + tt_ * 8192), (LAS unsigned*)(sb_ + 16384), 16, 0, 0); \
        __builtin_amdgcn_global_load_lds((const unsigned*)(Vg + tt_ * 8192 + 4096), (LAS unsigned*)(sb_ + 24576), 16, 0, 0); } while (0)
#define ATT_QK(P0, P1, tt) do { const LAS unsigned char* Ks_ = lds + ((tt) & 3) * 32768 + comp * 8192 + hi * 1024 + r32 * 16; \
        { const bf16x8 a0_ = *(const LAS bf16x8*)(Ks_), a1_ = *(const LAS bf16x8*)(Ks_ + 512); \
          P0 = __builtin_amdgcn_mfma_f32_32x32x16_bf16(a0_, qr[0], negm, 0, 0, 0); P1 = __builtin_amdgcn_mfma_f32_32x32x16_bf16(a1_, qr[0], negm, 0, 0, 0); } \
        _Pragma("unroll") for (int d0_ = 1; d0_ < 4; ++d0_) { const bf16x8 a0_ = *(const LAS bf16x8*)(Ks_ + d0_ * 2048), a1_ = *(const LAS bf16x8*)(Ks_ + d0_ * 2048 + 512); \
          P0 = __builtin_amdgcn_mfma_f32_32x32x16_bf16(a0_, qr[d0_], P0, 0, 0, 0); P1 = __builtin_amdgcn_mfma_f32_32x32x16_bf16(a1_, qr[d0_], P1, 0, 0, 0); } } while (0)
    ATT_DMA(0); ATT_DMA(1); ATT_DMA(2);
    asm volatile("s_waitcnt vmcnt(8)" ::: "memory");
    __builtin_amdgcn_s_barrier();
    const int vlane = ((lane & 15) >> 2) * 64 + ((lane >> 4) & 1) * 32 + (lane & 3) * 8 + hi * 256;
    f32x16 p0, p1;
    { const f32x16 negm = (f32x16){}; ATT_QK(p0, p1, 0); }
    asm volatile("s_waitcnt vmcnt(4) lgkmcnt(0)" ::: "memory");
    __builtin_amdgcn_s_barrier();
    if (grp == 1) { __builtin_amdgcn_s_setprio(1); __builtin_amdgcn_s_barrier(); }
    for (int i = 0; i < 128; ++i) {
        float rm, rm2;
        asm("v_max3_f32 %0, %1, %2, %3" : "=v"(rm) : "v"(p0[0]), "v"(p0[1]), "v"(p0[2]));
        asm("v_max3_f32 %0, %1, %2, %3" : "=v"(rm2) : "v"(p1[0]), "v"(p1[1]), "v"(p1[2]));
#pragma unroll
        for (int r = 3; r < 15; r += 2) { asm("v_max3_f32 %0, %1, %2, %3" : "=v"(rm) : "v"(rm), "v"(p0[r]), "v"(p0[r + 1])); asm("v_max3_f32 %0, %1, %2, %3" : "=v"(rm2) : "v"(rm2), "v"(p1[r]), "v"(p1[r + 1])); }
        asm("v_max3_f32 %0, %1, %2, %3" : "=v"(rm) : "v"(rm), "v"(p0[15]), "v"(p1[15]));
        rm = swap32_max(fmaxf(rm, rm2));
        const bool need = (i == 0) || (rm > 6.0f);
        if (__any(need)) {
            const float dl = need ? rm : 0.f;
            mrow += dl;
#pragma unroll
            for (int r = 0; r < 16; ++r) { p0[r] -= dl; p1[r] -= dl; }
            if (i > 0) {
                const float f = fexp2(-dl); lrow *= f;
                if (hi == 0) wsf[r32] = f;
                asm volatile("s_waitcnt lgkmcnt(0)" ::: "memory");
#pragma unroll
                for (int r = 0; r < 16; ++r) { const float fr_ = wsf[crow(r, hi)];
#pragma unroll
                    for (int d = 0; d < 4; ++d) o[d][r] *= fr_; }
            }
        }
        float ls0 = 0.f, ls1 = 0.f;
#pragma unroll
        for (int r = 0; r < 16; ++r) { p0[r] = fexp2(p0[r]); p1[r] = fexp2(p1[r]); ls0 += p0[r]; ls1 += p1[r]; }
        lrow += ls0 + ls1;
        const bf16x8 pa0 = pack8(p0[0], p0[1], p0[2], p0[3], p0[4], p0[5], p0[6], p0[7]), pa1 = pack8(p0[8], p0[9], p0[10], p0[11], p0[12], p0[13], p0[14], p0[15]);
        const bf16x8 pa2 = pack8(p1[0], p1[1], p1[2], p1[3], p1[4], p1[5], p1[6], p1[7]), pa3 = pack8(p1[8], p1[9], p1[10], p1[11], p1[12], p1[13], p1[14], p1[15]);
        bf16x8 kf[4], kg[4];
        const LAS unsigned char* Ks_ = lds + ((i + 1) & 3) * 32768 + comp * 8192 + hi * 1024 + r32 * 16;
        kf[0] = *(const LAS bf16x8*)(Ks_); kf[1] = *(const LAS bf16x8*)(Ks_ + 512); kf[2] = *(const LAS bf16x8*)(Ks_ + 2048); kf[3] = *(const LAS bf16x8*)(Ks_ + 2560);
        asm volatile("s_waitcnt vmcnt(0) lgkmcnt(0)" ::: "memory");
        __builtin_amdgcn_s_barrier();
        __builtin_amdgcn_sched_barrier(0);
        const LAS char* Vs = (const LAS char*)lds + (i & 3) * 32768 + 16384 + vlane;
#define ATT_LDV(dst, d) do { dst[0] = cat8(vtr(Vs + (d) * 4096), vtr(Vs + (d) * 4096 + 512)); dst[1] = cat8(vtr(Vs + (d) * 4096 + 1024), vtr(Vs + (d) * 4096 + 1536)); \
        dst[2] = cat8(vtr(Vs + (d) * 4096 + 2048), vtr(Vs + (d) * 4096 + 2560)); dst[3] = cat8(vtr(Vs + (d) * 4096 + 3072), vtr(Vs + (d) * 4096 + 3584)); } while (0)
#define ATT_PV(d, vv) do { asm volatile("" : "+v"(o[d])); o[d] = __builtin_amdgcn_mfma_f32_32x32x16_bf16(pa0, vv[0], o[d], 0, 0, 0); o[d] = __builtin_amdgcn_mfma_f32_32x32x16_bf16(pa1, vv[1], o[d], 0, 0, 0); \
        o[d] = __builtin_amdgcn_mfma_f32_32x32x16_bf16(pa2, vv[2], o[d], 0, 0, 0); o[d] = __builtin_amdgcn_mfma_f32_32x32x16_bf16(pa3, vv[3], o[d], 0, 0, 0); } while (0)
        bf16x8 va[4], vb[4];
        kg[0] = *(const LAS bf16x8*)(Ks_ + 4096); kg[1] = *(const LAS bf16x8*)(Ks_ + 4608); kg[2] = *(const LAS bf16x8*)(Ks_ + 6144); kg[3] = *(const LAS bf16x8*)(Ks_ + 6656);
        ATT_LDV(va, 0);
        __builtin_amdgcn_sched_barrier(0);
        if (i + 1 < 128) {
            f32x16 negm; { const float nm_ = -mrow;
#pragma unroll
                for (int r = 0; r < 16; ++r) negm[r] = nm_; }
            p0 = __builtin_amdgcn_mfma_f32_32x32x16_bf16(kf[0], qr[0], negm, 0, 0, 0); p1 = __builtin_amdgcn_mfma_f32_32x32x16_bf16(kf[1], qr[0], negm, 0, 0, 0);
            p0 = __builtin_amdgcn_mfma_f32_32x32x16_bf16(kf[2], qr[1], p0, 0, 0, 0); p1 = __builtin_amdgcn_mfma_f32_32x32x16_bf16(kf[3], qr[1], p1, 0, 0, 0);
            asm volatile("s_waitcnt lgkmcnt(8)" ::: "memory"); __builtin_amdgcn_sched_barrier(0);
            p0 = __builtin_amdgcn_mfma_f32_32x32x16_bf16(kg[0], qr[2], p0, 0, 0, 0); p1 = __builtin_amdgcn_mfma_f32_32x32x16_bf16(kg[1], qr[2], p1, 0, 0, 0);
            p0 = __builtin_amdgcn_mfma_f32_32x32x16_bf16(kg[2], qr[3], p0, 0, 0, 0); p1 = __builtin_amdgcn_mfma_f32_32x32x16_bf16(kg[3], qr[3], p1, 0, 0, 0);
        }
        __builtin_amdgcn_sched_barrier(0);
        ATT_LDV(vb, 1);
        asm volatile("s_waitcnt lgkmcnt(8)" ::: "memory"); __builtin_amdgcn_sched_barrier(0);
        ATT_PV(0, va);
        __builtin_amdgcn_sched_barrier(0);
        ATT_LDV(va, 2);
        asm volatile("s_waitcnt lgkmcnt(8)" ::: "memory"); __builtin_amdgcn_sched_barrier(0);
        ATT_PV(1, vb);
        __builtin_amdgcn_sched_barrier(0);
        ATT_LDV(vb, 3);
        asm volatile("s_waitcnt lgkmcnt(8)" ::: "memory"); __builtin_amdgcn_sched_barrier(0);
        ATT_PV(2, va);
        asm volatile("s_waitcnt lgkmcnt(0)" ::: "memory"); __builtin_amdgcn_sched_barrier(0);
        ATT_PV(3, vb);
        __builtin_amdgcn_sched_barrier(0);
#undef ATT_LDV
#undef ATT_PV
        if (i + 3 < 128) { ATT_DMA(i + 3); asm volatile("s_waitcnt vmcnt(4) lgkmcnt(0)" ::: "memory"); }
        else asm volatile("s_waitcnt vmcnt(0) lgkmcnt(0)" ::: "memory");
        __builtin_amdgcn_s_barrier();
        __builtin_amdgcn_sched_barrier(0);
    }
    if (grp == 0) __builtin_amdgcn_s_barrier(); else __builtin_amdgcn_s_setprio(0);
#undef ATT_DMA
#undef ATT_QK
    lrow = swap32_add(lrow);
    if (hi == 0) wsf[r32] = frcp(lrow);
    asm volatile("s_waitcnt lgkmcnt(0)" ::: "memory");
#pragma unroll
    for (int r = 0; r < 16; ++r) { const float il = wsf[crow(r, hi)];
#pragma unroll
        for (int d = 0; d < 4; ++d) o[d][r] *= il; }
    LAS float* xb = (LAS float*)lds + (size_t)qsub * 4096 + lane;
    if (comp == 1) {
#pragma unroll
        for (int d = 0; d < 4; ++d)
#pragma unroll
            for (int r = 0; r < 16; ++r) xb[(d * 16 + r) * 64] = o[d][r];
    }
    __syncthreads();
    if (comp == 0) {
        float ss[16];
#pragma unroll
        for (int r = 0; r < 16; ++r) { ss[r] = 0.f;
#pragma unroll
            for (int d = 0; d < 4; ++d) { const float v = o[d][r] - lam * xb[(d * 16 + r) * 64]; o[d][r] = v; ss[r] += v * v; } }
        float gcol[4];
#pragma unroll
        for (int d = 0; d < 4; ++d) gcol[d] = subg[d * 32 + r32] * outscale;
#pragma unroll
        for (int r = 0; r < 16; ++r) { const float tot = half_sum(ss[r]); const float rs = __builtin_amdgcn_rsqf(tot * (1.f / 128.f) + LN_EPS);
            bf16* orow = MIX + ((size_t)b * 8192 + qb * 128 + qsub * 32 + crow(r, hi)) * 1024 + h * 128 + r32;
#pragma unroll
            for (int d = 0; d < 4; ++d) orow[d * 32] = (bf16)(pk2(o[d][r] * rs * gcol[d], 0.f) & 0xffffu); }
    }
    __syncthreads();
}

__device__ __forceinline__ void ret_kv_pair(LAS unsigned char* lds, const bf16* RET, float* RKV, const int unit0, const float* lg2f, const float* lg2b) {
    const int tid = otid(), lane = tid & 63, r32 = lane & 31, hi = lane >> 5; const int wid = __builtin_amdgcn_readfirstlane(tid >> 6);
    const int wg = wid >> 2, w4 = wid & 3, t4 = tid & 255;
    const int unit = unit0 + wg; const int bh = unit >> 6, n = unit & 63, b = bh >> 2, h = bh & 3;
    LAS unsigned char* base = lds + wg * 49152;
    const float l2f = lg2f[h], l2b = lg2b[h];
    const bf16* src = RET + ((size_t)b * 8192 + n * 128) * 1024 + 64 * h;
#pragma unroll
    for (int i = 0; i < 4; ++i) { const int idx = t4 + 256 * i; const int j = idx >> 3, c = idx & 7;
        const u32x4 kk = *(const u32x4*)(src + (size_t)j * 1024 + 256 + c * 8); const u32x4 vv = *(const u32x4*)(src + (size_t)j * 1024 + 512 + c * 8);
        const float wf = fexp2((float)(127 - j) * l2f), wb = fexp2((float)j * l2b);
        u32x4 vf, vb;
#pragma unroll
        for (int e = 0; e < 4; ++e) { const float lo = bflo(vv[e]), hh = bfhi(vv[e]); vf[e] = pk2(lo * wf, hh * wf); vb[e] = pk2(lo * wb, hh * wb); }
        *(LAS u32x4*)(base + j * 128 + c * 16) = kk; *(LAS u32x4*)(base + 16384 + j * 128 + c * 16) = vf; *(LAS u32x4*)(base + 32768 + j * 128 + c * 16) = vb; }
    __syncthreads();
    const int da = w4 >> 1, eb = w4 & 1;
    const int rowoff = (8 * hi + ((lane & 15) >> 2)) * 128 + (16 * ((lane >> 4) & 1) + 4 * (lane & 3)) * 2;
    f32x16 af = (f32x16){}, ab = (f32x16){};
#pragma unroll
    for (int s = 0; s < 8; ++s) {
        const LAS char* kp = (const LAS char*)base + s * 2048 + rowoff + da * 64;
        const LAS char* vp = (const LAS char*)base + 16384 + s * 2048 + rowoff + eb * 64;
        const bf16x8 ka = cat8(vtr(kp), vtr(kp + 512));
        const bf16x8 vf = cat8(vtr(vp), vtr(vp + 512)), vb = cat8(vtr(vp + 16384), vtr(vp + 16384 + 512));
        af = __builtin_amdgcn_mfma_f32_32x32x16_bf16(ka, vf, af, 0, 0, 0);
        ab = __builtin_amdgcn_mfma_f32_32x32x16_bf16(ka, vb, ab, 0, 0, 0);
    }
    float* of = RKV + ((size_t)(bh * 64 + n) * 2) * 4096 + eb * 32 + r32;
#pragma unroll
    for (int r = 0; r < 16; ++r) { const int d = da * 32 + crow(r, hi); of[d * 64] = af[r]; of[4096 + d * 64] = ab[r]; }
    __syncthreads();
}
__device__ __forceinline__ void ret_out_pair(LAS unsigned char* lds, const bf16* RET, const bf16* RST, bf16* MIX, const int unit0, const float* lg2f, const float* lg2b) {
    const int tid = otid(), lane = tid & 63, r32 = lane & 31, hi = lane >> 5; const int wid = __builtin_amdgcn_readfirstlane(tid >> 6);
    const int wg = wid >> 2, w4 = wid & 3, t4 = tid & 255;
    const int unit = unit0 + wg; const int bh = unit >> 6, n = unit & 63, b = bh >> 2, h = bh & 3;
    LAS unsigned char* base = lds + wg * 49152;
    const float l2f = lg2f[h], l2b = lg2b[h];
    const size_t row0 = (size_t)b * 8192 + n * 128;
    const bf16* src = RET + row0 * 1024 + 64 * h;
#pragma unroll
    for (int i = 0; i < 4; ++i) { const int idx = t4 + 256 * i; const int j = idx >> 3, c = idx & 7;
        *(LAS u32x4*)(base + j * 128 + c * 16) = *(const u32x4*)(src + (size_t)j * 1024 + 256 + c * 8);
        *(LAS u32x4*)(base + 16384 + j * 128 + c * 16) = *(const u32x4*)(src + (size_t)j * 1024 + 512 + c * 8); }
    const bf16* rs = RST + ((size_t)(bh * 64 + n) * 2) * 4096;
#pragma unroll
    for (int i = 0; i < 4; ++i) { const int idx = t4 + 256 * i;
        *(LAS u32x4*)(base + 32768 + idx * 16) = *(const u32x4*)(rs + (size_t)idx * 8); }
    bf16x8 qr[4];
    const bf16* qp = src + (size_t)(32 * w4 + r32) * 1024;
#pragma unroll
    for (int d0 = 0; d0 < 4; ++d0) qr[d0] = *(const bf16x8*)(qp + d0 * 16 + hi * 8);
    unsigned short gpre[16][2];
#pragma unroll
    for (int r = 0; r < 16; ++r) { const bf16* gp_ = RET + (row0 + 32 * w4 + crow(r, hi)) * 1024 + 768 + 64 * h + r32; gpre[r][0] = gp_[0]; gpre[r][1] = gp_[32]; }
    __syncthreads();
    const int cq = 32 * w4 + r32;
    f32x16 yi[2] = {(f32x16){}, (f32x16){}}, yf[2] = {(f32x16){}, (f32x16){}}, yb[2] = {(f32x16){}, (f32x16){}};
    const int trl = ((lane & 15) >> 2) * 128 + (16 * ((lane >> 4) & 1) + 4 * (lane & 3)) * 2;
#pragma unroll
    for (int kb = 0; kb < 4; ++kb) {
        f32x16 p = (f32x16){};
#pragma unroll
        for (int d0 = 0; d0 < 4; ++d0) { const bf16x8 a = *(const LAS bf16x8*)(base + (32 * kb + r32) * 128 + (16 * d0 + 8 * hi) * 2); p = __builtin_amdgcn_mfma_f32_32x32x16_bf16(a, qr[d0], p, 0, 0, 0); }
#pragma unroll
        for (int r = 0; r < 16; ++r) { const int j = 32 * kb + crow(r, hi); const int rel = cq - j; p[r] *= fexp2(rel >= 0 ? (float)rel * l2f : (float)(-rel) * l2b); }
        const bf16x8 pa0 = pack8(p[0], p[1], p[2], p[3], p[4], p[5], p[6], p[7]), pa1 = pack8(p[8], p[9], p[10], p[11], p[12], p[13], p[14], p[15]);
#pragma unroll
        for (int eb = 0; eb < 2; ++eb) {
            const LAS char* vp = (const LAS char*)base + 16384 + (32 * kb + 4 * hi) * 128 + trl + eb * 64;
            const bf16x8 v0 = cat8(vtr(vp), vtr(vp + 8 * 128)), v1 = cat8(vtr(vp + 16 * 128), vtr(vp + 24 * 128));
            yi[eb] = __builtin_amdgcn_mfma_f32_32x32x16_bf16(pa0, v0, yi[eb], 0, 0, 0);
            yi[eb] = __builtin_amdgcn_mfma_f32_32x32x16_bf16(pa1, v1, yi[eb], 0, 0, 0);
        }
    }
#pragma unroll
    for (int d0 = 0; d0 < 4; ++d0)
#pragma unroll
        for (int eb = 0; eb < 2; ++eb) {
            const LAS char* rp = (const LAS char*)base + 32768 + (16 * d0 + 8 * hi) * 128 + trl + eb * 64;
            const bf16x8 rf = cat8(vtr(rp), vtr(rp + 4 * 128)), rb = cat8(vtr(rp + 8192), vtr(rp + 8192 + 4 * 128));
            yf[eb] = __builtin_amdgcn_mfma_f32_32x32x16_bf16(qr[d0], rf, yf[eb], 0, 0, 0);
            yb[eb] = __builtin_amdgcn_mfma_f32_32x32x16_bf16(qr[d0], rb, yb[eb], 0, 0, 0);
        }
#pragma unroll
    for (int r = 0; r < 16; ++r) {
        const int c = 32 * w4 + crow(r, hi);
        const float sf = fexp2((float)(c + 1) * l2f), sb = fexp2((float)(128 - c) * l2b);
        const float y0 = yi[0][r] + sf * yf[0][r] + sb * yb[0][r], y1 = yi[1][r] + sf * yf[1][r] + sb * yb[1][r];
        const float mean = half_sum(y0 + y1) * (1.f / 64.f); const float d0_ = y0 - mean, d1_ = y1 - mean;
        const float var = half_sum(d0_ * d0_ + d1_ * d1_) * (1.f / 64.f); const float rstd = __builtin_amdgcn_rsqf(var + LN_EPS);
        bf16* op = MIX + (row0 + c) * 1024 + 768 + 64 * h + r32;
        const float g0 = bf2f(gpre[r][0]), g1 = bf2f(gpre[r][1]);
        op[0] = (bf16)(pk2(g0 * sigmoidf_(g0) * d0_ * rstd, 0.f) & 0xffffu); op[32] = (bf16)(pk2(g1 * sigmoidf_(g1) * d1_ * rstd, 0.f) & 0xffffu);
    }
    __syncthreads();
}

__device__ __forceinline__ int moe_tables(LAS unsigned char* lds, const unsigned* gcnt) {
    LAS int* cnt = (LAS int*)(lds + TAB_OFF); LAS int* tstart = cnt + 32; LAS unsigned char* tile_e = (LAS unsigned char*)(tstart + 36);
    const int tid = otid();
    if (tid < 32) cnt[tid] = (int)gcnt[tid];
    __syncthreads();
    if (tid == 0) { int s = 0; for (int e = 0; e < 32; ++e) { tstart[e] = s; s += (cnt[e] + 255) >> 8; } tstart[32] = s; }
    __syncthreads();
    const int ntile = tstart[32];
    for (int p = tid; p < ntile; p += NTHR) { int e = 0;
#pragma unroll
        for (int k = 1; k < 32; ++k) e += (tstart[k] <= p) ? 1 : 0;
        tile_e[p] = (unsigned char)e; }
    __syncthreads();
    return ntile;
}

constexpr int NPH_LAYER = 10, NPH = 3 + DEPTH * NPH_LAYER;
#ifndef PH_MASK
#define PH_MASK 0x1FFFF
#endif
#define PHM(j) (((PH_MASK) >> (j)) & 1)
#ifndef DUP_MASK
#define DUP_MASK 0x0
#endif
#define NREP(j) (1 + (((DUP_MASK) >> (j)) & 1))
__global__ void __launch_bounds__(NTHR, 2) hybrid_fwd(Args args) {
    extern __shared__ __attribute__((aligned(16))) unsigned char lds_raw[];
    LAS unsigned char* lds = (LAS unsigned char*)lds_raw;
    volatile LAS unsigned* MISC = (volatile LAS unsigned*)(lds + MISC_OFF);
    const int G = gridDim.x, bx = blockIdx.x;
    const int NGW = G * NWAVES, NGT = G * NTHR;
#define PH_IDS const int tid = otid(); const int lane = tid & 63; const int wave = __builtin_amdgcn_readfirstlane(tid >> 6); const int gw = bx * NWAVES + wave; const int gt = bx * NTHR + tid; (void)lane; (void)gw; (void)gt; (void)wave;
    unsigned char* ws = args.ws;
    unsigned* ctl = (unsigned*)(ws + WS_CTL);
    for (int u = threadIdx.x; u < (LDS_BYTES - LDSCTL_OFF) / 4; u += NTHR) ((LAS unsigned*)(lds + LDSCTL_OFF))[u] = 0u;
    __syncthreads();
#if MK_SPLIT
    XcdBarrier bar; bar.bar = ctl + CW_BAR; bar.x = 0; bar.st = nullptr;
#define GRID_BAR() do { } while (0)
#else
    XcdBarrier bar = xcd_barrier_post(ctl + CW_BAR, MISC + 8);
#define GRID_BAR() xcd_barrier(bar)
#endif
    const int lo = args.ph_lo, hi_ph = args.ph_hi;
#define IN(k) (lo <= (k) && (k) < hi_ph)
#ifndef BAR_REP
#define BAR_REP 1
#endif
#define SEAM(k) do { if (IN((k) + 1)) { for (int br_ = 0; br_ < BAR_REP; ++br_) GRID_BAR(); } STAMP(k); } while (0)
#if STAMP_SEL >= 0
    if (threadIdx.x == 0) { const unsigned long long t0_ = __builtin_amdgcn_s_memrealtime(); MISC[16] = (unsigned)t0_; MISC[17] = (unsigned)(t0_ >> 32); MISC[18] = 0u; }
#define STAMP(k) do { if (threadIdx.x == 0) { const unsigned long long now_ = __builtin_amdgcn_s_memrealtime(); const unsigned long long last_ = (unsigned long long)MISC[16] | ((unsigned long long)MISC[17] << 32); \
        if ((k) == STAMP_SEL) MISC[18] = __float_as_uint((float)(now_ - last_) * 0.0002f); MISC[16] = (unsigned)now_; MISC[17] = (unsigned)(now_ >> 32); } } while (0)
#else
#define STAMP(k) do { } while (0)
#endif

    const float* x_in = (const float*)args.in[0]; const float* c_in = (const float*)args.in[1]; const int* pos_in = (const int*)args.in[2];
    const float* ada_w = (const float*)args.in[3]; const float* ada_b = (const float*)args.in[4];
    const float* w_in = (const float*)args.in[5]; const float* w_out = (const float*)args.in[6];
    const float* lq1 = (const float*)args.in[7]; const float* lk1 = (const float*)args.in[8]; const float* lq2 = (const float*)args.in[9]; const float* lk2 = (const float*)args.in[10];
    const float* subln_g = (const float*)args.in[11];
    const float* s5_lre = (const float*)args.in[12]; const float* s5_lim = (const float*)args.in[13]; const float* s5_ls = (const float*)args.in[14];
    const float* s5_bre = (const float*)args.in[15]; const float* s5_bim = (const float*)args.in[16]; const float* s5_cre = (const float*)args.in[17]; const float* s5_cim = (const float*)args.in[18];
    const float* s5_d = (const float*)args.in[19]; const float* glu_w = (const float*)args.in[20]; const float* glu_b = (const float*)args.in[21];
    const float* ln_g = (const float*)args.in[22]; const float* ln_b = (const float*)args.in[23];
    const float* router_w = (const float*)args.in[24]; const float* router_b = (const float*)args.in[25];
    const float* exp_w1 = (const float*)args.in[26]; const float* exp_b1 = (const float*)args.in[27]; const float* exp_w2 = (const float*)args.in[28]; const float* exp_b2 = (const float*)args.in[29];
    float* MOD = (float*)(ws + WS_MOD); float* ROT = (float*)(ws + WS_ROT); float* PW = (float*)(ws + WS_PW); float* BB = (float*)(ws + WS_BB);
    bf16* WIN = (bf16*)(ws + WS_WIN); bf16* WOUT = (bf16*)(ws + WS_WOUT); bf16* GLU = (bf16*)(ws + WS_GLU); bf16* W1S = (bf16*)(ws + WS_W1S); bf16* TW = (bf16*)(ws + WS_TW);
    bf16* W1 = (bf16*)(ws + WS_W1); bf16* W2 = (bf16*)(ws + WS_W2); bf16* HB = (bf16*)(ws + WS_HB);
    bf16* QIMG = (bf16*)(ws + WS_QIMG); bf16* KIMG = (bf16*)(ws + WS_KIMG); bf16* VIMG = (bf16*)(ws + WS_VIMG); bf16* UG2 = (bf16*)(ws + WS_UG2); bf16* RET = (bf16*)(ws + WS_RET);
    float* S5S = (float*)(ws + WS_S5S); bf16* YB = (bf16*)(ws + WS_YB); float* RKV = (float*)(ws + WS_RKV); bf16* RST = (bf16*)(ws + WS_RST); bf16* MIX = (bf16*)(ws + WS_MIX);
    float* YPRE = (float*)(ws + WS_YPRE); float* X1 = (float*)(ws + WS_X1); float* XB = (float*)(ws + WS_XB);
    int* LIST = (int*)(ws + WS_LIST); int* TOKI = (int*)(ws + WS_TOKI); float* GATE = (float*)(ws + WS_GATE); bf16* A2 = (bf16*)(ws + WS_A2); bf16* YS = (bf16*)(ws + WS_YS);
    float* COSA = ROT, *SINA = ROT + (size_t)T * 32, *COSR = ROT + (size_t)T * 64, *SINR = ROT + (size_t)T * 96;

    if (PHM(10) && IN(0)) {
        PH_IDS
        for (int rep = 0; rep < NREP(10); ++rep) {
        LAS float* cond = (LAS float*)lds; LAS float* red = (LAS float*)(lds + 16384);
        for (int i = tid; i < 4096; i += NTHR) { const float v = c_in[i]; cond[i] = v * sigmoidf_(v); }
        __syncthreads();
        for (int it = bx; it < 4 * 96; it += G) {
            const int l = it / 96, n0 = (it % 96) * 64;
            float a0 = 0.f, a1 = 0.f, a2 = 0.f, a3 = 0.f;
            const float* wp = ada_w + ((size_t)l * 1024 + wave * 128) * 6144 + n0 + lane;
#pragma unroll 64
            for (int kk = 0; kk < 128; ++kk) { const float wv = wp[(size_t)kk * 6144]; const int k = wave * 128 + kk; a0 += cond[k] * wv; a1 += cond[1024 + k] * wv; a2 += cond[2048 + k] * wv; a3 += cond[3072 + k] * wv; }
            red[(wave * 4 + 0) * 64 + lane] = a0; red[(wave * 4 + 1) * 64 + lane] = a1; red[(wave * 4 + 2) * 64 + lane] = a2; red[(wave * 4 + 3) * 64 + lane] = a3;
            __syncthreads();
            if (tid < 256) { const int b = tid >> 6; float s = ada_b[(size_t)l * 6144 + n0 + lane];
#pragma unroll
                for (int w = 0; w < 8; ++w) s += red[(w * 4 + b) * 64 + lane];
                MOD[((size_t)l * 4 + b) * 6144 + n0 + lane] = s; }
            __syncthreads();
        }
        for (int i = gt; i < T * 32; i += NGT) { const int row = i >> 5, f = i & 31; const double p = (double)pos_in[row];
            float c, s; sincos_rev(p * args.invfA[f], c, s); COSA[i] = c; SINA[i] = s; sincos_rev(p * args.invfR[f], c, s); COSR[i] = c; SINR[i] = s; }
        for (int i = gt; i < DEPTH * 32 * 1024; i += NGT) { const int k = i & 1023, e = (i >> 10) & 31, ll = i >> 15; ((float*)(ws + WS_ROUTW))[i] = router_w[((size_t)ll * 1024 + k) * 32 + e]; }
        for (int q = gt; q < 4 * 2 * 16 * 64 * 65; q += NGT) {
            const int i = q / 65, tau = q - i * 65; const int g = (i >> 6) & 15, ld = i >> 10;
            const float lr = fminf(s5_lre[i], -1e-4f), li = s5_lim[i]; const float dt = expf(s5_ls[ld * 16 + g]);
            const float mag = expf((float)tau * lr * dt); float c, sn; sincos_rev((double)tau * (double)li * (double)dt, c, sn);
            PW[(size_t)i * 130 + 2 * tau] = mag * c; PW[(size_t)i * 130 + 2 * tau + 1] = mag * sn;
        }
        for (int q = gt; q < 4 * 2 * 16 * 64 * 16; q += NGT) {
            const int i = q >> 4, n = q & 15; const int g = (i >> 6) & 15, ld = i >> 10;
            const float lr = fminf(s5_lre[i], -1e-4f), li = s5_lim[i]; const float dt = expf(s5_ls[ld * 16 + g]);
            const float mag = expf(lr * dt); float c, sn; sincos_rev((double)li * (double)dt, c, sn);
            const float ar = mag * c, ai = mag * sn, den = lr * lr + li * li;
            const float fre = ((ar - 1.0f) * lr + ai * li) / den, fim = (ai * lr - (ar - 1.0f) * li) / den;
            const float br = s5_bre[q], bi = s5_bim[q]; BB[(size_t)q * 2] = fre * br - fim * bi; BB[(size_t)q * 2 + 1] = fre * bi + fim * br;
        }
        __syncthreads(); }
        SEAM(0);
    }
    if (PHM(11) && IN(1)) {
        PH_IDS
        for (int rep = 0; rep < NREP(11); ++rep) {
        if (wave >= 4) {
        const int gw2 = bx * 4 + (wave - 4), NGW2 = G * 4, bt = bx * 256 + (tid - 256), NBT = G * 256;
        for (int m0 = gw2; m0 < T; m0 += 4 * NGW2) { f32x4 v[4][4];
#pragma unroll
            for (int r = 0; r < 4; ++r) { const f32x4* xr = (const f32x4*)(x_in + (size_t)(m0 + r * NGW2) * DM) + lane;
#pragma unroll
                for (int j = 0; j < 4; ++j) v[r][j] = xr[64 * j]; }
#pragma unroll
            for (int r = 0; r < 4; ++r) { const int m = m0 + r * NGW2; const float* md = MOD + (size_t)(m >> 13) * 6144;
#pragma unroll
                for (int j = 0; j < 4; ++j) *(u32x2*)((bf16*)XB + (size_t)m * DM + 4 * lane + 256 * j) = (u32x2){pk2(v[r][j][0], v[r][j][1]), pk2(v[r][j][2], v[r][j][3])};
                mod_row_store(v[r], md, md + 1024, HB + (size_t)m * DM, lane); } }
        float* KT = S5S;
        {
            LAS float* Bl = (LAS float*)(lds + 32768 + wave * 8704);
            LAS float* Pl = (LAS float*)(lds + (wave == 7 ? 102400 : (wave - 4) * 10368)); LAS float* Cr = Pl + 512; LAS float* Ci = Cr + 16 * 65;
#pragma unroll 1
            for (int j = bt; j < 4 * 16 * 2 * 64 * 16; j += NBT) {
                const int n = j & 15, dir = (j >> 10) & 1, g = (j >> 11) & 15, l = j >> 15, tau0 = ((j & ~63) >> 4) & 63;
                const size_t pg = ((size_t)(l * 2 + dir) * 16 + g);
                const float* bsrc = BB + pg * 2048 + 4 * lane; const float* psrc = PW + (pg * 64 + lane) * 130 + 2 * tau0;
                const float* crs = s5_cre + pg * 1024 + 4 * lane; const float* cis = s5_cim + pg * 1024 + 4 * lane;
                f32x4 bf[8], cf[4], df[4]; f32x2 pf[4];
#pragma unroll
                for (int q = 0; q < 8; ++q) bf[q] = *(const f32x4*)(bsrc + 256 * q);
#pragma unroll
                for (int t = 0; t < 4; ++t) pf[t] = *(const f32x2*)(psrc + 2 * t);
#pragma unroll
                for (int q = 0; q < 4; ++q) { cf[q] = *(const f32x4*)(crs + 256 * q); df[q] = *(const f32x4*)(cis + 256 * q); }
#pragma unroll
                for (int q = 0; q < 8; ++q) *(LAS f32x4*)(Bl + 256 * q + 4 * lane) = bf[q];
#pragma unroll
                for (int t = 0; t < 4; ++t) *(LAS f32x2*)(Pl + (lane * 4 + t) * 2) = pf[t];
#pragma unroll
                for (int q = 0; q < 4; ++q) { const int o = (q * 4 + (lane >> 4)) * 65 + 4 * (lane & 15);
#pragma unroll
                    for (int e = 0; e < 4; ++e) { Cr[o + e] = cf[q][e]; Ci[o + e] = df[q][e]; } }
                asm volatile("s_waitcnt lgkmcnt(0)" ::: "memory");
                float acc[16];
#pragma unroll
                for (int m = 0; m < 16; ++m) acc[m] = 0.f;
                const LAS float* pl = Pl + ((lane >> 4) & 3) * 2; const LAS float* crl = Cr + n * 65; const LAS float* cil = Ci + n * 65;
#pragma unroll 4
                for (int p = 0; p < 64; ++p) {
                    const f32x2 pw = *(const LAS f32x2*)(pl + p * 8); const float c_r = crl[p], c_i = cil[p];
                    const float x = c_r * pw[0] - c_i * pw[1], y = c_r * pw[1] + c_i * pw[0];
#pragma unroll
                    for (int m4 = 0; m4 < 8; ++m4) { const f32x4 bv = *(const LAS f32x4*)(Bl + p * 32 + 4 * m4);
                        acc[2 * m4] += bv[0] * x - bv[1] * y; acc[2 * m4 + 1] += bv[2] * x - bv[3] * y; }
                }
                asm volatile("s_waitcnt lgkmcnt(0)" ::: "memory");
#pragma unroll
                for (int m4 = 0; m4 < 4; ++m4) *(f32x4*)(KT + (size_t)j * 16 + 4 * m4) = (f32x4){acc[4 * m4], acc[4 * m4 + 1], acc[4 * m4 + 2], acc[4 * m4 + 3]};
            }
        }
#pragma unroll 2
        for (int i = bt; i < 4 * 16 * 1024 * 32; i += NBT) {
            const int c8 = i & 31, rowj = (i >> 5) & 1023, g = (i >> 15) & 15, l = i >> 19;
            const int col = c8 * 8, dir = col >> 7, part = (col >> 6) & 1, p0 = col & 63;
            const size_t pg = ((size_t)(l * 2 + dir) * 16 + g);
            const int j = rowj >> 4, n = rowj & 15; const int tau = dir == 0 ? j + 1 : 64 - j;
            const float* cp = s5_cre + (pg * 16 + n) * 64 + p0; const float* cq = s5_cim + (pg * 16 + n) * 64 + p0;
            const f32x4 cr0 = *(const f32x4*)cp, cr1 = *(const f32x4*)(cp + 4), ci0 = *(const f32x4*)cq, ci1 = *(const f32x4*)(cq + 4);
            float v[8];
#pragma unroll
            for (int e = 0; e < 8; ++e) { const f32x2 a = *(const f32x2*)(PW + (pg * 64 + p0 + e) * 130 + 2 * tau); const float cr = e < 4 ? cr0[e & 3] : cr1[e & 3], ci = e < 4 ? ci0[e & 3] : ci1[e & 3];
                v[e] = part == 0 ? (cr * a[0] - ci * a[1]) : -(cr * a[1] + ci * a[0]); }
            *(u32x4*)(TW + ((size_t)(l * 16 + g) * 1024 + rowj) * 1280 + 1024 + col) = (u32x4){pk2(v[0], v[1]), pk2(v[2], v[3]), pk2(v[4], v[5]), pk2(v[6], v[7])};
        }
#pragma unroll 2
        for (int i = bt; i < 4 * 16 * 256 * 128; i += NBT) {
            const int c8 = i & 127, p2 = (i >> 7) & 255, g = (i >> 15) & 15, l = i >> 19;
            const int dir = p2 >> 7, part = (p2 >> 6) & 1, p = p2 & 63;
            const size_t pg = ((size_t)(l * 2 + dir) * 16 + g);
            const int sidx = c8 >> 1, m0 = (c8 & 1) * 8; const int tau = dir == 0 ? 63 - sidx : sidx;
            const f32x2 pwv = *(const f32x2*)(PW + (pg * 64 + p) * 130 + 2 * tau);
            const float* bp = BB + ((pg * 64 + p) * 16 + m0) * 2;
            const f32x4 b0 = *(const f32x4*)bp, b1 = *(const f32x4*)(bp + 4), b2 = *(const f32x4*)(bp + 8), b3 = *(const f32x4*)(bp + 12);
            const float br[8] = {b0[0], b0[2], b1[0], b1[2], b2[0], b2[2], b3[0], b3[2]}, bi[8] = {b0[1], b0[3], b1[1], b1[3], b2[1], b2[3], b3[1], b3[3]};
            float v[8];
#pragma unroll
            for (int e = 0; e < 8; ++e) v[e] = part == 0 ? (pwv[0] * br[e] - pwv[1] * bi[e]) : (pwv[0] * bi[e] + pwv[1] * br[e]);
            *(u32x4*)(W1S + (size_t)i * 8) = (u32x4){pk2(v[0], v[1]), pk2(v[2], v[3]), pk2(v[4], v[5]), pk2(v[6], v[7])};
        }
        }
        {
            LAS unsigned* scr = (LAS unsigned*)(lds + 32768 + wave * 8704);
            constexpr int I_IN = 16 * 44, I_OUT = 16 * 16, I_GLU = 4 * 8, I_W1 = 16 * 32, I_W2 = 16 * 16;
            constexpr int N_SMALL = DEPTH * (I_IN + I_OUT + I_GLU);
            constexpr int N_ALL = N_SMALL + DEPTH * NE * (I_W1 + I_W2);
#define CONV_ITEM(PART, itx, v, h) do { int r = (itx); \
                if (r < N_SMALL) { \
                    const int l = r / (I_IN + I_OUT + I_GLU); r %= (I_IN + I_OUT + I_GLU); \
                    if (r < I_IN) transpose_part<1, PART>(w_in + (size_t)l * 1024 * INW, 1024, INW, WIN + (size_t)l * INW * 1024, scr, r, lane, v, h); \
                    else if (r < I_IN + I_OUT) transpose_part<0, PART>(w_out + (size_t)l * 1024 * 1024, 1024, 1024, WOUT + (size_t)l * 1024 * 1024, scr, r - I_IN, lane, v, h); \
                    else transpose_part<3, PART>(glu_w + (size_t)l * 256 * 512, 256, 512, GLU + (size_t)l * 512 * 256, scr, r - I_IN - I_OUT, lane, v, h); \
                } else { \
                    r -= N_SMALL; const int le = r / (I_W1 + I_W2); r %= (I_W1 + I_W2); \
                    if (r < I_W1) transpose_part<2, PART>(exp_w1 + (size_t)le * 1024 * 2048, 1024, 2048, W1 + (size_t)le * 2048 * 1024, scr, r, lane, v, h); \
                    else transpose_part<0, PART>(exp_w2 + (size_t)le * 1024 * 1024, 1024, 1024, W2 + (size_t)le * 1024 * 1024, scr, r - I_W1, lane, v, h); \
                } } while (0)
            static_assert(N_ALL % 8 == 0, "8 items per grab");
            int it0 = 0; if (lane == 0) it0 = (int)__hip_atomic_fetch_add(ctl + CW_CONV, 8u, __ATOMIC_RELAXED, __HIP_MEMORY_SCOPE_AGENT);
            it0 = __builtin_amdgcn_readfirstlane(it0);
            while (it0 < N_ALL) {
                int nx0 = 0; if (lane == 0) nx0 = (int)__hip_atomic_fetch_add(ctl + CW_CONV, 8u, __ATOMIC_RELAXED, __HIP_MEMORY_SCOPE_AGENT);
                float va[32], vb[32];
                CONV_ITEM(0, it0, va, 0);
#pragma unroll 1
                for (int i = 0; i < 8; ++i) {
                    CONV_ITEM(0, it0 + i, vb, 1);
                    CONV_ITEM(1, it0 + i, va, 0);
                    if (i + 1 < 8) CONV_ITEM(0, it0 + i + 1, va, 0);
                    CONV_ITEM(1, it0 + i, vb, 1);
                    CONV_ITEM(2, it0 + i, vb, 0);
                }
                it0 = __builtin_amdgcn_readfirstlane(nx0);
            }
#undef CONV_ITEM
        }
        }
        SEAM(1);
    }
    if (PHM(11) && IN(2)) {
        PH_IDS
        const float* KT = S5S;
        LAS float* slab = (LAS float*)lds;
        for (int it = bx; it < 4 * 16 * 16; it += G) {
            const int n = it & 15, lg = it >> 4;
            for (int q = tid; q < 512; q += NTHR) { const int dt = q >> 2, c4 = q & 3;
                *(LAS f32x4*)(slab + dt * 16 + c4 * 4) = *(const f32x4*)(KT + (((size_t)lg * 128 + dt) * 16 + n) * 16 + c4 * 4); }
            __syncthreads();
#pragma unroll 4
            for (int q = tid; q < 64 * 128; q += NTHR) { const int c8 = q & 127, j = q >> 7; const int sidx = c8 >> 1, m0 = (c8 & 1) * 8;
                const int d = j - sidx; const int tau = d >= 0 ? d : -d; const LAS float* kf = slab + ((d >= 0 ? 0 : 64) + tau) * 16 + m0;
                f32x4 a0 = *(const LAS f32x4*)kf, a1 = *(const LAS f32x4*)(kf + 4);
                if (d == 0) { a0 += *(const LAS f32x4*)(kf + 1024); a1 += *(const LAS f32x4*)(kf + 1028); }
                *(u32x4*)(TW + ((size_t)lg * 1024 + j * 16 + n) * 1280 + sidx * 16 + m0) = pack8u(a0, a1); }
            __syncthreads();
        }
        SEAM(2);
    }

    for (int l = 0; l < DEPTH; ++l) {
        const int P = 3 + l * NPH_LAYER;
        const float* modl = MOD + (size_t)l * 4 * 6144;
        unsigned* gcnt = ctl + CW_GCNT + 64 * l;
        if (PHM(0) && IN(P + 0)) {
            DenseSched S{T / 256, INW / 256, G, bx, (const char*)HB, (const char*)(WIN + (size_t)l * INW * 1024), (size_t)256 * 1024 * 2, (size_t)256 * 1024 * 2};
            EpiProj E{QIMG, KIMG, VIMG, UG2, RET, COSA, SINA, COSR, SINR};
            for (int rep = 0; rep < NREP(0); ++rep) pg8::gemm_phase<EpiProj, DenseSched, false>(lds, 1024, 1024, 1024, S, E);
            SEAM(P + 0);
        }
        if (PHM(1) && IN(P + 1)) {
            S5G1Sched S{G, bx, (const char*)UG2, (const char*)(W1S + (size_t)l * 16 * 256 * 1024)};
            EpiS5S E{(float*)(ws + WS_S5S4)};
            for (int rep = 0; rep < NREP(1); ++rep) {
            if (PHM(12)) pg8::gemm_phase<EpiS5S, S5G1Sched, false>(lds, 256, 1280, 1024, S, E);
            __syncthreads();
            if (PHM(13)) {
                if (bx < 128) ret_kv_pair(lds, RET, RKV, 2 * bx, args.lg2f, args.lg2b);
                else for (int k = 0; k < 3; ++k) ret_kv_pair(lds, RET, RKV, 2 * (128 + (bx - 128) * 3 + k), args.lg2f, args.lg2b);
            }
            }
            SEAM(P + 1);
        }
        if (PHM(2) && IN(P + 2)) {
            PH_IDS
            for (int rep = 0; rep < NREP(2); ++rep) {
            if (bx < 128) {
                const int dir = bx & 1, g = (bx >> 1) & 15, b = bx >> 5;
                const size_t pg = ((size_t)(l * 2 + dir) * 16 + g);
                const float aqr = PW[(pg * 64 + lane) * 130 + 128], aqi = PW[(pg * 64 + lane) * 130 + 129];
                const float* sb = (const float*)(ws + WS_S5S4) + ((size_t)g * 512 + b * 128) * 256 + dir * 128 + lane;
                bf16* ob = UG2 + ((size_t)g * 512 + b * 128) * 1280 + 1024 + dir * 128 + lane;
                float sr[16], si[16];
#pragma unroll
                for (int k = 0; k < 16; ++k) { const int cc = 16 * wave + k; const int c = dir == 0 ? cc : 127 - cc; float ar_ = 0.f, ai_ = 0.f;
#pragma unroll
                    for (int q = 0; q < 4; ++q) { ar_ += sb[(size_t)q * (16 * 512 * 256) + (size_t)c * 256]; ai_ += sb[(size_t)q * (16 * 512 * 256) + (size_t)c * 256 + 64]; }
                    sr[k] = ar_; si[k] = ai_; }
                float hr = 0.f, hi2 = 0.f;
#pragma unroll
                for (int k = 0; k < 16; ++k) { const float nr = aqr * hr - aqi * hi2 + sr[k], ni = aqr * hi2 + aqi * hr + si[k]; hr = nr; hi2 = ni; }
                LAS float* seg = (LAS float*)lds;
                seg[(wave * 2 + 0) * 64 + lane] = hr; seg[(wave * 2 + 1) * 64 + lane] = hi2;
                float a16r = aqr, a16i = aqi;
#pragma unroll
                for (int q = 0; q < 4; ++q) { const float tr_ = a16r * a16r - a16i * a16i, ti_ = 2.f * a16r * a16i; a16r = tr_; a16i = ti_; }
                __syncthreads();
                hr = 0.f; hi2 = 0.f;
                for (int w2 = 0; w2 < wave; ++w2) { const float er = seg[(w2 * 2 + 0) * 64 + lane], ei = seg[(w2 * 2 + 1) * 64 + lane]; const float nr = a16r * hr - a16i * hi2 + er, ni = a16r * hi2 + a16i * hr + ei; hr = nr; hi2 = ni; }
#pragma unroll
                for (int k = 0; k < 16; ++k) { const int cc = 16 * wave + k; const int c = dir == 0 ? cc : 127 - cc;
                    ob[(size_t)c * 1280] = (bf16)(pk2(hr, 0.f) & 0xffffu); ob[(size_t)c * 1280 + 64] = (bf16)(pk2(hi2, 0.f) & 0xffffu);
                    const float nr = aqr * hr - aqi * hi2 + sr[k], ni = aqr * hi2 + aqi * hr + si[k]; hr = nr; hi2 = ni; }
                __syncthreads();
            }
            for (int i = gt; i < 2 * 16 * 4096; i += NGT) { const int idx = i & 4095, dir = (i >> 12) & 1, bh = i >> 13, h = bh & 3;
                const float dk = fexp2(128.f * (dir == 0 ? args.lg2f[h] : args.lg2b[h]));
                const float* kv = RKV + (size_t)bh * 64 * 2 * 4096 + dir * 4096 + idx; bf16* rs = RST + (size_t)bh * 64 * 2 * 4096 + dir * 4096 + idx;
                float st = 0.f;
#pragma unroll 16
                for (int nn = 0; nn < 64; ++nn) { const int n = dir == 0 ? nn : 63 - nn; const float v = kv[(size_t)n * 8192]; rs[(size_t)n * 8192] = (bf16)(pk2(st, 0.f) & 0xffffu); st = dk * st + v; }
            }
            }
            SEAM(P + 2);
        }
        if (PHM(3) && IN(P + 3)) {
            float lam;
            { float s1 = 0.f, s2 = 0.f; for (int i = 0; i < 64; ++i) { s1 += lq1[l * 64 + i] * lk1[l * 64 + i]; s2 += lq2[l * 64 + i] * lk2[l * 64 + i]; } lam = expf(s1) - expf(s2) + args.lam_init[l]; }
            if (PHM(14)) for (int rep = 0; rep < NREP(14); ++rep) for (int u = bx; u < 1024; u += G) { const int qb = u & 63, bh = u >> 6; attn_unit(lds, QIMG, KIMG, VIMG, MIX, bh >> 2, bh & 3, qb, lam, subln_g + l * 128, 1.0f - args.lam_init[l]); }
            const int half = G >> 1;
            if (PHM(15)) {
                GroupSched S{4, half, bx < half ? bx : -1, (const char*)UG2, (const char*)(TW + (size_t)l * 16 * 1024 * 1280), (size_t)512 * 1280 * 2, (size_t)1024 * 1280 * 2, (size_t)256 * 1280 * 2, (size_t)256 * 1280 * 2};
                EpiS5Y E{YB, UG2, s5_d + l * 256};
                for (int rep = 0; rep < NREP(15); ++rep) pg8::gemm_phase<EpiS5Y, GroupSched, false>(lds, 1280, 1280, 1280, S, E);
            }
            __syncthreads();
            if (PHM(16)) for (int rep = 0; rep < NREP(16); ++rep) {
                if (bx < half) ret_out_pair(lds, RET, RST, MIX, 2 * bx, args.lg2f, args.lg2b);
                else for (int k = 0; k < 3; ++k) ret_out_pair(lds, RET, RST, MIX, 2 * (half + (bx - half) * 3 + k), args.lg2f, args.lg2b);
            }
            SEAM(P + 3);
        }
        if (PHM(4) && IN(P + 4)) {
            DenseSched S{T / 256, 2, G, bx, (const char*)YB, (const char*)(GLU + (size_t)l * 512 * 256), (size_t)256 * 256 * 2, (size_t)256 * 256 * 2};
            EpiGlu E{MIX, glu_b + l * 512};
            for (int rep = 0; rep < NREP(4); ++rep) pg8::gemm_phase<EpiGlu, DenseSched, false>(lds, 256, 256, 256, S, E);
            SEAM(P + 4);
        }
        if (PHM(5) && IN(P + 5)) {
            DenseSched S{T / 256, 4, G, bx, (const char*)MIX, (const char*)(WOUT + (size_t)l * 1024 * 1024), (size_t)256 * 1024 * 2, (size_t)256 * 1024 * 2};
            EpiOut E{(bf16*)YPRE, modl};
            for (int rep = 0; rep < NREP(5); ++rep) pg8::gemm_phase<EpiOut, DenseSched, false>(lds, 1024, 1024, 1024, S, E);
            SEAM(P + 5);
        }
        if (PHM(6) && IN(P + 6)) {
            PH_IDS
            for (int rep = 0; rep < NREP(6); ++rep) { const bool commit = (rep == NREP(6) - 1);
            __syncthreads();
            constexpr int TPITCH = 2064;
            LAS float* PART = (LAS float*)(lds + 2 * 16 * TPITCH);
            bf16x8 Bh[4][2], Bl[4][2];
#pragma unroll
            for (int ks = 0; ks < 4; ++ks)
#pragma unroll
                for (int nb = 0; nb < 2; ++nb) { const float* wp = (const float*)(ws + WS_ROUTW) + (size_t)l * 32768 + (size_t)(16 * nb + (lane & 15)) * 1024 + 128 * wave + 32 * ks + 8 * (lane >> 4);
                    const f32x4 w0 = *(const f32x4*)wp, w1 = *(const f32x4*)(wp + 4);
                    const bf16x8 h = pack8(w0[0], w0[1], w0[2], w0[3], w1[0], w1[1], w1[2], w1[3]); Bh[ks][nb] = h;
                    Bl[ks][nb] = pack8(w0[0] - bf2f((unsigned short)h[0]), w0[1] - bf2f((unsigned short)h[1]), w0[2] - bf2f((unsigned short)h[2]), w0[3] - bf2f((unsigned short)h[3]),
                                       w1[0] - bf2f((unsigned short)h[4]), w1[1] - bf2f((unsigned short)h[5]), w1[2] - bf2f((unsigned short)h[6]), w1[3] - bf2f((unsigned short)h[7])); }
            LAS int* lcnt = (LAS int*)(lds + TAB_OFF); LAS int* lbase = lcnt + 32; LAS int* ent = lbase + 32;
            if (tid < 32) lcnt[tid] = 0;
            __syncthreads();
            const float rbv = router_b[l * 32 + (lane >> 1)];
            int it = 0;
            u32x2 xn[2][4]; u32x2 yn[2][4];
#pragma unroll
            for (int r = 0; r < 2; ++r)
#pragma unroll
                for (int j = 0; j < 4; ++j) { yn[r][j] = __builtin_nontemporal_load((const u32x2*)((const bf16*)YPRE + (size_t)(gw + r * NGW) * DM + 4 * lane + 256 * j)); xn[r][j] = __builtin_nontemporal_load((const u32x2*)((const bf16*)XB + (size_t)(gw + r * NGW) * DM + 4 * lane + 256 * j)); }
            for (int m0 = gw; m0 < T; m0 += 2 * NGW, ++it) {
                f32x4 v[2][4]; float mean[2], rstd[2];
#pragma unroll
                for (int r = 0; r < 2; ++r)
#pragma unroll
                    for (int j = 0; j < 4; ++j) { const u32x2 ym = yn[r][j], xm = xn[r][j]; v[r][j] = (f32x4){bflo(xm[0]), bfhi(xm[0]), bflo(xm[1]), bfhi(xm[1])} * DN_ALPHA + (f32x4){bflo(ym[0]), bfhi(ym[0]), bflo(ym[1]), bfhi(ym[1])}; }
                { const int mn = (m0 + 2 * NGW < T) ? m0 + 2 * NGW : m0;
#pragma unroll
                  for (int r = 0; r < 2; ++r)
#pragma unroll
                    for (int j = 0; j < 4; ++j) { yn[r][j] = __builtin_nontemporal_load((const u32x2*)((const bf16*)YPRE + (size_t)(mn + r * NGW) * DM + 4 * lane + 256 * j)); xn[r][j] = __builtin_nontemporal_load((const u32x2*)((const bf16*)XB + (size_t)(mn + r * NGW) * DM + 4 * lane + 256 * j)); } }
                f32x4 pg_[4], pb_[4], psc[4], psh[4];
                const float* sh0 = modl + (size_t)(m0 >> 13) * 6144 + 3 * 1024;
#pragma unroll
                for (int j = 0; j < 4; ++j) { const int col = 4 * lane + 256 * j; pg_[j] = *(const f32x4*)(ln_g + (size_t)(l * 2) * DM + col); pb_[j] = *(const f32x4*)(ln_b + (size_t)(l * 2) * DM + col);
                    psh[j] = *(const f32x4*)(sh0 + col); psc[j] = *(const f32x4*)(sh0 + 1024 + col); }
#pragma unroll
                for (int r = 0; r < 2; ++r) row_stats(v[r], mean[r], rstd[r]);
#pragma unroll
                for (int j = 0; j < 4; ++j) { const int col = 4 * lane + 256 * j; const f32x4 gg = pg_[j], bb = pb_[j];
#pragma unroll
                    for (int r = 0; r < 2; ++r) { v[r][j] = (v[r][j] - mean[r]) * rstd[r] * gg + bb; *(u32x2*)((bf16*)X1 + (size_t)(m0 + r * NGW) * DM + col) = (u32x2){pk2(v[r][j][0], v[r][j][1]), pk2(v[r][j][2], v[r][j][3])}; } }
#pragma unroll
                for (int r = 0; r < 2; ++r) row_stats(v[r], mean[r], rstd[r]);
#pragma unroll
                for (int r = 0; r < 2; ++r) { const int m = m0 + r * NGW; const float* sh = modl + (size_t)(m >> 13) * 6144 + 3 * 1024; const float* sc = sh + 1024;
                    if (sh != sh0) {
#pragma unroll
                        for (int j = 0; j < 4; ++j) { const int col = 4 * lane + 256 * j; psc[j] = *(const f32x4*)(sc + col); psh[j] = *(const f32x4*)(sh + col); } }
#pragma unroll
                    for (int j = 0; j < 4; ++j) { const int col = 4 * lane + 256 * j; const f32x4 a = psc[j], bb = psh[j];
                        v[r][j] = (v[r][j] - mean[r]) * rstd[r] * (a + 1.0f) + bb; const unsigned h0 = pk2(v[r][j][0], v[r][j][1]), h1 = pk2(v[r][j][2], v[r][j][3]); *(u32x2*)(HB + (size_t)m * DM + col) = (u32x2){h0, h1};
                        *(LAS u32x2*)(lds + (2 * wave + r) * TPITCH + col * 2) = (u32x2){h0, h1};
                        *(LAS u32x2*)(lds + 16 * TPITCH + (2 * wave + r) * TPITCH + col * 2) = (u32x2){pk2(v[r][j][0] - bflo(h0), v[r][j][1] - bfhi(h0)), pk2(v[r][j][2] - bflo(h1), v[r][j][3] - bfhi(h1))}; } }
                asm volatile("s_waitcnt lgkmcnt(0)" ::: "memory"); __builtin_amdgcn_s_barrier();
                { f32x4 racc[2] = {(f32x4){0.f, 0.f, 0.f, 0.f}, (f32x4){0.f, 0.f, 0.f, 0.f}};
#pragma unroll
                  for (int ks = 0; ks < 4; ++ks) { const int ao = (lane & 15) * TPITCH + (128 * wave + 32 * ks + 8 * (lane >> 4)) * 2;
                      const bf16x8 ah = *(const LAS bf16x8*)(lds + ao), al = *(const LAS bf16x8*)(lds + 16 * TPITCH + ao);
#pragma unroll
                      for (int nb = 0; nb < 2; ++nb) { racc[nb] = __builtin_amdgcn_mfma_f32_16x16x32_bf16(ah, Bh[ks][nb], racc[nb], 0, 0, 0);
                          racc[nb] = __builtin_amdgcn_mfma_f32_16x16x32_bf16(ah, Bl[ks][nb], racc[nb], 0, 0, 0); racc[nb] = __builtin_amdgcn_mfma_f32_16x16x32_bf16(al, Bh[ks][nb], racc[nb], 0, 0, 0); } }
#pragma unroll
                  for (int nb = 0; nb < 2; ++nb)
#pragma unroll
                      for (int i = 0; i < 4; ++i) PART[(wave * 16 + 4 * (lane >> 4) + i) * 33 + 16 * nb + (lane & 15)] = racc[nb][i]; }
                asm volatile("s_waitcnt lgkmcnt(0)" ::: "memory"); __builtin_amdgcn_s_barrier();
#pragma unroll
                for (int r = 0; r < 2; ++r) {
                    float lgv = rbv;
#pragma unroll
                    for (int w2 = 0; w2 < 8; ++w2) lgv += PART[(w2 * 16 + 2 * wave + r) * 33 + (lane >> 1)];
                    int te[4]; float tv[4];
#pragma unroll
                    for (int k = 0; k < 4; ++k) { const float mx = wave_max(lgv); const unsigned long long bm = __ballot(lgv == mx); const int fl = __ffsll((long long)bm) - 1;
                        te[k] = fl >> 1; tv[k] = mx; lgv = ((lane >> 1) == (fl >> 1)) ? -INFINITY : lgv; }
                    float gs = 0.f, ge[4];
#pragma unroll
                    for (int k = 0; k < 4; ++k) { ge[k] = fexp2((tv[k] - tv[0]) * LOG2E); gs += ge[k]; }
                    const float ig = frcp(gs);
                    if (lane < 4 && commit) { const int e = lane == 0 ? te[0] : lane == 1 ? te[1] : lane == 2 ? te[2] : te[3]; const float gv = (lane == 0 ? ge[0] : lane == 1 ? ge[1] : lane == 2 ? ge[2] : ge[3]) * ig;
                        const int lp = atomicAdd((int*)&lcnt[e], 1);
                        const int sl = (wave * 32 + it * 2 + r) * 4 + lane; ent[sl * 3] = e; ent[sl * 3 + 1] = lp; ent[sl * 3 + 2] = __float_as_int(gv); }
                }
            }
            if (!commit) continue;
            __syncthreads();
            if (tid < 32) lbase[tid] = (int)atomicAdd(gcnt + tid, (unsigned)lcnt[tid]);
            __syncthreads();
            { int nl = 0; for (int m = gw; m < T; m += NGW, ++nl) { if (lane < 4) { const int sl = (wave * 32 + nl) * 4 + lane; const int e = ent[sl * 3], pos = lbase[e] + ent[sl * 3 + 1];
                    LIST[(size_t)e * T + pos] = m; TOKI[((size_t)m * 4 + lane) * 2] = e; TOKI[((size_t)m * 4 + lane) * 2 + 1] = pos; GATE[(size_t)m * 4 + lane] = __int_as_float(ent[sl * 3 + 2]); } } }
            }
            SEAM(P + 6);
        }
        if (PHM(7) && IN(P + 7)) {
            const int ntile = moe_tables(lds, gcnt);
            LAS int* cnt = (LAS int*)(lds + TAB_OFF);
            MoeSched S{ntile, 8, G, bx, (const char*)HB, (const char*)(W1 + (size_t)l * 32 * 2048 * 1024), (size_t)2048 * 1024 * 2, 0, (size_t)256 * 1024 * 2, cnt, cnt + 32, (const LAS unsigned char*)(cnt + 68), LIST};
            EpiMoe1 E{A2, exp_b1 + (size_t)l * 32 * 2048};
            for (int rep = 0; rep < NREP(7); ++rep) pg8::gemm_phase<EpiMoe1, MoeSched, true>(lds, 1024, 1024, 1024, S, E);
            SEAM(P + 7);
        }
        if (PHM(8) && IN(P + 8)) {
            const int ntile = ((const LAS int*)(lds + TAB_OFF))[32 + 32];
            LAS int* cnt = (LAS int*)(lds + TAB_OFF);
            MoeSched S{ntile, 4, G, bx, (const char*)A2, (const char*)(W2 + (size_t)l * 32 * 1024 * 1024), (size_t)1024 * 1024 * 2, (size_t)256 * 1024 * 2, (size_t)256 * 1024 * 2, cnt, cnt + 32, (const LAS unsigned char*)(cnt + 68), LIST};
            EpiMoe2 E{YS, exp_b2 + (size_t)l * 32 * 1024};
            for (int rep = 0; rep < NREP(8); ++rep) pg8::gemm_phase<EpiMoe2, MoeSched, false>(lds, 1024, 1024, 1024, S, E);
            SEAM(P + 8);
        }
        if (PHM(9) && IN(P + 9)) {
            PH_IDS
            const LAS int* tstart = (const LAS int*)(lds + TAB_OFF) + 32;
            for (int rep = 0; rep < NREP(9); ++rep)
            for (int m0 = gw; m0 < T; m0 += 2 * NGW) {
                int te[2][4], tp[2][4]; float tg[2][4];
#pragma unroll
                for (int r = 0; r < 2; ++r) { const int m = m0 + r * NGW; const u32x4 q0 = *(const u32x4*)(TOKI + (size_t)m * 8), q1 = *(const u32x4*)(TOKI + (size_t)m * 8 + 4); const f32x4 gq = *(const f32x4*)(GATE + (size_t)m * 4);
                    te[r][0] = q0[0]; tp[r][0] = q0[1]; te[r][1] = q0[2]; tp[r][1] = q0[3]; te[r][2] = q1[0]; tp[r][2] = q1[1]; te[r][3] = q1[2]; tp[r][3] = q1[3];
                    tg[r][0] = gq[0]; tg[r][1] = gq[1]; tg[r][2] = gq[2]; tg[r][3] = gq[3]; }
                u32x2 yw[2][4][4]; u32x2 xx[2][4];
#pragma unroll
                for (int r = 0; r < 2; ++r) {
#pragma unroll
                    for (int k = 0; k < 4; ++k) { const bf16* yr = YS + ((size_t)tstart[te[r][k]] * 256 + tp[r][k]) * 1024;
#pragma unroll
                        for (int j = 0; j < 4; ++j) yw[r][k][j] = __builtin_nontemporal_load((const u32x2*)(yr + 4 * lane + 256 * j)); }
#pragma unroll
                    for (int j = 0; j < 4; ++j) xx[r][j] = __builtin_nontemporal_load((const u32x2*)((const bf16*)X1 + (size_t)(m0 + r * NGW) * DM + 4 * lane + 256 * j)); }
                f32x4 pg2[4], plg[4], plb[4], nsh[4], nsc[4];
                const int b0 = m0 >> 13; const float* md0 = MOD + ((size_t)(l + 1 < DEPTH ? l + 1 : l) * 4 + b0) * 6144;
#pragma unroll
                for (int j = 0; j < 4; ++j) { const int col = 4 * lane + 256 * j; pg2[j] = *(const f32x4*)(modl + (size_t)b0 * 6144 + 5 * 1024 + col);
                    plg[j] = *(const f32x4*)(ln_g + (size_t)(l * 2 + 1) * DM + col); plb[j] = *(const f32x4*)(ln_b + (size_t)(l * 2 + 1) * DM + col);
                    nsh[j] = *(const f32x4*)(md0 + col); nsc[j] = *(const f32x4*)(md0 + 1024 + col); }
#pragma unroll
                for (int r = 0; r < 2; ++r) {
                    const int m = m0 + r * NGW, b = m >> 13;
                    if (b != b0) {
                        const float* md = MOD + ((size_t)(l + 1 < DEPTH ? l + 1 : l) * 4 + b) * 6144;
#pragma unroll
                        for (int j = 0; j < 4; ++j) { const int col = 4 * lane + 256 * j; pg2[j] = *(const f32x4*)(modl + (size_t)b * 6144 + 5 * 1024 + col); nsh[j] = *(const f32x4*)(md + col); nsc[j] = *(const f32x4*)(md + 1024 + col); } }
                    f32x4 v[4];
#pragma unroll
                    for (int j = 0; j < 4; ++j) { f32x4 ff = (f32x4){0.f, 0.f, 0.f, 0.f};
#pragma unroll
                        for (int k = 0; k < 4; ++k) { const u32x2 w = yw[r][k][j]; ff += (f32x4){bflo(w[0]), bfhi(w[0]), bflo(w[1]), bfhi(w[1])} * tg[r][k]; }
                        const f32x4 gg = pg2[j]; const u32x2 xw = xx[r][j]; v[j] = (f32x4){bflo(xw[0]), bfhi(xw[0]), bflo(xw[1]), bfhi(xw[1])} * DN_ALPHA + (gg + 1.0f) * ff; }
                    float mean, rstd; row_stats(v, mean, rstd);
#pragma unroll
                    for (int j = 0; j < 4; ++j) { const int col = 4 * lane + 256 * j; const f32x4 gg = plg[j], bb = plb[j];
                        v[j] = (v[j] - mean) * rstd * gg + bb;
                        if (l + 1 < DEPTH) *(u32x2*)((bf16*)XB + (size_t)m * DM + col) = (u32x2){pk2(v[j][0], v[j][1]), pk2(v[j][2], v[j][3])}; else *(f32x4*)(args.out + (size_t)m * DM + col) = v[j]; }
                    if (l + 1 < DEPTH) { float mean2, rstd2; row_stats(v, mean2, rstd2);
#pragma unroll
                        for (int j = 0; j < 4; ++j) { const int col = 4 * lane + 256 * j; const f32x4 h = (v[j] - mean2) * rstd2 * (nsc[j] + 1.0f) + nsh[j]; *(u32x2*)(HB + (size_t)m * DM + col) = (u32x2){pk2(h[0], h[1]), pk2(h[2], h[3])}; } }
                }
            }
            SEAM(P + 9);
        }
    }
#if STAMP_SEL >= 0
    __syncthreads();
    if (bx == 0 && threadIdx.x == 0) args.out[0] = __uint_as_float(MISC[18]);
#endif
#undef IN
#undef SEAM
#undef GRID_BAR
}

extern "C" void kernel_launch(void* const* d_in, const int* in_sizes, int n_in, void* d_out, int out_size, void* d_ws, size_t ws_size, hipStream_t stream) {
    static int grid = 0;
    if (grid == 0) {
        if (n_in != 30 || in_sizes[0] != T * DM || out_size != T * DM || ws_size < WS_END) { fprintf(stderr, "kernel_launch: unexpected problem (n_in %d, in0 %d, out %d, ws %zu)\n", n_in, n_in > 0 ? in_sizes[0] : -1, out_size, ws_size); grid = -1; return; }
        int dev = 0, cus = 0, per_cu = 0;
        if (hipGetDevice(&dev) != hipSuccess || hipDeviceGetAttribute(&cus, hipDeviceAttributeMultiprocessorCount, dev) != hipSuccess) { grid = -1; return; }
        if (hipFuncSetAttribute((const void*)hybrid_fwd, hipFuncAttributeMaxDynamicSharedMemorySize, LDS_BYTES) != hipSuccess) { fprintf(stderr, "kernel_launch: hipFuncSetAttribute failed\n"); grid = -1; return; }
        if (hipOccupancyMaxActiveBlocksPerMultiprocessor(&per_cu, (const void*)hybrid_fwd, NTHR, LDS_BYTES) != hipSuccess || per_cu < 1) { fprintf(stderr, "kernel_launch: occupancy query says %d\n", per_cu); (void)hipGetLastError(); if (per_cu < 1) { grid = -1; return; } }
        if (cus < 128) { grid = -1; return; }
        grid = cus >= 256 ? 256 : 128;
    }
    if (grid < 0) return;
    (void)hipMemsetAsync((char*)d_ws + WS_CTL, 0, CTL_BYTES, stream);
    Args a{};
    for (int i = 0; i < 30; ++i) a.in[i] = d_in[i];
    a.out = (float*)d_out; a.ws = (unsigned char*)d_ws;
    for (int i = 0; i < 32; ++i) { a.invfA[i] = std::pow(10000.0, -(double)i / 32.0); a.invfR[i] = std::pow(10000.0, -(double)i / 31.0); }
    for (int l = 0; l < 4; ++l) a.lam_init[l] = (float)(0.8 - 0.6 * std::exp(-0.3 * l));
    for (int h = 0; h < 4; ++h) { a.lg2f[h] = (float)std::log2(1.0 - std::exp2(-5.0 - h)); a.lg2b[h] = (float)std::log2(1.0 - std::exp2(-5.5 - h)); }
#if MK_SPLIT
    for (int p = 0; p < NPH; ++p) { a.ph_lo = p; a.ph_hi = p + 1; hipLaunchKernelGGL(hybrid_fwd, dim3(grid), dim3(NTHR), LDS_BYTES, stream, a); }
#else
    a.ph_lo = 0; a.ph_hi = NPH;
    hipLaunchKernelGGL(hybrid_fwd, dim3(grid), dim3(NTHR), LDS_BYTES, stream, a);
#endif
}
```
